# Optimizing an MI355X kernel written in HIP

```python
import math
import jax, jax.numpy as jnp
from jax import lax
import numpy as np

D_MODEL = 1024
BATCH = 4
SEQ = 4096
DEPTH = 2

GRID_W = 64
EPS = 1e-6
HEAD_DIM = 64
GLA_HEADS = 4
GLA_DK = 32
GLA_DV = 64
GLA_WIDTH = GLA_HEADS * GLA_DV
GLA_QK = GLA_HEADS * GLA_DK
GLA_LOWRANK = 16
GLA_GATE_NORM = 16.0
GLA_CHUNK = 32
ATT_HEADS = 8
ATT_KV_HEADS = 2
ATT_GROUP = ATT_HEADS // ATT_KV_HEADS
ATT_WIDTH = ATT_HEADS * HEAD_DIM
ATT_KV = ATT_KV_HEADS * HEAD_DIM
ATT_BLOCK = 128
ROPE_THETA = 10000.0
ROPE_HALF = HEAD_DIM // 2
HY_WIDTH = D_MODEL - GLA_WIDTH - ATT_WIDTH
HY_EMB = 33
HY_BANDS = (HY_EMB - 1) // 2
HY_ORDER_DIM = 64
HY_INNER = 2
HY_TARGET = 1e-2
HY_FAST = 0.3
HY_SLOW = 1.5
HY_MIN_DECAY = math.log(HY_TARGET) / HY_SLOW
HY_MAX_DECAY = math.log(HY_TARGET) / HY_FAST
N_EXPERTS = 16
EC_FACTOR = 2
EXPERT_FF = 2816
SPLITS = (GLA_QK, GLA_QK, GLA_WIDTH, GLA_WIDTH, 2 * GLA_LOWRANK, ATT_WIDTH, ATT_KV, ATT_KV, 3 * HY_WIDTH)
D_IN_PROJ = sum(SPLITS)

kernel_name = 'hybrid_gla_gqa_hyena_ec_moe_encoder'


def rmsnorm(x, g):
    xf = x.astype(jnp.float32)
    y = xf * lax.rsqrt(jnp.mean(xf * xf, axis=-1, keepdims=True) + EPS)
    return (y * g.astype(jnp.float32)).astype(x.dtype)


def axial_rope_tables(L):
    n_rows = L // GRID_W
    row = jnp.repeat(jnp.arange(n_rows), GRID_W).astype(jnp.float32)
    col = jnp.tile(jnp.arange(GRID_W), n_rows).astype(jnp.float32)
    inv = 1.0 / (ROPE_THETA ** (jnp.arange(0, ROPE_HALF, 2, dtype=jnp.float32) / ROPE_HALF))
    ar = row[:, None] * inv[None]
    ac = col[:, None] * inv[None]
    ang = jnp.concatenate([ar, ar, ac, ac], axis=-1)
    return jnp.cos(ang), jnp.sin(ang)


def apply_axial_rope(x, cos, sin):
    xr = x.reshape(x.shape[:-1] + (2, 2, ROPE_HALF // 2))
    rot = jnp.stack([-xr[..., 1, :], xr[..., 0, :]], axis=-2).reshape(x.shape)
    return (x * cos[None, :, None, :] + rot * sin[None, :, None, :]).astype(x.dtype)


def gla_direction(q, k, v, log_a):
    B, H, L, dk = q.shape
    dv = v.shape[-1]
    n = L // GLA_CHUNK
    rs = lambda t: t.reshape(B, H, n, GLA_CHUNK, t.shape[-1])
    q, k, v, log_a = rs(q), rs(k), rs(v), rs(log_a)
    b = jnp.cumsum(log_a, axis=-2)
    lower = jnp.tril(jnp.ones((GLA_CHUNK, GLA_CHUNK), dtype=bool))
    diff = b[..., :, None, :] - b[..., None, :, :]
    decay = jnp.exp(jnp.where(lower[:, :, None], diff, -jnp.inf))
    scores = jnp.einsum('bhnid,bhnjd,bhnijd->bhnij', q, k, decay)
    o_intra = jnp.einsum('bhnij,bhnjv->bhniv', scores, v)
    b_last = b[..., -1:, :]
    q_dec = q * jnp.exp(b)
    k_dec = k * jnp.exp(b_last - b)
    a_last = jnp.exp(b_last[..., 0, :])

    def step(state, inp):
        qd, kd, vc, al = inp
        o = jnp.einsum('bhcd,bhdv->bhcv', qd, state)
        state = state * al[..., None] + jnp.einsum('bhcd,bhcv->bhdv', kd, vc)
        return state, o

    mv = lambda t: jnp.moveaxis(t, 2, 0)
    s0 = jnp.zeros((B, H, dk, dv), jnp.float32)
    _, o_inter = lax.scan(step, s0, (mv(q_dec), mv(k_dec), mv(v), mv(a_last)))
    o = o_intra + jnp.moveaxis(o_inter, 0, 2)
    return o.reshape(B, H, L, dv)


def gla_group(gq, gk, gv, gg, glr, w_dec, b_dec, norm_g):
    B, L, _ = gq.shape
    heads = lambda t, d: jnp.transpose(t.reshape(B, L, GLA_HEADS, d), (0, 2, 1, 3)).astype(jnp.float32)
    q = heads(gq, GLA_DK) * (GLA_DK ** -0.5)
    k = heads(gk, GLA_DK)
    v = heads(gv, GLA_DV)
    lr_f, lr_b = jnp.split(glr, 2, axis=-1)
    la_f = heads(jax.nn.log_sigmoid((lr_f @ w_dec[0] + b_dec[0]).astype(jnp.float32)) / GLA_GATE_NORM, GLA_DK)
    la_b = heads(jax.nn.log_sigmoid((lr_b @ w_dec[1] + b_dec[1]).astype(jnp.float32)) / GLA_GATE_NORM, GLA_DK)
    fl = lambda t: jnp.flip(t, axis=2)
    o = gla_direction(q, k, v, la_f) + fl(gla_direction(fl(q), fl(k), fl(v), fl(la_b)))
    o = jnp.transpose(o, (0, 2, 1, 3))
    o = rmsnorm(o, norm_g) * jax.nn.silu(gg.reshape(B, L, GLA_HEADS, GLA_DV).astype(jnp.float32))
    return o.reshape(B, L, GLA_WIDTH).astype(gq.dtype)


def attention_group(aq, ak, av, q_norm_g, k_norm_g, cos, sin):
    B, L, _ = aq.shape
    q = apply_axial_rope(rmsnorm(aq.reshape(B, L, ATT_HEADS, HEAD_DIM), q_norm_g), cos, sin)
    k = apply_axial_rope(rmsnorm(ak.reshape(B, L, ATT_KV_HEADS, HEAD_DIM), k_norm_g), cos, sin)
    v = av.reshape(B, L, ATT_KV_HEADS, HEAD_DIM)
    kf = k.astype(jnp.float32)
    vf = v.astype(jnp.float32)
    nb = L // ATT_BLOCK
    qb = jnp.moveaxis(q.reshape(B, nb, ATT_BLOCK, ATT_KV_HEADS, ATT_GROUP, HEAD_DIM), 1, 0)
    scale = HEAD_DIM ** -0.5

    def block(qc):
        s = jnp.einsum('bqkgd,bskd->bkgqs', qc.astype(jnp.float32), kf) * scale
        p = jax.nn.softmax(s, axis=-1)
        return jnp.einsum('bkgqs,bskd->bqkgd', p, vf)

    o = lax.map(block, qb)
    return jnp.moveaxis(o, 0, 1).reshape(B, L, ATT_WIDTH).astype(aq.dtype)


def short_conv3(u, w, b):
    up = jnp.pad(u, ((0, 0), (1, 1), (0, 0)))
    return up[:, :-2] * w[0] + up[:, 1:-1] * w[1] + up[:, 2:] * w[2] + b


def hyena_filters(L, w1, b1, w2, b2, w3, freq):
    pos = jnp.arange(L, dtype=jnp.float32)
    t = pos / (L - 1)
    f = jnp.linspace(1e-4, HY_BANDS - 1, HY_BANDS, dtype=jnp.float32)
    ang = (2.0 * math.pi * pos / L)[:, None] * f[None]
    z = jnp.concatenate([t[:, None], jnp.cos(ang), -jnp.sin(ang)], axis=-1)
    fr = freq.astype(jnp.float32)
    h = jnp.sin(fr * (z @ w1.astype(jnp.float32) + b1.astype(jnp.float32)))
    for i in range(HY_INNER):
        h = jnp.sin(fr * (h @ w2[i].astype(jnp.float32) + b2[i].astype(jnp.float32)))
    h = h @ w3.astype(jnp.float32)
    deltas = jnp.abs(jnp.linspace(HY_MIN_DECAY, HY_MAX_DECAY, HY_WIDTH, dtype=jnp.float32))
    window = jnp.exp(-t[:, None] * deltas[None])
    h = h * jnp.concatenate([window, window], axis=-1)
    h_f, h_b = h[:, :HY_WIDTH], h[:, HY_WIDTH:]
    return jnp.concatenate([h_f, jnp.zeros((1, HY_WIDTH), jnp.float32), h_b[1:][::-1]], axis=0)


def long_conv(z, h_full):
    L = z.shape[1]
    Z = jnp.fft.rfft(z.astype(jnp.float32), n=2 * L, axis=1)
    Hf = jnp.fft.rfft(h_full, n=2 * L, axis=0)
    return jnp.fft.irfft(Z * Hf[None], n=2 * L, axis=1)[:, :L]


def hyena_group(hy, conv_w, conv_b, w1, b1, w2, b2, w3, freq, skip):
    L = hy.shape[1]
    u = short_conv3(hy, conv_w, conv_b)
    x0, x1, v = jnp.split(u, 3, axis=-1)
    z = (v * x1).astype(jnp.float32)
    z = long_conv(z, hyena_filters(L, w1, b1, w2, b2, w3, freq)) + z * skip.astype(jnp.float32)
    return (x0.astype(jnp.float32) * z).astype(hy.dtype)


def expert_choice_ffn(h, router_w, w_gate, w_up, w_down):
    B, T, D = h.shape
    cap = EC_FACTOR * T // N_EXPERTS
    aff = jax.nn.softmax((h @ router_w).astype(jnp.float32), axis=-1)
    gates, idx = lax.top_k(jnp.transpose(aff, (0, 2, 1)), cap)
    xg = jax.vmap(lambda hb, ib: hb[ib])(h, idx)
    a = jnp.einsum('becd,edf->becf', xg, w_gate)
    u = jnp.einsum('becd,edf->becf', xg, w_up)
    y = jnp.einsum('becf,efd->becd', jax.nn.silu(a) * u, w_down)
    y = y * gates[..., None].astype(y.dtype)
    return jax.vmap(lambda ib, yb: jnp.zeros((T, D), yb.dtype).at[ib.reshape(-1)].add(yb.reshape(-1, D)))(idx, y)


def setup_inputs(seed: int = 0) -> dict:
    key = jax.random.key(seed)
    ks = jax.random.split(key, 30)
    nrm = lambda k, shape, s: jax.random.normal(k, shape, jnp.float32) * s
    gain = lambda k, shape: 1.0 + 0.05 * jax.random.normal(k, shape, jnp.float32)
    D = D_MODEL
    return {
        'x': nrm(ks[0], (BATCH, SEQ, D), 1.0),
        'c': nrm(ks[1], (BATCH, D), 1.0),
        'ada_w': nrm(ks[2], (DEPTH, D, 6 * D), 0.5 * D ** -0.5),
        'ada_b': nrm(ks[3], (DEPTH, 6 * D), 0.02),
        'mix_pre_g': gain(ks[4], (DEPTH, D)),
        'mix_post_g': gain(ks[5], (DEPTH, D)),
        'w_in': nrm(ks[6], (DEPTH, D, D_IN_PROJ), D ** -0.5),
        'gla_w_dec': nrm(ks[7], (DEPTH, 2, GLA_LOWRANK, GLA_QK), GLA_LOWRANK ** -0.5),
        'gla_b_dec': nrm(ks[8], (DEPTH, 2, GLA_QK), 0.1),
        'gla_norm_g': gain(ks[9], (DEPTH, GLA_DV)),
        'q_norm_g': gain(ks[10], (DEPTH, HEAD_DIM)),
        'k_norm_g': gain(ks[11], (DEPTH, HEAD_DIM)),
        'hy_conv_w': nrm(ks[12], (DEPTH, 3, 3 * HY_WIDTH), 3 ** -0.5),
        'hy_conv_b': nrm(ks[13], (DEPTH, 3 * HY_WIDTH), 0.02),
        'hy_w1': nrm(ks[14], (DEPTH, HY_EMB, HY_ORDER_DIM), HY_EMB ** -0.5),
        'hy_b1': nrm(ks[15], (DEPTH, HY_ORDER_DIM), 0.1),
        'hy_w2': nrm(ks[16], (DEPTH, HY_INNER, HY_ORDER_DIM, HY_ORDER_DIM), HY_ORDER_DIM ** -0.5),
        'hy_b2': nrm(ks[17], (DEPTH, HY_INNER, HY_ORDER_DIM), 0.1),
        'hy_w3': nrm(ks[18], (DEPTH, HY_ORDER_DIM, 2 * HY_WIDTH), 0.005),
        'hy_freq': gain(ks[19], (DEPTH, HY_ORDER_DIM)),
        'hy_skip': nrm(ks[20], (DEPTH, HY_WIDTH), 1.0),
        'w_out': nrm(ks[21], (DEPTH, D, D), D ** -0.5),
        'ffn_pre_g': gain(ks[22], (DEPTH, D)),
        'ffn_post_g': gain(ks[23], (DEPTH, D)),
        'router_w': nrm(ks[24], (DEPTH, D, N_EXPERTS), D ** -0.5),
        'exp_w_gate': nrm(ks[25], (DEPTH, N_EXPERTS, D, EXPERT_FF), D ** -0.5),
        'exp_w_up': nrm(ks[26], (DEPTH, N_EXPERTS, D, EXPERT_FF), D ** -0.5),
        'exp_w_down': nrm(ks[27], (DEPTH, N_EXPERTS, EXPERT_FF, D), EXPERT_FF ** -0.5),
    }


def reference(x, c, ada_w, ada_b, mix_pre_g, mix_post_g, w_in, gla_w_dec, gla_b_dec, gla_norm_g,
              q_norm_g, k_norm_g, hy_conv_w, hy_conv_b, hy_w1, hy_b1, hy_w2, hy_b2, hy_w3, hy_freq,
              hy_skip, w_out, ffn_pre_g, ffn_post_g, router_w, exp_w_gate, exp_w_up, exp_w_down):
    L = x.shape[1]
    cos, sin = axial_rope_tables(L)
    cond = jax.nn.silu(c)
    split_at = np.cumsum(SPLITS)[:-1].tolist()
    for l in range(DEPTH):
        mod = (cond @ ada_w[l] + ada_b[l])[:, None, :]
        sh_m, sc_m, g_m, sh_f, sc_f, g_f = jnp.split(mod, 6, axis=-1)
        h = rmsnorm(x, mix_pre_g[l]) * (1.0 + sc_m) + sh_m
        proj = h @ w_in[l]
        gq, gk, gv, gg, glr, aq, ak, av, hy = jnp.split(proj, split_at, axis=-1)
        o_gla = gla_group(gq, gk, gv, gg, glr, gla_w_dec[l], gla_b_dec[l], gla_norm_g[l])
        o_att = attention_group(aq, ak, av, q_norm_g[l], k_norm_g[l], cos, sin)
        o_hy = hyena_group(hy, hy_conv_w[l], hy_conv_b[l], hy_w1[l], hy_b1[l], hy_w2[l], hy_b2[l],
                           hy_w3[l], hy_freq[l], hy_skip[l])
        y = jnp.concatenate([o_gla, o_att, o_hy], axis=-1) @ w_out[l]
        x = x + g_m * rmsnorm(y, mix_post_g[l])
        h = rmsnorm(x, ffn_pre_g[l]) * (1.0 + sc_f) + sh_f
        y = expert_choice_ffn(h, router_w[l], exp_w_gate[l], exp_w_up[l], exp_w_down[l])
        x = x + g_f * rmsnorm(y, ffn_post_g[l])
    return x
```

```cpp
#include <hip/hip_runtime.h>
#include <hip/hip_bf16.h>
#include <cstdio>
#include <cstdint>
#include <cmath>
namespace pg8 {
#define PG8_LAS __attribute__((address_space(3)))
typedef unsigned short bf16_t;
typedef short bf16x8 __attribute__((ext_vector_type(8)));
typedef float f32x4 __attribute__((ext_vector_type(4)));
typedef unsigned u32x4 __attribute__((ext_vector_type(4)));
constexpr int BM = 256, BK = 64, HALF = 128, HTB = HALF * BK * 2  , STAGE_BYTES = 8 * HTB, NXCD = 8, WGM = 8;

__host__ __device__ __forceinline__ int lds_byte(int r, int c) { const int st = (r >> 4) * 2 + (c >> 5), rr = r & 15, cc = c & 31, ob = rr * 64 + cc * 2; return st * 1024 + (ob ^ (((ob >> 9) & 1) << 5)); }
__host__ __device__ __forceinline__ void stage_rc(int b, int& R, int& C) { const int st = b / 1024, sb = b % 1024, swz = sb ^ (((sb >> 9) & 1) << 5); R = (st >> 1) * 16 + swz / 64; C = (st & 1) * 32 + (swz % 64) / 2; }
__host__ __device__ __forceinline__ int perm32(int rho) { const int n = rho >> 4, i = rho & 15; return 8 * (i >> 2) + 4 * n + (i & 3); }

struct Unit { int pm, pn, pc; };
struct Gemm { const bf16_t* A; const bf16_t* Bt; int M, N, K; };

struct StaticOrder {
    int nM, nN, nwg, G, c;
    __host__ __device__ void init(int M, int N, int G_, int c_) { nM = M / BM; nN = N / BM; nwg = nM * nN; G = G_; c = c_; }
    __host__ __device__ bool next(int i, Unit& u) const {
        const long L = (long)i * G + c; if (L >= nwg) return false;
        int wgid = (int)L; { const int q = nwg / NXCD, r = nwg % NXCD, xcd = wgid % NXCD, off = wgid / NXCD; wgid = (xcd < r ? xcd * (q + 1) : r * (q + 1) + (xcd - r) * q) + off; }
        const int nig = WGM * nN, gid = wgid / nig, fm = gid * WGM, gsz = (nM - fm) < WGM ? (nM - fm) : WGM;
        u.pm = fm + ((wgid % nig) % gsz); u.pn = (wgid % nig) / gsz; u.pc = u.pn; return true;
    }
    __device__ __forceinline__ void a_ready(const Unit&) const {}
    __device__ __forceinline__ void done(const Unit&) const {}
};

__device__ __forceinline__ unsigned cvt_pk_bf16(float lo, float hi) { unsigned r; asm volatile("v_cvt_pk_bf16_f32 %0, %1, %2" : "=v"(r) : "v"(lo), "v"(hi)); return r; }
typedef float f32x2 __attribute__((ext_vector_type(2)));
__device__ __forceinline__ f32x2 gelu_pk(f32x2 v) {
    const f32x2 av = __builtin_elementwise_abs(v), d = av * 0.2316418882f + 1.0f;
    f32x2 t; t.x = __builtin_amdgcn_rcpf(d.x); t.y = __builtin_amdgcn_rcpf(d.y);
    f32x2 q = t * 0.5307027145f + (-0.7265760135f); q = q * t + 0.7107068705f; q = q * t + (-0.142248368f); q = q * t + 0.127414796f; q = q * t;
    const f32x2 s = (v * v) * (-0.72134752044f);
    f32x2 e; e.x = __builtin_amdgcn_exp2f(s.x); e.y = __builtin_amdgcn_exp2f(s.y);
    const f32x2 m = v * (q * e), r = v - m;
    f32x2 o; o.x = v.x < 0.f ? m.x : r.x; o.y = v.y < 0.f ? m.y : r.y; return o;
}

template <int ACT  > struct EpiBf16 {
    static constexpr bool PERM = true, AFTER_DRAIN = false; static_assert(ACT == 0 || ACT == 1, "EpiBf16: ACT is 0 (none) or 1 (gelu_pk)");
    bf16_t* O; int ldc; const float* bias; int split_cols; size_t split_stride; float scale0;
    __device__ __forceinline__ void operator()(const f32x4 (&acc)[2][2][4][2], const Unit& u, int wr, int wc, int fr, int fq) const {
        const int row0 = u.pm * BM + wr * 64 + fr; int colt = u.pc * BM; bf16_t* base = O;
        float sc = 1.f; if (split_cols) { const int t = colt / split_cols; base += (size_t)t * split_stride; colt -= t * split_cols; if (t == 0) sc = scale0; }
        const int col0 = colt + wc * 32 + 8 * fq, bcol0 = u.pc * BM + wc * 32 + 8 * fq;
        f32x4 bv[2][2];
#pragma unroll
        for (int bj = 0; bj < 2; ++bj)
#pragma unroll
            for (int n = 0; n < 2; ++n) bv[bj][n] = bias ? *(const f32x4*)(bias + bcol0 + bj * HALF + 4 * n) : (f32x4){0.f, 0.f, 0.f, 0.f};
#pragma unroll
        for (int ai = 0; ai < 2; ++ai)
#pragma unroll
            for (int m = 0; m < 4; ++m) { bf16_t* rowp = base + (size_t)(row0 + ai * HALF + m * 16) * ldc + col0;
#pragma unroll
                for (int bj = 0; bj < 2; ++bj) { f32x4 v0 = acc[ai][bj][m][0] + bv[bj][0], v1 = acc[ai][bj][m][1] + bv[bj][1];
                    if (ACT == 1) { f32x2 a = gelu_pk((f32x2){v0[0], v0[1]}), b = gelu_pk((f32x2){v0[2], v0[3]}), c = gelu_pk((f32x2){v1[0], v1[1]}), d = gelu_pk((f32x2){v1[2], v1[3]});
                        v0 = (f32x4){a.x, a.y, b.x, b.y}; v1 = (f32x4){c.x, c.y, d.x, d.y}; }
                    v0 = v0 * sc; v1 = v1 * sc; u32x4 w; w.x = cvt_pk_bf16(v0[0], v0[1]); w.y = cvt_pk_bf16(v0[2], v0[3]); w.z = cvt_pk_bf16(v1[0], v1[1]); w.w = cvt_pk_bf16(v1[2], v1[3]);
                    *(u32x4*)(rowp + bj * HALF) = w; } }
    }
};

struct EpiF32 {
    static constexpr bool PERM = false, AFTER_DRAIN = false;
    float* O; int ldc; const float* rowscale; float mul;
    __device__ __forceinline__ void operator()(const f32x4 (&acc)[2][2][4][2], const Unit& u, int wr, int wc, int fr, int fq) const {
        const int row0 = u.pm * BM + wr * 64 + fr, col0 = u.pc * BM + wc * 32 + 4 * fq;
#pragma unroll
        for (int ai = 0; ai < 2; ++ai)
#pragma unroll
            for (int m = 0; m < 4; ++m) { const int row = row0 + ai * HALF + m * 16; const float s = (rowscale ? rowscale[row] : 1.f) * mul; float* rowp = O + (size_t)row * ldc + col0;
#pragma unroll
                for (int bj = 0; bj < 2; ++bj)
#pragma unroll
                    for (int n = 0; n < 2; ++n) *(f32x4*)(rowp + bj * HALF + n * 16) = acc[ai][bj][m][n] * s; }
    }
};
struct EpiBf16Row {
    static constexpr bool PERM = true, AFTER_DRAIN = false;
    bf16_t* O; int ldc; const float* rowscale; float mul;
    __device__ __forceinline__ void operator()(const f32x4 (&acc)[2][2][4][2], const Unit& u, int wr, int wc, int fr, int fq) const {
        const int row0 = u.pm * BM + wr * 64 + fr, col0 = u.pc * BM + wc * 32 + 8 * fq;
#pragma unroll
        for (int ai = 0; ai < 2; ++ai)
#pragma unroll
            for (int m = 0; m < 4; ++m) { const int row = row0 + ai * HALF + m * 16; const float s = (rowscale ? rowscale[row] : 1.f) * mul; bf16_t* rowp = O + (size_t)row * ldc + col0;
#pragma unroll
                for (int bj = 0; bj < 2; ++bj) { const f32x4 v0 = acc[ai][bj][m][0] * s, v1 = acc[ai][bj][m][1] * s;
                    u32x4 w; w.x = cvt_pk_bf16(v0[0], v0[1]); w.y = cvt_pk_bf16(v0[2], v0[3]); w.z = cvt_pk_bf16(v1[0], v1[1]); w.w = cvt_pk_bf16(v1[2], v1[3]);
                    *(u32x4*)(rowp + bj * HALF) = w; } }
    }
};
__device__ __forceinline__ float silu_mul(float g, float u) { return g * u * __builtin_amdgcn_rcpf(1.0f + __builtin_amdgcn_exp2f(-1.44269504089f * g)); }
struct EpiSwiGLU {
    static constexpr bool PERM = true, AFTER_DRAIN = false;
    bf16_t* O; int ldc;
    __device__ __forceinline__ void operator()(const f32x4 (&acc)[2][2][4][2], const Unit& u, int wr, int wc, int fr, int fq) const {
        const int row0 = u.pm * BM + wr * 64 + fr, col0 = u.pc * HALF + wc * 32 + 8 * fq;
#pragma unroll
        for (int ai = 0; ai < 2; ++ai)
#pragma unroll
            for (int m = 0; m < 4; ++m) { bf16_t* rowp = O + (size_t)(row0 + ai * HALF + m * 16) * ldc + col0;
                const f32x4 g0 = acc[ai][0][m][0], g1 = acc[ai][0][m][1], u0 = acc[ai][1][m][0], u1 = acc[ai][1][m][1];
                u32x4 w; w.x = cvt_pk_bf16(silu_mul(g0[0], u0[0]), silu_mul(g0[1], u0[1])); w.y = cvt_pk_bf16(silu_mul(g0[2], u0[2]), silu_mul(g0[3], u0[3]));
                w.z = cvt_pk_bf16(silu_mul(g1[0], u1[0]), silu_mul(g1[1], u1[1])); w.w = cvt_pk_bf16(silu_mul(g1[2], u1[2]), silu_mul(g1[3], u1[3]));
                *(u32x4*)rowp = w; }
    }
};
__device__ __forceinline__ unsigned pk4_fp8(float a, float b, float c, float d) {
    a = __builtin_amdgcn_fmed3f(a, -448.f, 448.f); b = __builtin_amdgcn_fmed3f(b, -448.f, 448.f); c = __builtin_amdgcn_fmed3f(c, -448.f, 448.f); d = __builtin_amdgcn_fmed3f(d, -448.f, 448.f);
    unsigned r = 0u; r = __builtin_amdgcn_cvt_pk_fp8_f32(a, b, r, false); r = __builtin_amdgcn_cvt_pk_fp8_f32(c, d, r, true); return r; }
struct EpiSwiGLU8 {
    static constexpr bool PERM = true, AFTER_DRAIN = false;
    unsigned char* O; int ntk; float isc;
    __device__ __forceinline__ f32x2 silu_mul2(f32x2 G, f32x2 U, float ka, float ks) const {
        const f32x2 a = G * ka; f32x2 ex; ex.x = __builtin_amdgcn_exp2f(a.x); ex.y = __builtin_amdgcn_exp2f(a.y);
        const f32x2 d = ex * ks + ks; f32x2 r; r.x = __builtin_amdgcn_rcpf(d.x); r.y = __builtin_amdgcn_rcpf(d.y);
        return (G * U) * r; }
    __device__ __forceinline__ void operator()(const f32x4 (&acc)[2][2][4][2], const Unit& u, int wr, int wc, int fr, int fq) const {
        typedef unsigned u32x2 __attribute__((ext_vector_type(2)));
        const int c = wc * 32 + 8 * fq;
        unsigned char* blk = O + ((size_t)u.pm * ntk + u.pc) * 32768 + (c >> 6) * 16384 + (c & 63) + (size_t)(wr * 64 + fr) * 64;
        const float ka = -1.44269504089f * isc, ks = 1.0f / (isc * isc);
        const int odd = fq & 1;
#pragma unroll
        for (int ai = 0; ai < 2; ++ai)
#pragma unroll
            for (int mp = 0; mp < 4; mp += 2) { u32x2 w[2];
#pragma unroll
                for (int q = 0; q < 2; ++q) { const int m = mp + q;
                    const f32x4 g0 = acc[ai][0][m][0], g1 = acc[ai][0][m][1], u0 = acc[ai][1][m][0], u1 = acc[ai][1][m][1];
                    const f32x2 h0 = silu_mul2((f32x2){g0[0], g0[1]}, (f32x2){u0[0], u0[1]}, ka, ks), h1 = silu_mul2((f32x2){g0[2], g0[3]}, (f32x2){u0[2], u0[3]}, ka, ks);
                    const f32x2 h2 = silu_mul2((f32x2){g1[0], g1[1]}, (f32x2){u1[0], u1[1]}, ka, ks), h3 = silu_mul2((f32x2){g1[2], g1[3]}, (f32x2){u1[2], u1[3]}, ka, ks);
                    w[q].x = pk4_fp8(h0.x, h0.y, h1.x, h1.y); w[q].y = pk4_fp8(h2.x, h2.y, h3.x, h3.y); }
                const auto rx = __builtin_amdgcn_permlane16_swap(w[0].x, w[1].x, false, false), ry = __builtin_amdgcn_permlane16_swap(w[0].y, w[1].y, false, false);
                u32x4 o; o.x = rx[0]; o.y = ry[0]; o.z = rx[1]; o.w = ry[1];
                *(u32x4*)(blk + (ai * HALF + (mp + odd) * 16) * 64 - 8 * odd) = o; __builtin_amdgcn_sched_barrier(0); }
    }
};
struct EpiF8Row {
    static constexpr bool PERM = true, AFTER_DRAIN = false;
    unsigned char* O; int ldc; const float* rowscale; float mul;
    __device__ __forceinline__ void operator()(const f32x4 (&acc)[2][2][4][2], const Unit& u, int wr, int wc, int fr, int fq) const {
        typedef unsigned u32x2 __attribute__((ext_vector_type(2)));
        const int row0 = u.pm * BM + wr * 64 + fr, col0 = u.pc * BM + wc * 32 + 8 * fq;
#pragma unroll
        for (int ai = 0; ai < 2; ++ai)
#pragma unroll
            for (int m = 0; m < 4; ++m) { const int row = row0 + ai * HALF + m * 16; const float s = (rowscale ? rowscale[row] : 1.f) * mul; unsigned char* rowp = O + (size_t)row * ldc + col0;
#pragma unroll
                for (int bj = 0; bj < 2; ++bj) { const f32x4 v0 = acc[ai][bj][m][0] * s, v1 = acc[ai][bj][m][1] * s;
                    u32x2 w; w.x = pk4_fp8(v0[0], v0[1], v0[2], v0[3]); w.y = pk4_fp8(v1[0], v1[1], v1[2], v1[3]);
                    *(u32x2*)(rowp + bj * HALF) = w; } }
    }
};
struct MoeOrder {
    int npn, per_e, total, G, c;
    __host__ __device__ void init(int npn_, int G_, int c_) { npn = npn_; per_e = 8 * npn_; total = 16 * per_e; G = G_; c = c_; }
    __host__ __device__ bool next(int i, Unit& u) const {
        const long L = (long)i * G + c; if (L >= total) return false;
        const int e = (int)L / per_e, r = (int)L % per_e; u.pm = 8 * e + (r & 7); u.pc = r >> 3; u.pn = npn * e + u.pc; return true;
    }
    __device__ __forceinline__ void a_ready(const Unit&) const {}
    __device__ __forceinline__ void done(const Unit&) const {}
};

typedef int pg8_v4i __attribute__((ext_vector_type(4)));
typedef int pg8_v8i __attribute__((ext_vector_type(8)));
__device__ __forceinline__ pg8_v8i cat8(bf16x8 lo, bf16x8 hi) { return __builtin_shufflevector(__builtin_bit_cast(pg8_v4i, lo), __builtin_bit_cast(pg8_v4i, hi), 0, 1, 2, 3, 4, 5, 6, 7); }
__device__ __forceinline__ void mfma_f8_inplace(f32x4& acc, pg8_v8i a, pg8_v8i b) { asm volatile("v_mfma_f32_16x16x128_f8f6f4 %0, %1, %2, %0" : "+v"(acc) : "v"(a), "v"(b)); }
template <class Epi, class Sched, bool ALIGN_EPI = false, bool SP2 = false, bool F8 = false, bool BTILED = false, bool ATILED = false>
__device__ __forceinline__ void gemm_phase(PG8_LAS unsigned char* lds, const Gemm g, const Sched& S, const Epi& E) {
    int tid_ = threadIdx.x; asm volatile("" : "+v"(tid_));
    const int tid = tid_, wid = __builtin_amdgcn_readfirstlane(tid >> 6), lane = tid & 63, wr = wid >> 2, wc = wid & 3, fr = lane & 15, fq = lane >> 4;
    const int K = g.K, nt = K / BK;
    unsigned voffA[2], voffB[2];
#pragma unroll
    for (int i = 0; i < 2; ++i) { int R, C; stage_rc(tid * 16 + i * 8192, R, C); const int Rb = Epi::PERM ? ((R & ~31) + perm32(R & 31)) : R;
        voffA[i] = ATILED ? (unsigned)((C >> 5) * 16384 + R * 64 + (C & 31) * 2) : (unsigned)(R * K + C) * 2u; voffB[i] = BTILED ? (unsigned)((C >> 5) * 16384 + Rb * 64 + (C & 31) * 2) : (unsigned)(Rb * K + C) * 2u; }
    const size_t kstep = (size_t)(BK * 2);
    const size_t hstep = (size_t)HALF * K * 2;
    const size_t tstep = 2 * hstep;
    const size_t kstepB = BTILED ? (size_t)32768 : kstep, hstepB = BTILED ? (size_t)8192 : hstep;
    const size_t kstepA = ATILED ? (size_t)32768 : kstep, hstepA = ATILED ? (size_t)8192 : hstep;
    const unsigned ldsw = (unsigned)wid * 1024u;
    const int aoff = lds_byte(wr * 64 + fr, fq * 8), boff = lds_byte(wc * 32 + fr, fq * 8);
#define PG8_SA(b, h) (((b) * 2 + (h)) * HTB)
#define PG8_SB(b, h) ((4 + (b) * 2 + (h)) * HTB)
#define PG8_STAGE(bufoff, gbase, voff) do { _Pragma("unroll") for (int _i = 0; _i < 2; ++_i) \
        __builtin_amdgcn_global_load_lds((const unsigned*)((const char*)(gbase) + (voff)[_i]), (PG8_LAS unsigned*)(lds + (bufoff) + ldsw + _i * 8192), 16, 0, 0); } while (0)
#define PG8_LDA(dst, b, h) do { _Pragma("unroll") for (int m = 0; m < 4; ++m) _Pragma("unroll") for (int k = 0; k < 2; ++k) dst[m][k] = *(const PG8_LAS bf16x8*)(lds + PG8_SA(b, h) + aoff + m * 2048 + k * 1024); } while (0)
#define PG8_LDB(dst, b, h) do { _Pragma("unroll") for (int n = 0; n < 2; ++n) _Pragma("unroll") for (int k = 0; k < 2; ++k) dst[n][k] = *(const PG8_LAS bf16x8*)(lds + PG8_SB(b, h) + boff + n * 2048 + k * 1024); } while (0)
#define PG8_MMA(ai, bj, At, Bt) do { __builtin_amdgcn_s_setprio(1); _Pragma("unroll") for (int m = 0; m < 4; ++m) _Pragma("unroll") for (int n = 0; n < 2; ++n) { \
        if constexpr (F8) mfma_f8_inplace(acc[ai][bj][m][n], cat8(Bt[n][0], Bt[n][1]), cat8(At[m][0], At[m][1])); \
        else { _Pragma("unroll") for (int k = 0; k < 2; ++k) acc[ai][bj][m][n] = __builtin_amdgcn_mfma_f32_16x16x32_bf16(Bt[n][k], At[m][k], acc[ai][bj][m][n], 0, 0, 0); } } \
        __builtin_amdgcn_s_setprio(0); } while (0)
#define PG8_WAIT_V(n) asm volatile("s_waitcnt vmcnt(" #n ")" ::: "memory")
#define PG8_WAIT_L(n) asm volatile("s_waitcnt lgkmcnt(" #n ")" ::: "memory")
#define PG8_BAR __builtin_amdgcn_s_barrier()
#define PG8_SCHED __builtin_amdgcn_sched_barrier(0)
    Unit cur, nxt; int ui = 0;
    if (!S.next(0, cur)) return;
    f32x4 acc[2][2][4][2];
#pragma unroll
    for (int a = 0; a < 2; ++a)
#pragma unroll
        for (int b = 0; b < 2; ++b)
#pragma unroll
            for (int m = 0; m < 4; ++m)
#pragma unroll
                for (int n = 0; n < 2; ++n) acc[a][b][m][n] = (f32x4){0.f, 0.f, 0.f, 0.f};
    bf16x8 At[4][2], B0[2][2], B1[2][2];
    const char* cA = (const char*)g.A + (size_t)cur.pm * tstep; const char* cB = (const char*)g.Bt + (size_t)cur.pn * tstep;
    S.a_ready(cur);
    if constexpr (SP2) {
        PG8_STAGE(PG8_SB(0, 0), cB, voffB); PG8_STAGE(PG8_SB(0, 1), cB + hstepB, voffB); PG8_STAGE(PG8_SA(0, 0), cA, voffA); PG8_STAGE(PG8_SA(0, 1), cA + hstepA, voffA);
        if (wr == 1) PG8_BAR;
        PG8_WAIT_V(2); PG8_BAR;
        PG8_STAGE(PG8_SB(1, 0), cB + kstepB, voffB); PG8_STAGE(PG8_SA(1, 0), cA + kstepA, voffA); PG8_STAGE(PG8_SB(1, 1), cB + hstepB + kstepB, voffB);
        PG8_WAIT_V(6); PG8_BAR;
    } else {
        PG8_STAGE(PG8_SB(0, 0), cB, voffB); PG8_STAGE(PG8_SA(0, 0), cA, voffA); PG8_STAGE(PG8_SB(0, 1), cB + hstepB, voffB); PG8_STAGE(PG8_SA(0, 1), cA + hstepA, voffA);
        if (wr == 1) PG8_BAR;
        PG8_WAIT_V(4); PG8_BAR;
        PG8_STAGE(PG8_SB(1, 0), cB + kstepB, voffB); PG8_STAGE(PG8_SA(1, 0), cA + kstepA, voffA); PG8_STAGE(PG8_SB(1, 1), cB + hstepB + kstepB, voffB);
        PG8_WAIT_V(6); PG8_BAR;
    }
    for (;;) {
        const bool has_next = S.next(ui + 1, nxt);
        const char* nA = has_next ? (const char*)g.A + (size_t)nxt.pm * tstep : cA; const char* nB = has_next ? (const char*)g.Bt + (size_t)nxt.pn * tstep : cB;
#pragma unroll 1
        for (int t = 0; t < nt; t += 2) {
            const bool last = (t == nt - 2);
            const char* a1 = cA + (size_t)(t + 1) * kstepA;
            const char* a2 = last ? nA : cA + (size_t)(t + 2) * kstepA; const char* b2 = last ? nB : cB + (size_t)(t + 2) * kstepB;
            const char* a3 = a2 + kstepA; const char* b3 = b2 + kstepB;
            if (last && has_next) S.a_ready(nxt);
            if constexpr (SP2) {
            PG8_LDB(B0, 0, 0); PG8_LDB(B1, 0, 1); PG8_SCHED; PG8_LDA(At, 0, 0); PG8_STAGE(PG8_SA(1, 1), a1 + hstepA, voffA);
            PG8_WAIT_V(8); PG8_WAIT_L(0); PG8_BAR; PG8_MMA(0, 0, At, B0); PG8_MMA(0, 1, At, B1); PG8_BAR; PG8_SCHED;
            PG8_LDA(At, 0, 1); PG8_STAGE(PG8_SB(0, 0), b2, voffB); PG8_STAGE(PG8_SB(0, 1), b2 + hstepB, voffB); PG8_STAGE(PG8_SA(0, 0), a2, voffA);
            PG8_WAIT_V(8); PG8_WAIT_L(0); PG8_BAR; PG8_MMA(1, 0, At, B0); PG8_MMA(1, 1, At, B1); PG8_BAR; PG8_SCHED;
            PG8_LDB(B0, 1, 0); PG8_LDB(B1, 1, 1); PG8_SCHED; PG8_LDA(At, 1, 0); PG8_STAGE(PG8_SA(0, 1), a2 + hstepA, voffA);
            PG8_WAIT_V(8); PG8_WAIT_L(0); PG8_BAR; PG8_MMA(0, 0, At, B0); PG8_MMA(0, 1, At, B1); PG8_BAR; PG8_SCHED;
            PG8_LDA(At, 1, 1); PG8_STAGE(PG8_SB(1, 0), b3, voffB); PG8_STAGE(PG8_SB(1, 1), b3 + hstepB, voffB); PG8_STAGE(PG8_SA(1, 0), a3, voffA);
            PG8_WAIT_V(8); PG8_WAIT_L(0); PG8_BAR; PG8_MMA(1, 0, At, B0); PG8_MMA(1, 1, At, B1); PG8_BAR; PG8_SCHED;
            } else {
            PG8_LDB(B0, 0, 0); PG8_SCHED; PG8_LDA(At, 0, 0); PG8_STAGE(PG8_SA(1, 1), a1 + hstepA, voffA);
            PG8_WAIT_L(8); PG8_BAR; PG8_WAIT_L(0); PG8_MMA(0, 0, At, B0); PG8_BAR; PG8_SCHED;
            PG8_LDB(B1, 0, 1); PG8_STAGE(PG8_SB(0, 0), b2, voffB);
            PG8_BAR; PG8_WAIT_L(0); PG8_MMA(0, 1, At, B1); PG8_BAR;
            PG8_LDA(At, 0, 1); PG8_STAGE(PG8_SA(0, 0), a2, voffA);
            PG8_BAR; PG8_WAIT_L(0); PG8_MMA(1, 0, At, B0); PG8_BAR; PG8_SCHED;
            PG8_STAGE(PG8_SB(0, 1), b2 + hstepB, voffB);
            PG8_WAIT_V(6); PG8_BAR; PG8_MMA(1, 1, At, B1); PG8_BAR;
            PG8_LDB(B0, 1, 0); PG8_SCHED; PG8_LDA(At, 1, 0); PG8_STAGE(PG8_SA(0, 1), a2 + hstepA, voffA);
            PG8_WAIT_L(8); PG8_BAR; PG8_WAIT_L(0); PG8_MMA(0, 0, At, B0); PG8_BAR; PG8_SCHED;
            PG8_LDB(B1, 1, 1); PG8_STAGE(PG8_SB(1, 0), b3, voffB);
            PG8_BAR; PG8_WAIT_L(0); PG8_MMA(0, 1, At, B1); PG8_BAR;
            PG8_LDA(At, 1, 1); PG8_STAGE(PG8_SA(1, 0), a3, voffA);
            PG8_BAR; PG8_WAIT_L(0); PG8_MMA(1, 0, At, B0); PG8_BAR; PG8_SCHED;
            PG8_STAGE(PG8_SB(1, 1), b3 + hstepB, voffB);
            PG8_WAIT_V(6); PG8_BAR; PG8_MMA(1, 1, At, B1); PG8_BAR;
            }
        }
        if constexpr (ALIGN_EPI) { if (wr == 0) PG8_BAR; }
        if constexpr (F8) asm volatile("s_nop 15\n\ts_nop 15" ::: "memory");
        if constexpr (!Epi::AFTER_DRAIN) { E(acc, cur, wr, wc, fr, fq); S.done(cur); }
        if (!has_next) break;
#pragma unroll
        for (int a = 0; a < 2; ++a)
#pragma unroll
            for (int b = 0; b < 2; ++b)
#pragma unroll
                for (int m = 0; m < 4; ++m)
#pragma unroll
                    for (int n = 0; n < 2; ++n) acc[a][b][m][n] = (f32x4){0.f, 0.f, 0.f, 0.f};
        cur = nxt; cA = nA; cB = nB; ++ui;
        if constexpr (ALIGN_EPI) { if (wr == 1) PG8_BAR; }
    }
    PG8_WAIT_V(0);
    if constexpr (!ALIGN_EPI) { if (wr == 0) PG8_BAR; }
    PG8_BAR;
    if constexpr (Epi::AFTER_DRAIN) { E.fused(acc, cur, wr, wc, fr, fq, lds, wid, lane); S.done(cur); }
#undef PG8_SA
#undef PG8_SB
#undef PG8_STAGE
#undef PG8_LDA
#undef PG8_LDB
#undef PG8_MMA
#undef PG8_WAIT_V
#undef PG8_WAIT_L
#undef PG8_BAR
#undef PG8_SCHED
}
}
namespace attn_body {
using bf16=__hip_bfloat16;
using bf16x8=__attribute__((ext_vector_type(8)))short;
using s16x4=__attribute__((ext_vector_type(4)))short;
using f32x16=__attribute__((ext_vector_type(16)))float;
using u32x4=__attribute__((ext_vector_type(4)))unsigned;
constexpr int BATCH=4,NHEAD=8,SEQ=4096,D=64,QP=512,KVP=256,OP=1024;
constexpr int NW=8,QBLK=32,QB=QBLK*NW,KVBLK=64,NQB=SEQ/QB;
constexpr int ATTN_UNIT_ROWS=QB;
__device__ __forceinline__ int crow(int r,int hi){return (r&3)+8*(r>>2)+4*hi;}
#define SBAR() __builtin_amdgcn_sched_barrier(0)
__device__ __forceinline__ void cmask(f32x16&p0,f32x16&p1,int jb,int qrel,int hi){
  const float NEG=-INFINITY; int kb=64*jb+4*hi;
  #pragma unroll
  for(int r=0;r<16;++r){int kv=kb+(r&3)+8*(r>>2); if(kv>qrel)p0[r]=NEG; if(kv+32>qrel)p1[r]=NEG;}
}

constexpr int NSLOT=3, SLOTB=8192;
constexpr int LDS_K=0, LDS_V=NSLOT*SLOTB, LDS_WS=2*NSLOT*SLOTB, LDS_OST=LDS_WS+NW*64*4, LDS_BYTES=LDS_OST+NW*4096;
constexpr float C2=0.125f*1.4426950408889634f;
__device__ __forceinline__ void glds16(const void*gsrc,unsigned lds_dst){unsigned keep;
  asm volatile("s_mov_b32 %0, m0\n\ts_mov_b32 m0, %2\n\ts_nop 0\n\tglobal_load_lds_dwordx4 %1, off\n\ts_mov_b32 m0, %0":"=&s"(keep):"v"(gsrc),"s"(lds_dst):"memory");}
__device__ __forceinline__ float max3f(float a,float b,float c){float r;asm("v_max3_f32 %0, %1, %2, %3":"=v"(r):"v"(a),"v"(b),"v"(c));return r;}
__device__ __forceinline__ float max2f(float a,float b){float r;asm("v_max_f32_e32 %0, %1, %2":"=v"(r):"v"(a),"v"(b));return r;}
__device__ __forceinline__ float fadd_s(float a,float b){float r;asm("v_add_f32_e32 %0, %1, %2":"=v"(r):"v"(a),"v"(b));return r;}
__device__ __forceinline__ float fsub_s(float a,float b){float r;asm("v_sub_f32_e32 %0, %1, %2":"=v"(r):"v"(a),"v"(b));return r;}
typedef float f32x2_t __attribute__((ext_vector_type(2))); typedef __bf16 bf16x2_t __attribute__((ext_vector_type(2)));
__device__ __forceinline__ unsigned cvtpk_s(float lo,float hi){f32x2_t v={lo,hi};bf16x2_t b=__builtin_convertvector(v,bf16x2_t);return __builtin_bit_cast(unsigned,b);}
#define WAIT_BAR(N) asm volatile("s_waitcnt vmcnt(" #N ") lgkmcnt(0)\n\ts_barrier":::"memory")

__device__ __forceinline__ void qkt(f32x16&p0,f32x16&p1,const char*Kslot,const bf16x8*qr,const f32x16&negm,int r32,int hi){
  const char*kb=Kslot+hi*1024+r32*16;
  #pragma unroll
  for(int d0=0;d0<4;++d0){
    const bf16x8 b0=*reinterpret_cast<const bf16x8*>(kb+d0*2048);
    const bf16x8 b1=*reinterpret_cast<const bf16x8*>(kb+d0*2048+512);
    if(d0==0){p0=__builtin_amdgcn_mfma_f32_32x32x16_bf16(b0,qr[0],negm,0,0,0);p1=__builtin_amdgcn_mfma_f32_32x32x16_bf16(b1,qr[0],negm,0,0,0);}
    else{p0=__builtin_amdgcn_mfma_f32_32x32x16_bf16(b0,qr[d0],p0,0,0,0);p1=__builtin_amdgcn_mfma_f32_32x32x16_bf16(b1,qr[d0],p1,0,0,0);}}
}
typedef __attribute__((address_space(3))) const char* lds_cptr;
typedef short v4i16_t __attribute__((ext_vector_type(4)));
__device__ __forceinline__ void kload8(bf16x8*kf,lds_cptr kp){
  kf[0]=*(const __attribute__((address_space(3))) bf16x8*)(kp);      kf[1]=*(const __attribute__((address_space(3))) bf16x8*)(kp+512);
  kf[2]=*(const __attribute__((address_space(3))) bf16x8*)(kp+2048); kf[3]=*(const __attribute__((address_space(3))) bf16x8*)(kp+2560);
  kf[4]=*(const __attribute__((address_space(3))) bf16x8*)(kp+4096); kf[5]=*(const __attribute__((address_space(3))) bf16x8*)(kp+4608);
  kf[6]=*(const __attribute__((address_space(3))) bf16x8*)(kp+6144); kf[7]=*(const __attribute__((address_space(3))) bf16x8*)(kp+6656);
}
__device__ __forceinline__ void kload2(bf16x8*kf,lds_cptr kp,int j){ kf[2*j]=*(const __attribute__((address_space(3))) bf16x8*)(kp+j*2048); kf[2*j+1]=*(const __attribute__((address_space(3))) bf16x8*)(kp+j*2048+512); }
__device__ __forceinline__ s16x4 vtr(lds_cptr p){ return __builtin_bit_cast(s16x4,__builtin_amdgcn_ds_read_tr16_b64_v4i16((__attribute__((address_space(3))) v4i16_t*)p)); }
__device__ __forceinline__ float rowmax(const f32x16&p0,const f32x16&p1){
  float a=max3f(p0[0],p0[1],p1[0]),b=max3f(p0[2],p0[3],p1[1]);a=max3f(a,p1[2],p1[3]);
  #pragma unroll
  for(int r=4;r<16;r+=4){a=max3f(a,p0[r],p0[r+1]);b=max3f(b,p0[r+2],p0[r+3]);a=max3f(a,p1[r],p1[r+1]);b=max3f(b,p1[r+2],p1[r+3]);}
  const float m=max2f(a,b);
  auto rr=__builtin_amdgcn_permlane32_swap(__float_as_uint(m),__float_as_uint(m),false,false);
  return max2f(__uint_as_float(rr[0]),__uint_as_float(rr[1]));
}
__device__ __forceinline__ void pv(f32x16*o,int vb,bf16x8 pa0,bf16x8 pa1,bf16x8 pa2,bf16x8 pa3){
  #pragma unroll
  for(int d0=0;d0<2;++d0){s16x4 lo[4],hi[4];
    #pragma unroll
    for(int ks=0;ks<4;++ks){
      asm volatile("ds_read_b64_tr_b16 %0,%1 offset:%c2":"=&v"(lo[ks]):"v"(vb),"i"(d0*4096+ks*1024):"memory");
      asm volatile("ds_read_b64_tr_b16 %0,%1 offset:%c2":"=&v"(hi[ks]):"v"(vb),"i"(d0*4096+ks*1024+512):"memory");}
    asm volatile("s_waitcnt lgkmcnt(0)":::"memory");SBAR();
    #define PK(k) (bf16x8){lo[k][0],lo[k][1],lo[k][2],lo[k][3],hi[k][0],hi[k][1],hi[k][2],hi[k][3]}
    o[d0]=__builtin_amdgcn_mfma_f32_32x32x16_bf16(pa0,PK(0),o[d0],0,0,0);
    o[d0]=__builtin_amdgcn_mfma_f32_32x32x16_bf16(pa1,PK(1),o[d0],0,0,0);
    o[d0]=__builtin_amdgcn_mfma_f32_32x32x16_bf16(pa2,PK(2),o[d0],0,0,0);
    o[d0]=__builtin_amdgcn_mfma_f32_32x32x16_bf16(pa3,PK(3),o[d0],0,0,0);
    #undef PK
  }
}

#ifndef ATTN_STORE16
#define ATTN_STORE16(p,v) (*(u32x4*)(p)=(v))
#endif
  template<int THRL,bool NOMAX=false> __device__ __forceinline__ void attn_unit(int b,int h,int qb,const bf16*Q,const bf16*__restrict__ K,const bf16*__restrict__ V,bf16*O,char*shm,float mfix=0.f){
  int tid_=threadIdx.x; asm volatile("":"+v"(tid_)); const int tid=tid_,lane=tid&63,r32=lane&31,hi=lane>>5; const int wid=__builtin_amdgcn_readfirstlane(tid>>6);
  const long rowbase=(long)b*SEQ; const int q0=qb*QB;
  const bf16*Qw=Q+(rowbase+q0+wid*QBLK)*QP+h*D;
  const bf16*Kh=K+rowbase*KVP+(h>>2)*D,*Vh=V+rowbase*KVP+(h>>2)*D;
  const unsigned lds0=(unsigned)(uintptr_t)shm;
  float*wsf=(float*)(shm+LDS_WS)+wid*64;
  const bf16*ksrc=Kh+(long)lane*KVP+wid*8;
  const bf16*vsrc=Vh+(long)(16*(wid&3)+(lane>>2))*KVP+(wid>>2)*32+(lane&3)*8;
  const unsigned kdst=lds0+LDS_K+wid*1024, vdst=lds0+LDS_V+wid*1024;
  #define DMA_K(t,slot) glds16(ksrc+(long)(t)*KVBLK*KVP,(unsigned)__builtin_amdgcn_readfirstlane(kdst+(slot)))
  #define DMA_V(t,slot) glds16(vsrc+(long)(t)*KVBLK*KVP,(unsigned)__builtin_amdgcn_readfirstlane(vdst+(slot)))
  const int vb0=(int)(lds0+LDS_V)+((lane>>4)&1)*32+(lane&3)*8+(4*hi+((lane&15)>>2))*64;
  const char*Kbase=shm+LDS_K; bf16x8 kf[8];
  const lds_cptr shm3=(lds_cptr)shm; const lds_cptr kp0=shm3+LDS_K+hi*1024+r32*16; const lds_cptr vp0=shm3+LDS_V+((lane>>4)&1)*32+(lane&3)*8+(4*hi+((lane&15)>>2))*64;
  const int NT=SEQ/KVBLK;
  DMA_K(0,0);DMA_V(0,0);DMA_K(1,SLOTB);
  bf16x8 qr[4];
  #pragma unroll
  for(int d0=0;d0<4;++d0)qr[d0]=*reinterpret_cast<const bf16x8*>(&Qw[(long)r32*QP+d0*16+hi*8]);
  float mhat=0.f,l_reg=0.f;f32x16 o[2];o[0]=f32x16{};o[1]=f32x16{};f32x16 negm=f32x16{};asm volatile("":"+v"(negm));
  const int qrel=wid*QBLK+r32;
  #define CMASK(P0,P1,t) do{}while(0)
  bool resc=false;
  #define START(P0,P1) do{ float rm; if constexpr(NOMAX) rm=mfix; else rm=rowmax(P0,P1); resc=false; \
    { const float dl=rm; mhat=fadd_s(mhat,dl); \
      _Pragma("unroll") for(int r=0;r<16;++r){P0[r]=fsub_s(P0[r],dl);P1[r]=fsub_s(P1[r],dl);} \
      _Pragma("unroll") for(int r=0;r<16;++r)negm[r]=-mhat; asm volatile("":"+v"(negm)); } \
    _Pragma("unroll") for(int r=0;r<16;++r)P0[r]=__builtin_amdgcn_exp2f(P0[r]); }while(0)
  #define RESC() do{ if(resc){ asm volatile("s_waitcnt lgkmcnt(0)":::"memory"); \
      _Pragma("unroll") for(int d_=0;d_<2;++d_) _Pragma("unroll") for(int r=0;r<16;++r)o[d_][r]*=wsf[crow(r,hi)]; } }while(0)
  f32x16 pA0,pA1,pB0,pB1;
  int sl_prev=0,sl_cur=0,sl_next=SLOTB;
  #define ROT() do{sl_prev=sl_cur;sl_cur=sl_next;sl_next=(sl_next==(NSLOT-1)*SLOTB)?0:sl_next+SLOTB;}while(0)
  DMA_K(2,2*SLOTB);
  WAIT_BAR(3);
  qkt(pA0,pA1,Kbase,qr,negm,r32,hi);asm volatile("s_nop 15\n\ts_nop 7":"+v"(pA0),"+v"(pA1));CMASK(pA0,pA1,0);
  START(pA0,pA1);
  _Pragma("unroll") for(int r=0;r<16;++r)pA1[r]=__builtin_amdgcn_exp2f(pA1[r]);
  WAIT_BAR(0);
  DMA_K(3,0);DMA_V(1,SLOTB);
  ROT();
  kload8(kf,kp0+sl_cur);
  WAIT_BAR(2);
  s16x4 vlo[8],vhi[8]; u32x4 pw0,pw1,pw2,pw3;
  #define PKW(P,B) cvtpk_s(P[B],P[B+1])
  #define PAF(k) __builtin_bit_cast(bf16x8,pw##k)
  #define VFR(i) (bf16x8){vlo[i][0],vlo[i][1],vlo[i][2],vlo[i][3],vhi[i][0],vhi[i][1],vhi[i][2],vhi[i][3]}
  #define PIN(x) asm volatile("":"+v"(x))
  #define MX3(a,b,c) __builtin_fmaxf(__builtin_fmaxf((a),(b)),(c))
  #define GAPA(MF,A0,A1,A2,A3,W0,W1,PW) do{ MF; sacc+=A0; sacc+=A1; sacc+=A2; sacc+=A3; PIN(sacc); W0; W1; PIN(PW); SBAR(); }while(0)
  #define EX(v) __builtin_amdgcn_exp2f(v)
  #define GAPB(MF,X,B) do{ MF; X[B]=EX(X[B]); X[B+1]=EX(X[B+1]); X[B+2]=EX(X[B+2]); X[B+3]=EX(X[B+3]); PIN(X); SBAR(); }while(0)
  #define VRD(i) do{ vlo[i]=vtr(vp_+(((i)>>2)*4096+((i)&3)*1024)); vhi[i]=vtr(vp_+(((i)>>2)*4096+((i)&3)*1024+512)); }while(0)
  #define KRD(G,j) do{ if(G){ kload2(kf,kp0+sl_next,j); SBAR(); } }while(0)
  #define STEP(C0,C1,P0,P1,t,GK,GV,GL) do{ SBAR(); \
    const lds_cptr vp_=vp0+sl_prev; \
    VRD(0); SBAR(); float sacc=(P0[0]+P0[1]); \
    GAPA(C0=__builtin_amdgcn_mfma_f32_32x32x16_bf16(kf[0],qr[0],negm,0,0,0), P0[2],P0[3],P0[4],P0[5],     pw0[0]=PKW(P0,0), pw0[1]=PKW(P0,2), pw0); \
    VRD(4); SBAR(); GAPA(C1=__builtin_amdgcn_mfma_f32_32x32x16_bf16(kf[1],qr[0],negm,0,0,0), P0[6],P0[7],P0[8],P0[9],     pw0[2]=PKW(P0,4), pw0[3]=PKW(P0,6), pw0); \
    VRD(1); SBAR(); GAPA(C0=__builtin_amdgcn_mfma_f32_32x32x16_bf16(kf[2],qr[1],C0,0,0,0),   P0[10],P0[11],P0[12],P0[13], pw1[0]=PKW(P0,8), pw1[1]=PKW(P0,10), pw1); \
    VRD(5); SBAR(); GAPA(C1=__builtin_amdgcn_mfma_f32_32x32x16_bf16(kf[3],qr[1],C1,0,0,0),   P0[14],P0[15],P1[0],P1[1],   pw1[2]=PKW(P0,12),pw1[3]=PKW(P0,14), pw1); \
    VRD(2); SBAR(); GAPA(C0=__builtin_amdgcn_mfma_f32_32x32x16_bf16(kf[4],qr[2],C0,0,0,0),   P1[2],P1[3],P1[4],P1[5],     pw2[0]=PKW(P1,0), pw2[1]=PKW(P1,2), pw2); \
    VRD(6); SBAR(); GAPA(C1=__builtin_amdgcn_mfma_f32_32x32x16_bf16(kf[5],qr[2],C1,0,0,0),   P1[6],P1[7],P1[8],P1[9],     pw2[2]=PKW(P1,4), pw2[3]=PKW(P1,6), pw2); \
    VRD(3); SBAR(); GAPA(C0=__builtin_amdgcn_mfma_f32_32x32x16_bf16(kf[6],qr[3],C0,0,0,0),   P1[10],P1[11],P1[12],P1[13], pw3[0]=PKW(P1,8), pw3[1]=PKW(P1,10), pw3); \
    VRD(7); SBAR(); GAPA(C1=__builtin_amdgcn_mfma_f32_32x32x16_bf16(kf[7],qr[3],C1,0,0,0),   P1[14],P1[15],0.f,0.f,       pw3[2]=PKW(P1,12),pw3[3]=PKW(P1,14), pw3); \
    l_reg+=sacc; \
    if(GK){DMA_K((t)+3,sl_cur);} if(GV){DMA_V((t)+1,sl_next);} \
    CMASK(C0,C1,t); \
    if constexpr(!NOMAX){ float a=MX3(C0[0],C0[1],C1[0]),b=MX3(C0[2],C0[3],C1[1]); a=MX3(a,C1[2],C1[3]); \
      _Pragma("unroll") for(int r=4;r<16;r+=4){a=MX3(a,C0[r],C0[r+1]);b=MX3(b,C0[r+2],C0[r+3]);a=MX3(a,C1[r],C1[r+1]);b=MX3(b,C1[r+2],C1[r+3]);} \
      float rm=__builtin_fmaxf(a,b); { auto rr=__builtin_amdgcn_permlane32_swap(__float_as_uint(rm),__float_as_uint(rm),false,false); rm=__builtin_fmaxf(__uint_as_float(rr[0]),__uint_as_float(rr[1])); } \
      resc=false; \
      if(__builtin_expect(__any(rm>(float)THRL),0)){ const float dl=__builtin_fmaxf(rm,0.f); mhat+=dl; \
        _Pragma("unroll") for(int r=0;r<16;++r){C0[r]-=dl;C1[r]-=dl;} \
        _Pragma("unroll") for(int r=0;r<16;++r)negm[r]=-mhat; asm volatile("":"+v"(negm)); \
        const float f=__builtin_amdgcn_exp2f(-dl); l_reg*=f; if(hi==0)wsf[r32]=f; resc=true; } } \
    SBAR(); \
    GAPB(o[0]=__builtin_amdgcn_mfma_f32_32x32x16_bf16(PAF(0),VFR(0),o[0],0,0,0), C0,0); \
    GAPB(o[1]=__builtin_amdgcn_mfma_f32_32x32x16_bf16(PAF(0),VFR(4),o[1],0,0,0), C0,4); \
    KRD(GL,0); GAPB(o[0]=__builtin_amdgcn_mfma_f32_32x32x16_bf16(PAF(1),VFR(1),o[0],0,0,0), C0,8); \
    KRD(GL,1); GAPB(o[1]=__builtin_amdgcn_mfma_f32_32x32x16_bf16(PAF(1),VFR(5),o[1],0,0,0), C0,12); \
    KRD(GL,2); GAPB(o[0]=__builtin_amdgcn_mfma_f32_32x32x16_bf16(PAF(2),VFR(2),o[0],0,0,0), C1,0); \
    KRD(GL,3); GAPB(o[1]=__builtin_amdgcn_mfma_f32_32x32x16_bf16(PAF(2),VFR(6),o[1],0,0,0), C1,4); \
    GAPB(o[0]=__builtin_amdgcn_mfma_f32_32x32x16_bf16(PAF(3),VFR(3),o[0],0,0,0), C1,8); \
    GAPB(o[1]=__builtin_amdgcn_mfma_f32_32x32x16_bf16(PAF(3),VFR(7),o[1],0,0,0), C1,12); \
    }while(0)
  int t=1;
  #undef CMASK
  #define CMASK(P0,P1,t) do{}while(0)
  for(;t+5<NT;t+=2){
    STEP(pB0,pB1,pA0,pA1,t,true,true,true);     WAIT_BAR(2); RESC(); ROT();
    STEP(pA0,pA1,pB0,pB1,t+1,true,true,true);   WAIT_BAR(2); RESC(); ROT();
  }
  #undef CMASK
  #define CMASK(P0,P1,t) do{}while(0)
  #define ENDW(tt) do{ if((tt)+3<NT){WAIT_BAR(2);} else if((tt)+2<NT){WAIT_BAR(1);} else {WAIT_BAR(0);} }while(0)
  for(;t+1<NT;t+=2){
    STEP(pB0,pB1,pA0,pA1,t,(t+3<NT),(t+1<NT),(t+1<NT));       ENDW(t);   RESC(); ROT();
    STEP(pA0,pA1,pB0,pB1,t+1,(t+4<NT),(t+2<NT),(t+2<NT));     ENDW(t+1); RESC(); ROT();
  }
  STEP(pB0,pB1,pA0,pA1,NT-1,false,false,false); RESC();
  { float sacc=pB0[0]+pB0[1]; _Pragma("unroll") for(int r=2;r<16;++r)sacc+=pB0[r]; _Pragma("unroll") for(int r=0;r<16;++r)sacc+=pB1[r]; l_reg+=sacc;
    pw0=(u32x4){PKW(pB0,0),PKW(pB0,2),PKW(pB0,4),PKW(pB0,6)};pw1=(u32x4){PKW(pB0,8),PKW(pB0,10),PKW(pB0,12),PKW(pB0,14)};pw2=(u32x4){PKW(pB1,0),PKW(pB1,2),PKW(pB1,4),PKW(pB1,6)};pw3=(u32x4){PKW(pB1,8),PKW(pB1,10),PKW(pB1,12),PKW(pB1,14)};
    SBAR(); pv(o,vb0+sl_cur,PAF(0),PAF(1),PAF(2),PAF(3)); }
  #undef PKW
  #undef PAF
  #undef VFR
  #undef PIN
  #undef MX3
  #undef GAPA
  #undef GAPB
  #undef EX
  #undef VRD
  #undef KRD
  #undef STEP
  #undef ENDW
  {auto rr=__builtin_amdgcn_permlane32_swap(__float_as_uint(l_reg),__float_as_uint(l_reg),false,false);l_reg=__uint_as_float(rr[0])+__uint_as_float(rr[1]);}
  if(hi==0)wsf[32+r32]=l_reg;asm volatile("s_waitcnt lgkmcnt(0)":::"memory");
  float rli[16];
  #pragma unroll
  for(int r=0;r<16;++r)rli[r]=__builtin_amdgcn_rcpf(wsf[32+crow(r,hi)]);
  bf16*Ow=O+(rowbase+q0+wid*QBLK)*OP+h*D;
  { bf16*stg=(bf16*)(shm+LDS_OST)+wid*2048;
    #pragma unroll
    for(int r=0;r<16;++r){const int orow=crow(r,hi);
      #pragma unroll
      for(int d0=0;d0<2;++d0)stg[orow*64+d0*32+r32]=__float2bfloat16(o[d0][r]*rli[r]);}
    asm volatile("s_waitcnt lgkmcnt(0)":::"memory");
    #pragma unroll
    for(int i=0;i<4;++i){const int row=i*8+(lane>>3),ch=lane&7; const u32x4 v=*(const u32x4*)(stg+row*64+ch*8); ATTN_STORE16(Ow+(long)row*OP+ch*8,v);} }
  asm volatile("s_waitcnt lgkmcnt(0)\n\ts_barrier":::"memory");
  #undef DMA_K
  #undef DMA_V
  #undef CMASK
  #undef START
  #undef RESC
  #undef ROT
}
#undef SBAR
#undef WAIT_BAR
}
constexpr int NWAVES = 8, NTHR = 512;
constexpr int BATCH = 4, SEQ = 4096, DM = 1024, M = BATCH * SEQ, DEPTH = 2;
constexpr int NPROJ = 2560, NIN = 2336;
constexpr int PC_GQ = 0, PC_GK = 128, PC_GV = 256, PC_GG = 512, PC_LAF = 768, PC_LAB = 896, PC_AQ = 1024, PC_AK = 1536, PC_AV = 1664, PC_HX0 = 1792, PC_HX1 = 2048, PC_HV = 2304;
constexpr int NEXP = 16, CAP = 512, FF = 2816, EROWS = BATCH * CAP;
constexpr int NCHUNK = SEQ / 32;
constexpr float EPS = 1e-6f;
constexpr float YE8_SCALE = 16.0f;
constexpr float W8_SCALE = 64.0f;
constexpr float ATT_C2 = 0.125f * 1.4426950408889634f;

constexpr size_t MiB = 1u << 20;
constexpr size_t WS_CTL = 0, CTL_ZERO_BYTES = 32768;
constexpr size_t WS_MOD = 1 * MiB, WS_AFF = 2 * MiB, WS_SLOT = 3 * MiB, WS_GATE = 4 * MiB, WS_ALAST = 5 * MiB, WS_HF = 6 * MiB;
constexpr size_t WS_WIN = 22 * MiB, WS_WOUT = 32 * MiB, WS_HN = 36 * MiB, WS_PROJ = 68 * MiB, WS_QP = 148 * MiB, WS_KV = 164 * MiB, WS_CAT = 172 * MiB;
constexpr size_t WS_GKV = 204 * MiB, WS_ZT = 236 * MiB, WS_YC = 244 * MiB, WS_Y = 260 * MiB, WS_XG = 324 * MiB, WS_H = 388 * MiB, WS_YE = 564 * MiB;
constexpr size_t WS_WGU = 692 * MiB, WS_WD = 1044 * MiB, WS_END = 1220 * MiB;
constexpr size_t WS_XR = 628 * MiB;
constexpr int CW_BAR = 4096;

constexpr int RING_BYTES = 131072, LDSCTL_OFF = RING_BYTES, MISC_OFF = LDSCTL_OFF + 320, LDS_BYTES = 147456;

#define GAS __attribute__((address_space(1)))
#define LAS __attribute__((address_space(3)))
typedef unsigned short bf16;
typedef unsigned v4u __attribute__((ext_vector_type(4)));
typedef unsigned v2u __attribute__((ext_vector_type(2)));
typedef float f32x4 __attribute__((ext_vector_type(4)));
#define LDS_WAIT() asm volatile("s_waitcnt lgkmcnt(0)" ::: "memory")
#define VM_WAIT() asm volatile("s_waitcnt vmcnt(0)" ::: "memory")
typedef float m_f32x2 __attribute__((ext_vector_type(2))); typedef __bf16 m_bf16x2 __attribute__((ext_vector_type(2)));
__device__ __forceinline__ unsigned pk2(float lo, float hi) { const m_f32x2 v = {lo, hi}; return __builtin_bit_cast(unsigned, __builtin_convertvector(v, m_bf16x2)); }
__device__ __forceinline__ unsigned f2bf(float f) { return pk2(f, f); }
__device__ __forceinline__ float bf2f(bf16 u) { return __uint_as_float((unsigned)u << 16); }
__device__ __forceinline__ float lane_get(float v, int src) { return __uint_as_float((unsigned)__builtin_amdgcn_ds_bpermute(src << 2, (int)__float_as_uint(v))); }
__device__ __forceinline__ unsigned lane_getu(unsigned v, int src) { return (unsigned)__builtin_amdgcn_ds_bpermute(src << 2, (int)v); }
template <int CTRL> __device__ __forceinline__ float dpp_f(float v) { return __uint_as_float((unsigned)__builtin_amdgcn_update_dpp(0, (int)__float_as_uint(v), CTRL, 0xF, 0xF, true)); }
constexpr int DPP_X1 = 0xB1, DPP_X2 = 0x4E, DPP_HMIR = 0x141, DPP_MIR = 0x140, DPP_ROR8 = 0x128;
__device__ __forceinline__ float swap16_sum(float a, float b) { const auto r = __builtin_amdgcn_permlane16_swap(__float_as_uint(a), __float_as_uint(b), false, false); return __uint_as_float(r[0]) + __uint_as_float(r[1]); }
__device__ __forceinline__ float swap32_sum(float a, float b) { const auto r = __builtin_amdgcn_permlane32_swap(__float_as_uint(a), __float_as_uint(b), false, false); return __uint_as_float(r[0]) + __uint_as_float(r[1]); }
__device__ __forceinline__ float swap16_max(float a) { const auto r = __builtin_amdgcn_permlane16_swap(__float_as_uint(a), __float_as_uint(a), false, false); return fmaxf(__uint_as_float(r[0]), __uint_as_float(r[1])); }
__device__ __forceinline__ float swap32_max(float a) { const auto r = __builtin_amdgcn_permlane32_swap(__float_as_uint(a), __float_as_uint(a), false, false); return fmaxf(__uint_as_float(r[0]), __uint_as_float(r[1])); }
__device__ __forceinline__ float row16_sum(float v) { v += dpp_f<DPP_X1>(v); v += dpp_f<DPP_X2>(v); v += dpp_f<DPP_HMIR>(v); v += dpp_f<DPP_MIR>(v); return v; }
__device__ __forceinline__ float half_sum(float v) { v = row16_sum(v); return swap16_sum(v, v); }
__device__ __forceinline__ float wave_sum(float v, int) { v = half_sum(v); return swap32_sum(v, v); }
__device__ __forceinline__ float siluf(float x) { return x / (1.0f + __expf(-x)); }
__device__ __forceinline__ float logsigf(float x) { return fminf(x, 0.f) - __logf(1.0f + __expf(-fabsf(x))); }
__device__ __forceinline__ float rsq(float x) { return __builtin_amdgcn_rsqf(x); }
#define XB_TMO      128
#define XB_XCNT(j)  (256  + 64 * (j))
#define XB_XSUB(j)  (1280 + 64 * (j))
#define XB_XGEN(j)  (2304 + 64 * (j))
#define XB_TOP      3328
#define XB_TOPGEN   3392
#define XCD_BAR_WORDS 3456
#define XB_SPIN_CAP (1u << 18)

__device__ __forceinline__ unsigned xb_ld(unsigned* p)              { return __hip_atomic_load(p, __ATOMIC_RELAXED, __HIP_MEMORY_SCOPE_AGENT); }
__device__ __forceinline__ unsigned xb_add(unsigned* p, unsigned v) { return __hip_atomic_fetch_add(p, v, __ATOMIC_RELAXED, __HIP_MEMORY_SCOPE_AGENT); }
__device__ __forceinline__ unsigned xb_xcc_id() { return (unsigned)__builtin_amdgcn_s_getreg((3 << 11) | 20) & 0xFu; }
#define XB_SPIN(cond, bar) do { unsigned _sp = 0; while (cond) { __builtin_amdgcn_s_sleep(1); \
    if ((++_sp & 255u) == 0u) { if (xb_ld(&(bar)[XB_TMO])) break; if (_sp > XB_SPIN_CAP) { atomicAdd(&(bar)[XB_TMO], 1u); break; } } } } while (0)

struct XcdBarrier {
    unsigned* bar; unsigned x;
    volatile LAS unsigned* st;
};

__device__ __forceinline__ XcdBarrier xcd_barrier_post(unsigned* bar, volatile LAS unsigned* st) {
    XcdBarrier b; b.bar = bar; b.x = xb_xcc_id(); b.st = st;
    if (threadIdx.x == 0) (void)xb_add(&bar[XB_XCNT(b.x)], 1u);
    return b;
}
__device__ __forceinline__ void xcd_barrier_complete(unsigned* bar, unsigned x, unsigned& nloc, unsigned& nx) {
    const unsigned G = gridDim.x * gridDim.y * gridDim.z;
    unsigned sum, cnt, mine, sp = 0u;
    for (;;) {
        sum = 0u; cnt = 0u; mine = 0u;
#pragma unroll
        for (unsigned j = 0; j < 16; ++j) { const unsigned c = xb_ld(&bar[XB_XCNT(j)]); sum += c; cnt += (c > 0u) ? 1u : 0u; mine = (j == x) ? c : mine; }
        if (sum == G) break;
        __builtin_amdgcn_s_sleep(1);
        if ((++sp & 255u) == 0u) { if (xb_ld(&bar[XB_TMO])) break; if (sp > XB_SPIN_CAP) { atomicAdd(&bar[XB_TMO], 1u); break; } }
    }
    nloc = mine > 0u ? mine : 1u; nx = cnt > 0u ? cnt : 1u;
}

__device__ __forceinline__ void xcd_barrier(const XcdBarrier& b) {
    asm volatile("s_waitcnt vmcnt(0)" ::: "memory");
    __syncthreads();
    if (threadIdx.x == 0) {
        unsigned* bar = b.bar;
        __builtin_amdgcn_s_waitcnt(0);
        unsigned nloc = b.st[0], nx = b.st[1];
        if (nloc == 0u) { xcd_barrier_complete(bar, b.x, nloc, nx); b.st[0] = nloc; b.st[1] = nx; }
        const unsigned old = xb_add(&bar[XB_XSUB(b.x)], 1u);
        const unsigned gen = old / nloc;
        if (old + 1u == (gen + 1u) * nloc) {
            __builtin_amdgcn_fence(__ATOMIC_RELEASE, "agent");
            asm volatile("s_waitcnt vmcnt(0)" ::: "memory");
            const unsigned og = xb_add(&bar[XB_TOP], 1u);
            const unsigned tg = og / nx;
            if (og + 1u == (tg + 1u) * nx) xb_add(&bar[XB_TOPGEN], 1u);
            else XB_SPIN(xb_ld(&bar[XB_TOPGEN]) == tg, bar);
            __builtin_amdgcn_fence(__ATOMIC_ACQUIRE, "agent");
            xb_add(&bar[XB_XGEN(b.x)], 1u);
            asm volatile("s_waitcnt vmcnt(0)" ::: "memory");
        } else {
            XB_SPIN(xb_ld(&bar[XB_XGEN(b.x)]) == gen, bar);
            __builtin_amdgcn_fence(__ATOMIC_ACQUIRE, "agent");
            asm volatile("s_waitcnt vmcnt(0)" ::: "memory");
        }
    }
    __syncthreads();
}

struct Frame {
    LAS unsigned char* lds;
    GAS unsigned* ctl;
    int tid, lane, wave, vcu, G;
    GAS float* out; GAS unsigned char* ws;
};
__device__ __forceinline__ const GAS float* INP(const Frame& F, int i) {
    const LAS unsigned* p = (const LAS unsigned*)(F.lds + LDSCTL_OFF) + 2 * i;
    const unsigned lo = __builtin_amdgcn_readfirstlane(p[0]), hi = __builtin_amdgcn_readfirstlane(p[1]);
    return (const GAS float*)(((unsigned long long)hi << 32) | lo);
}
enum { I_X = 0, I_C, I_ADAW, I_ADAB, I_MPRE, I_MPOST, I_WIN, I_GWDEC, I_GBDEC, I_GNORM, I_QNORM, I_KNORM, I_HCW, I_HCB, I_HW1, I_HB1, I_HW2, I_HB2, I_HW3, I_HFREQ, I_HSKIP,
       I_WOUT, I_FPRE, I_FPOST, I_ROUTER, I_EG, I_EU, I_ED };

__device__ __forceinline__ void transpose_item(const GAS float* src, size_t src_ld, GAS bf16* dst, size_t dst_ld, int lane) {
    const GAS float* s = src + lane; float v[32];
#pragma unroll
    for (int i = 0; i < 32; ++i) v[i] = __builtin_nontemporal_load(s + (size_t)i * src_ld);
    GAS v4u* d = (GAS v4u*)(dst + (size_t)lane * dst_ld);
#pragma unroll
    for (int q = 0; q < 4; ++q) { v4u o; o.x = pk2(v[8 * q], v[8 * q + 1]); o.y = pk2(v[8 * q + 2], v[8 * q + 3]); o.z = pk2(v[8 * q + 4], v[8 * q + 5]); o.w = pk2(v[8 * q + 6], v[8 * q + 7]); d[q] = o; }
}
__device__ __forceinline__ unsigned pk4_f8(float a, float b, float c, float d) {
    a = fminf(fmaxf(a, -448.f), 448.f); b = fminf(fmaxf(b, -448.f), 448.f); c = fminf(fmaxf(c, -448.f), 448.f); d = fminf(fmaxf(d, -448.f), 448.f);
    unsigned r = 0u; r = __builtin_amdgcn_cvt_pk_fp8_f32(a, b, r, false); r = __builtin_amdgcn_cvt_pk_fp8_f32(c, d, r, true); return r; }
struct F8Tile { const GAS float* src; size_t ld; GAS unsigned char* dst; };
__device__ __forceinline__ F8Tile f8_tile(Frame& F, int tile) {
    const int le = tile / 528; int r = tile % 528; const int which = r / 176; r %= 176; const int nn = F.tid >> 1, hh = F.tid & 1; F8Tile t;
    if (which < 2) { const int kb = r & 15, nb = r >> 4, n = 256 * nb + nn, pn = n >> 7, row = (n & 127) + which * 128;
        t.src = INP(F, which == 0 ? I_EG : I_EU) + (size_t)le * DM * FF + (size_t)(64 * kb + 8 * F.wave) * FF + 256 * nb + 4 * F.lane; t.ld = FF;
        t.dst = (GAS unsigned char*)(F.ws + WS_WGU) + (size_t)le * 5632 * DM + (size_t)(((pn * 8 + (kb >> 1)) * 2 + (kb & 1)) * 16384 + row * 64 + 32 * hh); }
    else { const int kb = r % 44, nb = r / 44;
        t.src = INP(F, I_ED) + (size_t)le * FF * DM + (size_t)(64 * kb + 8 * F.wave) * DM + 256 * nb + 4 * F.lane; t.ld = DM;
        t.dst = (GAS unsigned char*)(F.ws + WS_WD) + (size_t)le * DM * FF + (size_t)(((nb * 22 + (kb >> 1)) * 2 + (kb & 1)) * 16384 + nn * 64 + 32 * hh); }
    return t;
}
__device__ __forceinline__ void f8_tile_load(const F8Tile& t, f32x4 (&v)[8]) {
#pragma unroll
    for (int i = 0; i < 8; ++i) { const GAS float* a = t.src + (size_t)i * t.ld; asm volatile("global_load_dwordx4 %0, %1, off nt" : "=v"(v[i]) : "v"(a) : "memory"); }
}
__device__ __forceinline__ void f8_tile_wait(f32x4 (&v)[8]) {
    asm volatile("s_waitcnt vmcnt(16)" : "+v"(v[0]), "+v"(v[1]), "+v"(v[2]), "+v"(v[3]), "+v"(v[4]), "+v"(v[5]), "+v"(v[6]), "+v"(v[7]) :: "memory");
}
__device__ __forceinline__ void f8_tile_finish(Frame& F, const F8Tile& t, f32x4 (&v)[8], LAS unsigned char* img) {
    f8_tile_wait(v);
#pragma unroll
    for (int j = 0; j < 4; ++j) { v2u o; o.x = pk4_f8(v[0][j] * W8_SCALE, v[1][j] * W8_SCALE, v[2][j] * W8_SCALE, v[3][j] * W8_SCALE); o.y = pk4_f8(v[4][j] * W8_SCALE, v[5][j] * W8_SCALE, v[6][j] * W8_SCALE, v[7][j] * W8_SCALE);
        *(LAS v2u*)(img + (4 * F.lane + j) * 80 + 8 * F.wave) = o; }
    asm volatile("s_waitcnt lgkmcnt(0)" ::: "memory"); __builtin_amdgcn_s_barrier(); asm volatile("" ::: "memory");
    const LAS unsigned char* rp = img + (F.tid >> 1) * 80 + 32 * (F.tid & 1);
    const v4u a = *(const LAS v4u*)rp, b = *(const LAS v4u*)(rp + 16);
    *(GAS v4u*)t.dst = a; *(GAS v4u*)(t.dst + 16) = b;
}
__device__ __forceinline__ void f8_convert_range(Frame& F, int first, int stride, int count) {
    if (count <= 0) return;
    LAS unsigned char* img0 = F.lds; LAS unsigned char* img1 = F.lds + 256 * 80; LAS unsigned char* img2 = F.lds + 2 * 256 * 80;
#define F8_TIDX(i) (first + stride * (((i) < count) ? (i) : count - 1))
    F8Tile ta = f8_tile(F, F8_TIDX(0)), tb = f8_tile(F, F8_TIDX(1)), tc; f32x4 va[8], vb[8], vc[8];
    f8_tile_load(ta, va); f8_tile_load(tb, vb);
#pragma unroll 1
    for (int i = 0; i < count; i += 3) {
        tc = f8_tile(F, F8_TIDX(i + 2)); f8_tile_load(tc, vc);
        f8_tile_finish(F, ta, va, img0);
        ta = f8_tile(F, F8_TIDX(i + 3)); f8_tile_load(ta, va);
        f8_tile_finish(F, tb, vb, img1);
        tb = f8_tile(F, F8_TIDX(i + 4)); f8_tile_load(tb, vb);
        f8_tile_finish(F, tc, vc, img2);
    }
#undef F8_TIDX
    __syncthreads();
}
constexpr int F8_NTILES = 32 * 528;
struct F8WItem { const GAS float* src; int ld; GAS unsigned char* dst; };
__device__ __forceinline__ F8WItem f8w_item(Frame& F, int q) {
    const int tile = q >> 2, quarter = q & 3, le = tile / 528; int r = tile % 528; const int which = r / 176; r %= 176;
    const int n4 = F.lane & 15, kq = F.lane >> 4; F8WItem it;
    if (which < 2) { const int kb = r & 15, nb = (r >> 4) * 4 + quarter, n = 64 * nb + 4 * n4, pn = n >> 7, row = (n & 127) + which * 128;
        it.src = INP(F, which == 0 ? I_EG : I_EU) + (size_t)le * DM * FF + (size_t)(64 * kb + 16 * kq) * FF + n; it.ld = FF;
        it.dst = (GAS unsigned char*)(F.ws + WS_WGU) + (size_t)le * 5632 * DM + (size_t)(((pn * 8 + (kb >> 1)) * 2 + (kb & 1)) * 16384 + row * 64 + 16 * kq); }
    else { const int kb = r % 44, nb = (r / 44) * 4 + quarter, n = 64 * nb + 4 * n4, pn = n >> 8, row = n & 255;
        it.src = INP(F, I_ED) + (size_t)le * FF * DM + (size_t)(64 * kb + 16 * kq) * DM + n; it.ld = DM;
        it.dst = (GAS unsigned char*)(F.ws + WS_WD) + (size_t)le * DM * FF + (size_t)(((pn * 22 + (kb >> 1)) * 2 + (kb & 1)) * 16384 + row * 64 + 16 * kq); }
    return it;
}
#ifndef MK_N_LAUNCHES
#define MK_N_LAUNCHES 1
#endif
constexpr int F8W_HOSTED = 4, F8W_IDLE = 5, F8W_BARQ = (MK_N_LAUNCHES == 1) ? 11 : 0, F8W_BARQ0 = (MK_N_LAUNCHES == 1) ? 15 : 0, F8W_BARW = 256 * 7, F8W_HOST0 = 2 * F8_NTILES;
__device__ __forceinline__ void f8w_load(const F8WItem& it, f32x4 (&v)[16]) {
#pragma unroll
    for (int i = 0; i < 16; ++i) { const GAS float* a = it.src + (size_t)i * it.ld; asm volatile("global_load_dwordx4 %0, %1, off nt" : "=v"(v[i]) : "v"(a) : "memory"); }
}
__device__ __forceinline__ void f8w_finish(const F8WItem& it, f32x4 (&v)[16]) {
    asm volatile("s_waitcnt vmcnt(0)" : "+v"(v[0]), "+v"(v[1]), "+v"(v[2]), "+v"(v[3]), "+v"(v[4]), "+v"(v[5]), "+v"(v[6]), "+v"(v[7]),
                 "+v"(v[8]), "+v"(v[9]), "+v"(v[10]), "+v"(v[11]), "+v"(v[12]), "+v"(v[13]), "+v"(v[14]), "+v"(v[15]) :: "memory");
#pragma unroll
    for (int j = 0; j < 4; ++j) { v4u o;
        o.x = pk4_f8(v[0][j] * W8_SCALE, v[1][j] * W8_SCALE, v[2][j] * W8_SCALE, v[3][j] * W8_SCALE); o.y = pk4_f8(v[4][j] * W8_SCALE, v[5][j] * W8_SCALE, v[6][j] * W8_SCALE, v[7][j] * W8_SCALE);
        o.z = pk4_f8(v[8][j] * W8_SCALE, v[9][j] * W8_SCALE, v[10][j] * W8_SCALE, v[11][j] * W8_SCALE); o.w = pk4_f8(v[12][j] * W8_SCALE, v[13][j] * W8_SCALE, v[14][j] * W8_SCALE, v[15][j] * W8_SCALE);
        *(GAS v4u*)(it.dst + j * 64) = o; }
}
__device__ __forceinline__ void f8w_convert_all(Frame& F) {
    const int gw = F.vcu * NWAVES + F.wave, NGW = F.G * NWAVES;
    const int h0 = (F.G == 256) ? F8W_HOST0 : 4 * F8_NTILES, h1 = h0 + F8W_HOSTED * NGW + F8W_IDLE * 1024 + F8W_BARQ * F8W_BARW;
    const int g0 = (F.G == 256) ? F8W_HOST0 - F8W_BARQ0 * F8W_BARW : 4 * F8_NTILES;
    for (int q = gw; q < 4 * F8_NTILES; q += NGW) { if (q >= g0 && q < h1) continue; const F8WItem it = f8w_item(F, q); f32x4 v[16];
#pragma unroll
        for (int i = 0; i < 16; ++i) v[i] = __builtin_nontemporal_load((const GAS f32x4*)(it.src + (size_t)i * it.ld));
#pragma unroll
        for (int j = 0; j < 4; ++j) { v4u o;
            o.x = pk4_f8(v[0][j] * W8_SCALE, v[1][j] * W8_SCALE, v[2][j] * W8_SCALE, v[3][j] * W8_SCALE); o.y = pk4_f8(v[4][j] * W8_SCALE, v[5][j] * W8_SCALE, v[6][j] * W8_SCALE, v[7][j] * W8_SCALE);
            o.z = pk4_f8(v[8][j] * W8_SCALE, v[9][j] * W8_SCALE, v[10][j] * W8_SCALE, v[11][j] * W8_SCALE); o.w = pk4_f8(v[12][j] * W8_SCALE, v[13][j] * W8_SCALE, v[14][j] * W8_SCALE, v[15][j] * W8_SCALE);
            *(GAS v4u*)(it.dst + j * 64) = o; } }
}

__device__ __forceinline__ void f8w_convert_one(Frame& F, int q) {
    const F8WItem it = f8w_item(F, q); f32x4 v[16];
#pragma unroll
    for (int k = 0; k < 16; ++k) v[k] = __builtin_nontemporal_load((const GAS f32x4*)(it.src + (size_t)k * it.ld));
#pragma unroll
    for (int j = 0; j < 4; ++j) { v4u o;
        o.x = pk4_f8(v[0][j] * W8_SCALE, v[1][j] * W8_SCALE, v[2][j] * W8_SCALE, v[3][j] * W8_SCALE); o.y = pk4_f8(v[4][j] * W8_SCALE, v[5][j] * W8_SCALE, v[6][j] * W8_SCALE, v[7][j] * W8_SCALE);
        o.z = pk4_f8(v[8][j] * W8_SCALE, v[9][j] * W8_SCALE, v[10][j] * W8_SCALE, v[11][j] * W8_SCALE); o.w = pk4_f8(v[12][j] * W8_SCALE, v[13][j] * W8_SCALE, v[14][j] * W8_SCALE, v[15][j] * W8_SCALE);
        *(GAS v4u*)(it.dst + j * 64) = o; }
}
__device__ __forceinline__ void f8w_convert_idle(Frame& F) {
    const int iw = ((int)blockIdx.x - 128) * NWAVES + F.wave;
    for (int i = 0; i < F8W_IDLE; ++i) { const F8WItem it = f8w_item(F, F8W_HOST0 + F8W_HOSTED * 2048 + iw + 1024 * i); f32x4 v[16];
#pragma unroll
        for (int k = 0; k < 16; ++k) v[k] = __builtin_nontemporal_load((const GAS f32x4*)(it.src + (size_t)k * it.ld));
#pragma unroll
        for (int j = 0; j < 4; ++j) { v4u o;
            o.x = pk4_f8(v[0][j] * W8_SCALE, v[1][j] * W8_SCALE, v[2][j] * W8_SCALE, v[3][j] * W8_SCALE); o.y = pk4_f8(v[4][j] * W8_SCALE, v[5][j] * W8_SCALE, v[6][j] * W8_SCALE, v[7][j] * W8_SCALE);
            o.z = pk4_f8(v[8][j] * W8_SCALE, v[9][j] * W8_SCALE, v[10][j] * W8_SCALE, v[11][j] * W8_SCALE); o.w = pk4_f8(v[12][j] * W8_SCALE, v[13][j] * W8_SCALE, v[14][j] * W8_SCALE, v[15][j] * W8_SCALE);
            *(GAS v4u*)(it.dst + j * 64) = o; } }
}
__device__ __forceinline__ void mod_item(Frame& F, int it) {
    const int l = it / 96, cg = it % 96, tid = F.tid;
    LAS float* cond = (LAS float*)F.lds; LAS float* part = (LAS float*)(F.lds + 16384);
    const GAS float* c = INP(F, I_C);
    for (int i = tid; i < BATCH * DM; i += NTHR) cond[i] = siluf(c[i]);
    __syncthreads();
    const int cl = tid & 15, kq = tid >> 4;
    const GAS float* W = INP(F, I_ADAW) + (size_t)l * DM * 6144 + cg * 64 + cl * 4;
    f32x4 acc[4];
#pragma unroll
    for (int b = 0; b < 4; ++b) acc[b] = (f32x4){0.f, 0.f, 0.f, 0.f};
#pragma unroll 4
    for (int kk = 0; kk < 32; ++kk) { const int k = kq * 32 + kk; const f32x4 w = *(const GAS f32x4*)(W + (size_t)k * 6144);
#pragma unroll
        for (int b = 0; b < 4; ++b) acc[b] += w * cond[b * DM + k]; }
#pragma unroll
    for (int b = 0; b < 4; ++b) *(LAS f32x4*)(part + (kq * 4 + b) * 64 + cl * 4) = acc[b];
    __syncthreads();
    if (tid < 256) { const int b = tid >> 6, col = tid & 63; float s = 0.f;
        for (int q = 0; q < 32; ++q) s += part[(q * 4 + b) * 64 + col];
        GAS float* mod = (GAS float*)(F.ws + WS_MOD);
        mod[(size_t)(l * 4 + b) * 6144 + cg * 64 + col] = s + INP(F, I_ADAB)[l * 6144 + cg * 64 + col]; }
    __syncthreads();
}
constexpr float HY_MIN_DECAY = -3.0701134573253943f, HY_MAX_DECAY = -15.350567286626972f;
__device__ __forceinline__ void filter_item(Frame& F, int it) {
    const int l = it >> 7, pg = it & 127, p0 = pg * 32, tid = F.tid, lane = F.lane, w = F.wave;
    LAS float* L = (LAS float*)F.lds;
    LAS float* W1 = L;
    LAS float* B1 = W1 + 33 * 64;
    LAS float* W2 = B1 + 64;
    LAS float* B2 = W2 + 2 * 64 * 64;
    LAS float* FR = B2 + 128;
    LAS float* EMB = FR + 64;
    LAS float* HB = EMB + 8 * 64;
    LAS float* H3 = HB + 8 * 64;
    for (int i = tid; i < 33 * 64; i += NTHR) W1[i] = INP(F, I_HW1)[l * 33 * 64 + i];
    for (int i = tid; i < 2 * 64 * 64; i += NTHR) W2[i] = INP(F, I_HW2)[l * 2 * 64 * 64 + i];
    if (tid < 64) { B1[tid] = INP(F, I_HB1)[l * 64 + tid]; FR[tid] = INP(F, I_HFREQ)[l * 64 + tid]; }
    if (tid < 128) B2[tid] = INP(F, I_HB2)[l * 128 + tid];
    __syncthreads();
    const float fr = FR[lane];
    for (int pj = 0; pj < 4; ++pj) {
        const int pl = w * 4 + pj, p = p0 + pl;
        if (lane < 16) { const float f = 1e-4f + (float)lane * ((15.0f - 1e-4f) / 15.0f); const float ang = (6.283185307179586f * (float)p / (float)SEQ) * f;
            EMB[w * 64 + 1 + lane] = cosf(ang); EMB[w * 64 + 17 + lane] = -sinf(ang); }
        if (lane == 0) EMB[w * 64] = (float)p / (float)(SEQ - 1);
        LDS_WAIT(); asm volatile("" ::: "memory");
        float a = B1[lane];
        for (int k = 0; k < 33; ++k) a += EMB[w * 64 + k] * W1[k * 64 + lane];
        float h = sinf(fr * a);
#pragma unroll
        for (int i = 0; i < 2; ++i) {
            LDS_WAIT(); asm volatile("" ::: "memory");
            HB[w * 64 + lane] = h;
            LDS_WAIT(); asm volatile("" ::: "memory");
            float a2 = B2[i * 64 + lane];
            for (int k = 0; k < 64; ++k) a2 += HB[w * 64 + k] * W2[(i * 64 + k) * 64 + lane];
            h = sinf(fr * a2);
        }
        H3[pl * 64 + lane] = h;
        LDS_WAIT(); asm volatile("" ::: "memory");
    }
    __syncthreads();
    {
        const int oc = tid, c = oc & 255; const GAS float* w3 = INP(F, I_HW3) + (size_t)l * 64 * 512 + oc;
        float wc[64];
#pragma unroll
        for (int k = 0; k < 64; ++k) wc[k] = w3[k * 512];
        const float delta = fabsf(HY_MIN_DECAY + (float)c * ((HY_MAX_DECAY - HY_MIN_DECAY) / 255.0f));
        GAS float* hf = (GAS float*)(F.ws + WS_HF) + ((size_t)l * 256 + c) * 8192;
        for (int pl = 0; pl < 32; ++pl) { const int p = p0 + pl; float a = 0.f;
#pragma unroll
            for (int k4 = 0; k4 < 16; ++k4) { const f32x4 hv = *(LAS f32x4*)(H3 + pl * 64 + 4 * k4); a += hv[0] * wc[4 * k4] + hv[1] * wc[4 * k4 + 1] + hv[2] * wc[4 * k4 + 2] + hv[3] * wc[4 * k4 + 3]; }
            const float t = (float)p / (float)(SEQ - 1); a *= __expf(-t * delta);
            if (oc < 256) hf[4096 + p]= a; else if (p > 0) hf[4096 - p] = a; }
        if (pg == 0 && oc < 256) hf[0] = 0.f;
    }
    __syncthreads();
}
__device__ __forceinline__ void row_load(const GAS float* row, int lane, f32x4 (&v)[4]) {
#pragma unroll
    for (int j = 0; j < 4; ++j) v[j] = ((const GAS f32x4*)row)[lane + 64 * j];
}
__device__ __forceinline__ void row_load_bf16(const GAS bf16* row, int lane, f32x4 (&v)[4]) {
#pragma unroll
    for (int j = 0; j < 4; ++j) { const v2u w = ((const GAS v2u*)row)[lane + 64 * j]; v[j] = (f32x4){__uint_as_float(w.x << 16), __uint_as_float(w.x & 0xffff0000u), __uint_as_float(w.y << 16), __uint_as_float(w.y & 0xffff0000u)}; }
}
__device__ __forceinline__ void row_load_f8(const GAS unsigned char* row, int lane, float scale, f32x4 (&v)[4]) {
    typedef float f32x2_ __attribute__((ext_vector_type(2)));
#pragma unroll
    for (int j = 0; j < 4; ++j) { const unsigned w = ((const GAS unsigned*)row)[lane + 64 * j]; const f32x2_ lo = __builtin_amdgcn_cvt_pk_f32_fp8(w, false), hi = __builtin_amdgcn_cvt_pk_f32_fp8(w, true);
        v[j] = (f32x4){lo.x * scale, lo.y * scale, hi.x * scale, hi.y * scale}; }
}
__device__ __forceinline__ float row_ss(const f32x4 (&v)[4], int lane) { float s = 0.f;
#pragma unroll
    for (int j = 0; j < 4; ++j) s += (v[j][0] * v[j][0] + v[j][1] * v[j][1]) + (v[j][2] * v[j][2] + v[j][3] * v[j][3]);
    return wave_sum(s, lane); }
__device__ __forceinline__ void row_modnorm(f32x4 (&v)[4], int lane, const GAS float* g, const GAS float* sc, const GAS float* sh, GAS bf16* orow) {
    const float rstd = rsq(row_ss(v, lane) * (1.0f / DM) + EPS);
#pragma unroll
    for (int j = 0; j < 4; ++j) { const int c4 = lane + 64 * j; const f32x4 gg = ((const GAS f32x4*)g)[c4], s1 = ((const GAS f32x4*)sc)[c4], s0 = ((const GAS f32x4*)sh)[c4];
        v[j] = v[j] * rstd * gg * (1.0f + s1) + s0;
        v2u o; o.x = pk2(v[j][0], v[j][1]); o.y = pk2(v[j][2], v[j][3]); ((GAS v2u*)orow)[c4] = o; }
}

__device__ __forceinline__ void row_modnorm_f8(f32x4 (&v)[4], int lane, const GAS float* g, const GAS float* sc, const GAS float* sh, GAS unsigned char* orow) {
    const float rstd = rsq(row_ss(v, lane) * (1.0f / DM) + EPS);
#pragma unroll
    for (int j = 0; j < 4; ++j) { const int c4 = lane + 64 * j; const f32x4 gg = ((const GAS f32x4*)g)[c4], s1 = ((const GAS f32x4*)sc)[c4], s0 = ((const GAS f32x4*)sh)[c4];
        v[j] = v[j] * rstd * gg * (1.0f + s1) + s0;
        ((GAS unsigned*)orow)[c4] = pk4_f8(v[j][0], v[j][1], v[j][2], v[j][3]); }
}
__device__ __forceinline__ void row_store_bf16(GAS bf16* row, int lane, const f32x4 (&v)[4]) {
#pragma unroll
    for (int j = 0; j < 4; ++j) { v2u o; o.x = pk2(v[j][0], v[j][1]); o.y = pk2(v[j][2], v[j][3]); ((GAS v2u*)row)[lane + 64 * j] = o; }
}
__device__ __forceinline__ void bf8_to_f32(const v4u& w, f32x4& lo, f32x4& hi) {
    lo = (f32x4){__uint_as_float(w.x << 16), __uint_as_float(w.x & 0xffff0000u), __uint_as_float(w.y << 16), __uint_as_float(w.y & 0xffff0000u)};
    hi = (f32x4){__uint_as_float(w.z << 16), __uint_as_float(w.z & 0xffff0000u), __uint_as_float(w.w << 16), __uint_as_float(w.w & 0xffff0000u)}; }
__device__ __forceinline__ void roww_load_bf16(const GAS bf16* row, int lane, f32x4 (&v)[4]) {
    const v4u a = ((const GAS v4u*)row)[2 * lane], b = ((const GAS v4u*)row)[2 * lane + 1]; bf8_to_f32(a, v[0], v[1]); bf8_to_f32(b, v[2], v[3]); }
__device__ __forceinline__ void roww_load(const GAS float* row, int lane, f32x4 (&v)[4]) {
#pragma unroll
    for (int j = 0; j < 4; ++j) v[j] = ((const GAS f32x4*)row)[4 * lane + j]; }
__device__ __forceinline__ void roww_store_bf16(GAS bf16* row, int lane, const f32x4 (&v)[4]) {
    v4u a, b; a.x = pk2(v[0][0], v[0][1]); a.y = pk2(v[0][2], v[0][3]); a.z = pk2(v[1][0], v[1][1]); a.w = pk2(v[1][2], v[1][3]);
    b.x = pk2(v[2][0], v[2][1]); b.y = pk2(v[2][2], v[2][3]); b.z = pk2(v[3][0], v[3][1]); b.w = pk2(v[3][2], v[3][3]);
    ((GAS v4u*)row)[2 * lane] = a; ((GAS v4u*)row)[2 * lane + 1] = b; }
__device__ __forceinline__ void prologue0(Frame& F) {
    for (int it = blockIdx.x; it < 192; it += F.G) mod_item(F, it);
}
__device__ __forceinline__ void prologue2(Frame& F);
__device__ __forceinline__ void prologue1(Frame& F) {
    for (int it = blockIdx.x; it < 256; it += F.G) filter_item(F, it);
    prologue2(F);
    {   GAS bf16* WIN = (GAS bf16*)(F.ws + WS_WIN);
        for (int it = blockIdx.x * NTHR + F.tid; it < DEPTH * 256 * DM; it += F.G * NTHR) {
            const int k = it & 1023, n = (it >> 10) & 255, l = it >> 18, dir = n >> 7, j = n & 127;
            const GAS float* wi = INP(F, I_WIN) + ((size_t)l * DM + k) * NIN + 768 + 16 * dir; const GAS float* wd = INP(F, I_GWDEC) + ((size_t)(l * 2 + dir) * 16) * 128 + j;
            float s = 0.f;
#pragma unroll
            for (int r = 0; r < 16; ++r) s += wi[r] * wd[r * 128];
            WIN[((size_t)l * NPROJ + 768 + n) * DM + k] = (bf16)f2bf(s); } }
    const int gw = F.vcu * NWAVES + F.wave, NGW = F.G * NWAVES;
    constexpr int N_WIN = 2 * 1152, N_WOUT = 2 * 512;
    for (int it0 = gw; it0 < N_WIN + N_WOUT; it0 += NGW) {
        int it = it0;
        if (it < N_WIN) { const int l = it / 1152; int r = it % 1152; int kb, srccol, dstrow;
            if (r < 384) { kb = r / 12; const int nb = r % 12; srccol = 64 * nb; dstrow = 64 * nb; } else { r -= 384; kb = r / 24; const int nb = r % 24; srccol = 800 + 64 * nb; dstrow = 1024 + 64 * nb; }
            transpose_item(INP(F, I_WIN) + ((size_t)l * DM + 32 * kb) * NIN + srccol, NIN, (GAS bf16*)(F.ws + WS_WIN) + ((size_t)l * NPROJ + dstrow) * DM + 32 * kb, DM, F.lane); continue; }
        it -= N_WIN;
        {   const int l = it / 512, r = it % 512, kb = r / 16, nb = r % 16;
            transpose_item(INP(F, I_WOUT) + ((size_t)l * DM + 32 * kb) * DM + 64 * nb, DM, (GAS bf16*)(F.ws + WS_WOUT) + ((size_t)l * DM + 64 * nb) * DM + 32 * kb, DM, F.lane); }
    }
    __syncthreads();
    f8w_convert_all(F);
}
__device__ __forceinline__ void prologue2(Frame& F) {
    const int gw = F.vcu * NWAVES + F.wave, NGW = F.G * NWAVES, lane = F.lane; const GAS float* mod = (const GAS float*)(F.ws + WS_MOD);
    LAS float* PV = (LAS float*)F.lds;
    for (int i = F.tid; i < 4 * 256; i += NTHR) { const int b = i >> 8, c4 = i & 255; const GAS float* mb = mod + (size_t)b * 6144;
        const f32x4 gg = ((const GAS f32x4*)INP(F, I_MPRE))[c4], s1 = ((const GAS f32x4*)(mb + 1024))[c4], s0 = ((const GAS f32x4*)mb)[c4];
        LAS f32x4* pv = (LAS f32x4*)(PV + b * 2048) + c4; pv[0] = gg * (1.0f + s1); pv[256] = s0; }
    __syncthreads();
    for (int m = gw; m < M; m += NGW) { const int b = m >> 12; f32x4 v[4]; row_load(INP(F, I_X) + (size_t)m * DM, lane, v);
        const LAS f32x4* Bv = (const LAS f32x4*)(PV + b * 2048); const float rstd = rsq(row_ss(v, lane) * (1.0f / DM) + EPS); GAS v2u* orow = (GAS v2u*)((GAS bf16*)(F.ws + WS_HN) + (size_t)m * DM);
#pragma unroll
        for (int j = 0; j < 4; ++j) { const int c4 = lane + 64 * j; const f32x4 o4 = v[j] * rstd * Bv[c4] + Bv[256 + c4]; v2u o; o.x = pk2(o4[0], o4[1]); o.y = pk2(o4[2], o4[3]); orow[c4] = o; } }
    __syncthreads();
}

__device__ __forceinline__ void gla_cumsums(const GAS bf16* proj_chunk  , int h, const GAS float* bdec  , int lane, float (&pf)[16], float (&sb)[16], float& totf, float& totb) {
    const int dk = lane & 31, half = lane >> 5;
    const float bf_ = bdec[h * 32 + dk], bb_ = bdec[128 + h * 32 + dk];
    const GAS bf16* pr = proj_chunk + (size_t)(16 * half) * NPROJ + h * 32 + dk;
    float accf = 0.f;
#pragma unroll
    for (int ii = 0; ii < 16; ++ii) { accf += logsigf(bf2f(pr[(size_t)ii * NPROJ + PC_LAF]) + bf_) * (1.0f / 16.0f); pf[ii] = accf; }
    float accb = 0.f;
#pragma unroll
    for (int ii = 15; ii >= 0; --ii) { accb += logsigf(bf2f(pr[(size_t)ii * NPROJ + PC_LAB]) + bb_) * (1.0f / 16.0f); sb[ii] = accb; }
    const float of = lane_get(accf, lane ^ 32), ob = lane_get(accb, lane ^ 32);
    totf = accf + of; totb = accb + ob;
    if (half == 1) {
#pragma unroll
        for (int ii = 0; ii < 16; ++ii) pf[ii] += of; }
    else {
#pragma unroll
        for (int ii = 0; ii < 16; ++ii) sb[ii] += ob; }
}
typedef short g_bf16x8 __attribute__((ext_vector_type(8)));
typedef float g_f32x16 __attribute__((ext_vector_type(16)));
__device__ __forceinline__ g_bf16x8 g_frag(unsigned a, unsigned b, unsigned c, unsigned d) { v4u w; w.x = a; w.y = b; w.z = c; w.w = d; return __builtin_bit_cast(g_bf16x8, w); }
__device__ __forceinline__ g_bf16x8 g_col8(const GAS bf16* p, size_t st) {
    unsigned e[8];
#pragma unroll
    for (int j = 0; j < 8; ++j) e[j] = p[(size_t)j * st];
    return g_frag(e[0] | (e[1] << 16), e[2] | (e[3] << 16), e[4] | (e[5] << 16), e[6] | (e[7] << 16));
}
__device__ __forceinline__ void gla_chunk_kv(Frame& F, int l, int item) {
    int lane = F.lane; asm volatile("" : "+v"(lane));
    const int n = item & 127, h = (item >> 7) & 3, b = item >> 9, dk = lane & 31, half = lane >> 5;
    const GAS bf16* proj = (const GAS bf16*)(F.ws + WS_PROJ) + (size_t)(b * SEQ + 32 * n) * NPROJ;
    g_bf16x8 vb[2][2];
#pragma unroll
    for (int s = 0; s < 2; ++s)
#pragma unroll
        for (int blk = 0; blk < 2; ++blk) vb[s][blk] = g_col8(proj + (size_t)(16 * half + 8 * s) * NPROJ + PC_GV + h * 64 + blk * 32 + dk, NPROJ);
    float pf[16], sb[16], totf, totb;
    gla_cumsums(proj, h, INP(F, I_GBDEC) + l * 256, lane, pf, sb, totf, totb);
    unsigned wf[8], wb[8];
#pragma unroll
    for (int ip = 0; ip < 8; ++ip) {
        const float k0 = bf2f(proj[(size_t)(16 * half + 2 * ip) * NPROJ + PC_GK + h * 32 + dk]), k1 = bf2f(proj[(size_t)(16 * half + 2 * ip + 1) * NPROJ + PC_GK + h * 32 + dk]);
        wf[ip] = pk2(k0 * __expf(totf - pf[2 * ip]), k1 * __expf(totf - pf[2 * ip + 1])); wb[ip] = pk2(k0 * __expf(totb - sb[2 * ip]), k1 * __expf(totb - sb[2 * ip + 1])); }
    GAS float* alast = (GAS float*)(F.ws + WS_ALAST);
    if (half == 0) { alast[(size_t)(((b * 4 + h) * 2 + 0) * NCHUNK + n) * 32 + dk] = __expf(totf); alast[(size_t)(((b * 4 + h) * 2 + 1) * NCHUNK + n) * 32 + dk] = __expf(totb); }
    g_f32x16 accf[2], accb[2];
#pragma unroll
    for (int blk = 0; blk < 2; ++blk)
#pragma unroll
        for (int r = 0; r < 16; ++r) { accf[blk][r] = 0.f; accb[blk][r] = 0.f; }
#pragma unroll
    for (int s = 0; s < 2; ++s) { const g_bf16x8 af = g_frag(wf[4 * s], wf[4 * s + 1], wf[4 * s + 2], wf[4 * s + 3]), ab = g_frag(wb[4 * s], wb[4 * s + 1], wb[4 * s + 2], wb[4 * s + 3]);
#pragma unroll
        for (int blk = 0; blk < 2; ++blk) { accf[blk] = __builtin_amdgcn_mfma_f32_32x32x16_bf16(af, vb[s][blk], accf[blk], 0, 0, 0); accb[blk] = __builtin_amdgcn_mfma_f32_32x32x16_bf16(ab, vb[s][blk], accb[blk], 0, 0, 0); } }
    GAS bf16* gkv = (GAS bf16*)(F.ws + WS_GKV);
    GAS bf16* of_ = gkv + (size_t)(((b * 4 + h) * 2 + 0) * NCHUNK + n) * 2048 + dk * 8 + 4 * half; GAS bf16* ob_ = gkv + (size_t)(((b * 4 + h) * 2 + 1) * NCHUNK + n) * 2048 + dk * 8 + 4 * half;
#pragma unroll
    for (int blk = 0; blk < 2; ++blk)
#pragma unroll
        for (int g = 0; g < 4; ++g) { const int f = ((((g >> 1) * 2 + blk) * 2 + (g & 1)) * 32) * 8;
            v2u wf_, wb_; wf_.x = pk2(accf[blk][4 * g], accf[blk][4 * g + 1]); wf_.y = pk2(accf[blk][4 * g + 2], accf[blk][4 * g + 3]); wb_.x = pk2(accb[blk][4 * g], accb[blk][4 * g + 1]); wb_.y = pk2(accb[blk][4 * g + 2], accb[blk][4 * g + 3]);
            *(GAS v2u*)(of_ + f) = wf_; *(GAS v2u*)(ob_ + f) = wb_; }
}
__device__ __forceinline__ void qk_prep_rows4(Frame& F, int l, int m0, int mstep, const LAS float* tab) {
    const int lane = F.lane;
    const LAS float* gt = tab + 2048;
    const GAS bf16* proj = (const GAS bf16*)(F.ws + WS_PROJ);
    v2u xa[5], xb[5];
#pragma unroll
    for (int i = 0; i < 5; ++i) { const int T = lane + 64 * i, q = (T * 205) >> 14, r = T - 80 * q, head = r >> 3, hf = (r >> 2) & 1, jj = r & 3, d1 = hf * 32 + 4 * jj;
        const GAS bf16* pr = proj + (size_t)(m0 + q * mstep) * NPROJ + ((head < 8) ? (PC_AQ + head * 64) : (PC_AK + (head - 8) * 64)) + d1;
        xa[i] = *(const GAS v2u*)pr; xb[i] = *(const GAS v2u*)(pr + 16); }
    const int mv = m0 + (lane >> 4) * mstep;
    const v4u vv = *(const GAS v4u*)(proj + (size_t)mv * NPROJ + PC_AV + 8 * (lane & 15));
#pragma unroll
    for (int i = 0; i < 5; ++i) { const int T = lane + 64 * i, q = (T * 205) >> 14, r = T - 80 * q, head = r >> 3, hf = (r >> 2) & 1, jj = r & 3, d1 = hf * 32 + 4 * jj;
        const int m = m0 + q * mstep, t = m & (SEQ - 1), pos = hf ? (t & 63) : (t >> 6);
        const float x1[4] = {__uint_as_float(xa[i].x << 16), __uint_as_float(xa[i].x & 0xffff0000u), __uint_as_float(xa[i].y << 16), __uint_as_float(xa[i].y & 0xffff0000u)};
        const float x2[4] = {__uint_as_float(xb[i].x << 16), __uint_as_float(xb[i].x & 0xffff0000u), __uint_as_float(xb[i].y << 16), __uint_as_float(xb[i].y & 0xffff0000u)};
        float ss = (x1[0] * x1[0] + x1[1] * x1[1]) + (x1[2] * x1[2] + x1[3] * x1[3]) + (x2[0] * x2[0] + x2[1] * x2[1]) + (x2[2] * x2[2] + x2[3] * x2[3]);
        ss += dpp_f<DPP_X1>(ss); ss += dpp_f<DPP_X2>(ss); ss += dpp_f<DPP_HMIR>(ss);
        const float rstd = rsq(ss * (1.0f / 64.0f) + EPS);
        const LAS float* g = gt + ((head < 8) ? 0 : 64) + d1; const f32x4 ga = *(const LAS f32x4*)g, gb = *(const LAS f32x4*)(g + 16);
        const LAS f32x4* tp = (const LAS f32x4*)(tab + (pos * 16 + 4 * jj) * 2); const f32x4 c0 = tp[0], c1 = tp[1];
        const float sc = (head < 8) ? rstd * ATT_C2 : rstd;
        float o1[4], o2[4];
#pragma unroll
        for (int e = 0; e < 4; ++e) { const float y1 = x1[e] * sc * ga[e], y2 = x2[e] * sc * gb[e]; const float cs = (e < 2) ? c0[2 * e] : c1[2 * e - 4], sn = (e < 2) ? c0[2 * e + 1] : c1[2 * e - 3];
            o1[e] = y1 * cs - y2 * sn; o2[e] = y2 * cs + y1 * sn; }
        GAS bf16* op = (head < 8) ? ((GAS bf16*)(F.ws + WS_QP) + (size_t)m * 512 + head * 64 + d1) : ((GAS bf16*)(F.ws + WS_KV) + (size_t)m * 256 + (head - 8) * 64 + d1);
        v2u w1, w2; w1.x = pk2(o1[0], o1[1]); w1.y = pk2(o1[2], o1[3]); w2.x = pk2(o2[0], o2[1]); w2.y = pk2(o2[2], o2[3]);
        *(GAS v2u*)op = w1; *(GAS v2u*)(op + 16) = w2; }
    *(GAS v4u*)((GAS bf16*)(F.ws + WS_KV) + (size_t)mv * 256 + 128 + 8 * (lane & 15)) = vv;
}
__device__ __forceinline__ float bfe(const v4u& w, int e) { const unsigned u = (e & 1) ? (w[e >> 1] & 0xffff0000u) : (w[e >> 1] << 16); return __uint_as_float(u); }
__device__ __forceinline__ void hy_rows(const GAS bf16* p, int tq0, v4u (&rows)[6]) {
#pragma unroll
    for (int r = 0; r < 6; ++r) { const int t = tq0 - 1 + r; rows[r] = (t >= 0 && t < SEQ) ? *(const GAS v4u*)(p + (ptrdiff_t)(r - 1) * NPROJ) : (v4u){0u, 0u, 0u, 0u}; }
}
template <int EH> __device__ __forceinline__ void hy_conv4x4(const v4u (&rows)[6], const GAS float* w, const GAS float* bias, float (&u)[4][4]) {
    const f32x4 w0 = *(const GAS f32x4*)(w + 4 * EH), w1 = *(const GAS f32x4*)(w + 768 + 4 * EH), w2 = *(const GAS f32x4*)(w + 1536 + 4 * EH), bs = *(const GAS f32x4*)(bias + 4 * EH);
#pragma unroll
    for (int e = 0; e < 4; ++e)
#pragma unroll
        for (int i = 0; i < 4; ++i) u[i][e] = bfe(rows[i], 4 * EH + e) * w0[e] + bfe(rows[i + 1], 4 * EH + e) * w1[e] + bfe(rows[i + 2], 4 * EH + e) * w2[e] + bs[e];
}
template <int EH> __device__ __forceinline__ void hy_z_half(const v4u (&r1)[6], const v4u (&r2)[6], const GAS float* cw, const GAS float* cb, unsigned (&zp)[4][4]) {
    float x1[4][4], vv[4][4]; hy_conv4x4<EH>(r1, cw + 256, cb + 256, x1); hy_conv4x4<EH>(r2, cw + 512, cb + 512, vv);
#pragma unroll
    for (int i = 0; i < 4; ++i) { zp[i][2 * EH] = pk2(x1[i][0] * vv[i][0], x1[i][1] * vv[i][1]); zp[i][2 * EH + 1] = pk2(x1[i][2] * vv[i][2], x1[i][3] * vv[i][3]); }
    __builtin_amdgcn_sched_barrier(0);
}
__device__ __forceinline__ void hy_prep_item(Frame& F, int l, int item, LAS unsigned char* lb) {
    int tid = F.tid; asm volatile("" : "+v"(tid));
    const int b = item >> 6, t0 = (item & 63) * 64, cg = tid & 31, tq = tid >> 5, tq0 = t0 + 4 * tq;
    const GAS bf16* p = (const GAS bf16*)(F.ws + WS_PROJ) + ((size_t)b * SEQ + tq0) * NPROJ + PC_HX1 + 8 * cg;
    const GAS float* cw = INP(F, I_HCW) + l * 3 * 768 + 8 * cg; const GAS float* cb = INP(F, I_HCB) + l * 768 + 8 * cg;
    v4u r1[6], r2[6]; hy_rows(p, tq0, r1); hy_rows(p + 256, tq0, r2);
    unsigned zp[4][4]; hy_z_half<0>(r1, r2, cw, cb, zp); hy_z_half<1>(r1, r2, cw, cb, zp);
    LAS bf16* zs = (LAS bf16*)lb;
#pragma unroll
    for (int e = 0; e < 8; ++e) { const int sh = (e & 1) * 16; v2u o;
        o.x = ((zp[0][e >> 1] >> sh) & 0xffffu) | (((zp[1][e >> 1] >> sh) & 0xffffu) << 16); o.y = ((zp[2][e >> 1] >> sh) & 0xffffu) | (((zp[3][e >> 1] >> sh) & 0xffffu) << 16);
        *(LAS v2u*)(zs + (8 * cg + e) * 72 + 4 * tq) = o; }
    __syncthreads();
    {   const int cc = tid >> 1, hh = tid & 1; GAS bf16* zt = (GAS bf16*)(F.ws + WS_ZT) + ((size_t)cc * BATCH + b) * SEQ + t0 + hh * 32;
#pragma unroll
        for (int q = 0; q < 4; ++q) *(GAS v4u*)(zt + 8 * q) = *(LAS v4u*)(zs + cc * 72 + hh * 32 + 8 * q); }
    __syncthreads();
}
__device__ __forceinline__ void phase_prep(Frame& F, int l) {
    LAS float* tab = (LAS float*)F.lds;
    for (int i = F.tid; i < 1024; i += NTHR) { const int pos = i >> 4, j = i & 15; const float inv = exp2f(-(float)j * (13.287712379549449f / 16.0f)); float sn, cs; sincosf((float)pos * inv, &sn, &cs); tab[2 * i] = cs; tab[2 * i + 1] = sn; }
    if (F.tid < 128) tab[2048 + F.tid] = (F.tid < 64) ? INP(F, I_QNORM)[l * 64 + F.tid] : INP(F, I_KNORM)[l * 64 + F.tid - 64];
    __syncthreads();
    for (int it = blockIdx.x; it < 256; it += F.G) hy_prep_item(F, l, it, F.lds + 8192 + 512);
    const int gw = F.vcu * NWAVES + F.wave, NGW = F.G * NWAVES;
    for (int it = gw; it < 2048; it += NGW) gla_chunk_kv(F, l, it);
    for (int m = gw; m + 3 * NGW < M; m += 4 * NGW) qk_prep_rows4(F, l, m, NGW, tab);
    if ((M / NGW) % 4 != 0 || M % NGW != 0) { for (int m = gw + (M / NGW / 4) * 4 * NGW; m < M; m += NGW) qk_prep_rows4(F, l, m, 0, tab); }
}

__device__ __forceinline__ void gla_scan_item(Frame& F, int item) {
    const int sub = item & 7, bhd = item >> 3, dir = bhd & 1, lane = F.lane, w = F.wave, dk0 = 16 * (sub >> 2) + 8 * (sub & 1) + 4 * (lane & 1);
    GAS bf16* kv = (GAS bf16*)(F.ws + WS_GKV) + (size_t)bhd * NCHUNK * 2048 + sub * 256 + 4 * lane;
    const GAS float* al = (const GAS float*)(F.ws + WS_ALAST) + (size_t)bhd * NCHUNK * 32 + dk0;
    LAS f32x4* AB = (LAS f32x4*)F.lds;
    v2u x[16]; f32x4 a[16];
#pragma unroll
    for (int q = 0; q < 16; ++q) { const int p = 16 * w + q, n = dir ? (NCHUNK - 1 - p) : p; x[q] = *(const GAS v2u*)(kv + (size_t)n * 2048); a[q] = *(const GAS f32x4*)(al + n * 32); }
    f32x4 A = (f32x4){1.f, 1.f, 1.f, 1.f}, B = (f32x4){0.f, 0.f, 0.f, 0.f};
#pragma unroll
    for (int q = 0; q < 16; ++q) { const f32x4 xv = (f32x4){__uint_as_float(x[q].x << 16), __uint_as_float(x[q].x & 0xffff0000u), __uint_as_float(x[q].y << 16), __uint_as_float(x[q].y & 0xffff0000u)};
        B = a[q] * B + xv; A = A * a[q]; }
    AB[(w * 2 + 0) * 64 + lane] = A; AB[(w * 2 + 1) * 64 + lane] = B;
    __syncthreads();
    f32x4 S = (f32x4){0.f, 0.f, 0.f, 0.f};
    for (int v = 0; v < w; ++v) S = AB[(v * 2 + 0) * 64 + lane] * S + AB[(v * 2 + 1) * 64 + lane];
#pragma unroll
    for (int q = 0; q < 16; ++q) { const int p = 16 * w + q, n = dir ? (NCHUNK - 1 - p) : p;
        v2u o; o.x = pk2(S[0], S[1]); o.y = pk2(S[2], S[3]); *(GAS v2u*)(kv + (size_t)n * 2048) = o;
        const f32x4 xv = (f32x4){__uint_as_float(x[q].x << 16), __uint_as_float(x[q].x & 0xffff0000u), __uint_as_float(x[q].y << 16), __uint_as_float(x[q].y & 0xffff0000u)};
        S = a[q] * S + xv; }
    __syncthreads();
}
typedef short hy_bf16x8 __attribute__((ext_vector_type(8)));
typedef short hy_bf16x8_a8 __attribute__((ext_vector_type(8), aligned(8)));
typedef float hy_f32x16 __attribute__((ext_vector_type(16)));
constexpr int HYC_CST = 8224, HYC_Z_OFF = 4 * HYC_CST * 2, HYC_ZROW = 144;
__device__ __forceinline__ void hy_conv_item(Frame& F, int l, int c) {
    const int tid = F.tid, lane = F.lane, w = F.wave;
    LAS bf16* G = (LAS bf16*)F.lds; LAS unsigned char* Z = F.lds + HYC_Z_OFF;
    const GAS float* hf = (const GAS float*)(F.ws + WS_HF) + ((size_t)l * 256 + c) * 8192;
    {
        LAS float* HS = (LAS float*)Z;
        for (int i = tid; i < 2048; i += NTHR) *(LAS f32x4*)(HS + 4 * i) = *(const GAS f32x4*)(hf + 4 * i);
        __syncthreads();
        for (int i = tid; i < 4 * HYC_CST / 2; i += NTHR) { const int q = i / (HYC_CST / 2), u = 2 * (i % (HYC_CST / 2)); const int i0 = 8192 + q - u, i1 = i0 - 1;
            const float v0 = (i0 >= 1 && i0 <= 8191) ? HS[i0] : 0.f, v1 = (i1 >= 1 && i1 <= 8191) ? HS[i1] : 0.f;
            ((LAS unsigned*)G)[i] = pk2(v0, v1); }
        __syncthreads(); }
    const GAS bf16* zt = (const GAS bf16*)(F.ws + WS_ZT) + (size_t)c * BATCH * SEQ;
    for (int i = tid; i < BATCH * SEQ / 8; i += NTHR) { const int b = i >> 9, s8 = i & 511, S = s8 >> 3, j8 = s8 & 7;
        *(LAS v4u*)(Z + (S * 4 + b) * HYC_ZROW + j8 * 16) = *(const GAS v4u*)(zt + (size_t)b * SEQ + s8 * 8); }
    if (tid < 36) ((LAS unsigned*)(Z + 256 * HYC_ZROW))[tid] = 0u;
    __syncthreads();
    const int r = lane & 31, h = lane >> 5, q = r & 3, nT = 8 * w + (r >> 2), nb = r & 3;
    hy_f32x16 acc0, acc1;
#pragma unroll
    for (int i = 0; i < 16; ++i) { acc0[i] = 0.f; acc1[i] = 0.f; }
    const int a_base = q * HYC_CST + 4096 + 8 * h - (r - q);
    hy_bf16x8 c2, c3;
    {   const LAS bf16* ap = G + (a_base - 64 * (8 * w - 63)); c2 = *(const LAS hy_bf16x8_a8*)(ap + 32); c3 = *(const LAS hy_bf16x8_a8*)(ap + 48); }
    const bool host = (l == 0) && (F.G == 256) && (c == F.vcu);
    const int hq0 = F8W_HOST0 + F.vcu * NWAVES + w; F8WItem hit; f32x4 hv[16]; int di = 0;
    for (int D = 8 * w - 63; D <= 8 * w + 7; ++D, ++di) {
        if (host && (di & 15) == 0) {
            if (di > 0) f8w_finish(hit, hv);
            if (di < 16 * F8W_HOSTED) { hit = f8w_item(F, hq0 + (di >> 4) * (F.G * NWAVES)); f8w_load(hit, hv); } }
        const int S = nT - D; const int zrow = (S >= 0 && S < 64) ? (S * 4 + nb) : 256;
        const LAS unsigned char* zp = Z + zrow * HYC_ZROW + h * 16;
        const LAS bf16* ap = G + (a_base - 64 * D);
        const hy_bf16x8 b0 = *(const LAS hy_bf16x8*)(zp), b1 = *(const LAS hy_bf16x8*)(zp + 32), b2 = *(const LAS hy_bf16x8*)(zp + 64), b3 = *(const LAS hy_bf16x8*)(zp + 96);
        const hy_bf16x8 a00 = *(const LAS hy_bf16x8_a8*)(ap), a01 = *(const LAS hy_bf16x8_a8*)(ap + 16), a10 = *(const LAS hy_bf16x8_a8*)(ap - 32), a11 = *(const LAS hy_bf16x8_a8*)(ap - 16);
        acc0 = __builtin_amdgcn_mfma_f32_32x32x16_bf16(a00, b0, acc0, 0, 0, 0); acc1 = __builtin_amdgcn_mfma_f32_32x32x16_bf16(a10, b0, acc1, 0, 0, 0);
        acc0 = __builtin_amdgcn_mfma_f32_32x32x16_bf16(a01, b1, acc0, 0, 0, 0); acc1 = __builtin_amdgcn_mfma_f32_32x32x16_bf16(a11, b1, acc1, 0, 0, 0);
        acc0 = __builtin_amdgcn_mfma_f32_32x32x16_bf16(c2, b2, acc0, 0, 0, 0);  acc1 = __builtin_amdgcn_mfma_f32_32x32x16_bf16(a00, b2, acc1, 0, 0, 0);
        acc0 = __builtin_amdgcn_mfma_f32_32x32x16_bf16(c3, b3, acc0, 0, 0, 0);  acc1 = __builtin_amdgcn_mfma_f32_32x32x16_bf16(a01, b3, acc1, 0, 0, 0);
        c2 = a10; c3 = a11;
    }
    GAS bf16* yc = (GAS bf16*)(F.ws + WS_YC) + ((size_t)c * BATCH + nb) * SEQ + 64 * nT + 4 * h;
#pragma unroll
    for (int g = 0; g < 4; ++g) {
        v2u o0; o0.x = pk2(acc0[4 * g], acc0[4 * g + 1]); o0.y = pk2(acc0[4 * g + 2], acc0[4 * g + 3]); *(GAS v2u*)(yc + 8 * g) = o0;
        v2u o1; o1.x = pk2(acc1[4 * g], acc1[4 * g + 1]); o1.y = pk2(acc1[4 * g + 2], acc1[4 * g + 3]); *(GAS v2u*)(yc + 32 + 8 * g) = o1; }
    __syncthreads();
}

__device__ __forceinline__ void gla_out_item(Frame& F, int l, int item, LAS bf16* wl  ) {
    int lane = F.lane; asm volatile("" : "+v"(lane));
    const int n = item & 127, h = (item >> 7) & 3, b = item >> 9, dk = lane & 31, half = lane >> 5;
    const size_t m0 = (size_t)b * SEQ + 32 * n;
    const GAS bf16* proj = (const GAS bf16*)(F.ws + WS_PROJ) + m0 * NPROJ;
    const GAS bf16* gkv = (const GAS bf16*)(F.ws + WS_GKV);
    LAS bf16* R1 = wl; LAS bf16* R2 = wl + 5120;
    LAS bf16* QDF = wl; LAS bf16* KIF = wl + 1280; LAS bf16* QDB = wl + 2560; LAS bf16* KIB = wl + 3840;
    const int rA = lane >> 2, pA = lane & 3, rB = lane >> 3, pB = lane & 7;
    v4u pin[8], pvv[4], pgg[4];
#pragma unroll
    for (int a = 0; a < 4; ++a) { const int col = (a == 0 ? PC_LAF : a == 1 ? PC_LAB : a == 2 ? PC_GQ : PC_GK) + h * 32 + 8 * pA;
        pin[2 * a] = *(const GAS v4u*)(proj + (size_t)rA * NPROJ + col); pin[2 * a + 1] = *(const GAS v4u*)(proj + (size_t)(rA + 16) * NPROJ + col); }
#pragma unroll
    for (int rep = 0; rep < 4; ++rep) { pvv[rep] = *(const GAS v4u*)(proj + (size_t)(rB + 8 * rep) * NPROJ + PC_GV + h * 64 + 8 * pB); pgg[rep] = *(const GAS v4u*)(proj + (size_t)(rB + 8 * rep) * NPROJ + PC_GG + h * 64 + 8 * pB); }
    g_bf16x8 sfr[2][2][2];
#pragma unroll
    for (int dir = 0; dir < 2; ++dir) { const GAS bf16* Sp = gkv + (size_t)(((b * 4 + h) * 2 + dir) * NCHUNK + n) * 2048 + (half * 32 + dk) * 8;
#pragma unroll
        for (int s = 0; s < 2; ++s)
#pragma unroll
            for (int blk = 0; blk < 2; ++blk) sfr[dir][s][blk] = *(const GAS g_bf16x8*)(Sp + (s * 2 + blk) * 512); }
    const float bf_ = (INP(F, I_GBDEC) + l * 256)[h * 32 + dk], bb_ = (INP(F, I_GBDEC) + l * 256)[128 + h * 32 + dk];
    LDS_WAIT(); asm volatile("" ::: "memory");
#pragma unroll
    for (int a = 0; a < 4; ++a) { *(LAS v4u*)(R1 + a * 1280 + rA * 40 + 8 * pA) = pin[2 * a]; *(LAS v4u*)(R1 + a * 1280 + (rA + 16) * 40 + 8 * pA) = pin[2 * a + 1]; }
#pragma unroll
    for (int rep = 0; rep < 4; ++rep) *(LAS v4u*)(R2 + (rB + 8 * rep) * 72 + 8 * pB) = pvv[rep];
    LDS_WAIT(); asm volatile("" ::: "memory");
    g_f32x16 o[2];
#pragma unroll
    for (int blk = 0; blk < 2; ++blk)
#pragma unroll
        for (int r = 0; r < 16; ++r) o[blk][r] = 0.f;
    g_bf16x8 qf[2], qb[2];
    {
        g_bf16x8 kf[2], kb[2];
        g_bf16x8 vfr[2][2];
#pragma unroll
        for (int s = 0; s < 2; ++s)
#pragma unroll
            for (int blk = 0; blk < 2; ++blk) { const LAS bf16* vp = R2 + (16 * s + 4 * half) * 72 + blk * 32 + dk; unsigned ev[8];
#pragma unroll
                for (int jj = 0; jj < 8; ++jj) ev[jj] = vp[(8 * (jj >> 2) + (jj & 3)) * 72];
                vfr[s][blk] = g_frag(ev[0] | (ev[1] << 16), ev[2] | (ev[3] << 16), ev[4] | (ev[5] << 16), ev[6] | (ev[7] << 16)); }
        {
            float pf[16], sb[16], qv[16], kv[16];
            {   const LAS bf16* cp = R1 + (16 * half) * 40 + dk;
                float accf = 0.f;
#pragma unroll
                for (int ii = 0; ii < 16; ++ii) { accf += logsigf(bf2f(cp[ii * 40]) + bf_) * (1.0f / 16.0f); pf[ii] = accf; }
                float accb = 0.f;
#pragma unroll
                for (int ii = 15; ii >= 0; --ii) { accb += logsigf(bf2f(cp[1280 + ii * 40]) + bb_) * (1.0f / 16.0f); sb[ii] = accb; }
#pragma unroll
                for (int ii = 0; ii < 16; ++ii) { qv[ii] = bf2f(cp[2560 + ii * 40]) * 0.17677669529663687f; kv[ii] = bf2f(cp[3840 + ii * 40]); }
                const float of = lane_get(accf, lane ^ 32), ob = lane_get(accb, lane ^ 32);
                if (half == 1) {
#pragma unroll
                    for (int ii = 0; ii < 16; ++ii) pf[ii] += of; }
                else {
#pragma unroll
                    for (int ii = 0; ii < 16; ++ii) sb[ii] += ob; }
            }
            LDS_WAIT(); asm volatile("" ::: "memory");
#pragma unroll
            for (int ii = 0; ii < 16; ++ii) { const int i = 16 * half + ii;
                QDF[i * 40 + dk] = (bf16)f2bf(qv[ii] * __expf(pf[ii])); KIF[i * 40 + dk] = (bf16)f2bf(kv[ii] * __expf(-pf[ii]));
                QDB[i * 40 + dk] = (bf16)f2bf(qv[ii] * __expf(sb[ii])); KIB[i * 40 + dk] = (bf16)f2bf(kv[ii] * __expf(-sb[ii])); }
            LDS_WAIT(); asm volatile("" ::: "memory");
        }
#pragma unroll
        for (int s = 0; s < 2; ++s) { const int fo = dk * 40 + 16 * s + 8 * half;
            qf[s] = *(const LAS g_bf16x8*)(QDF + fo); kf[s] = *(const LAS g_bf16x8*)(KIF + fo); qb[s] = *(const LAS g_bf16x8*)(QDB + fo); kb[s] = *(const LAS g_bf16x8*)(KIB + fo); }
        LDS_WAIT(); asm volatile("" ::: "memory");
#pragma unroll
        for (int rep = 0; rep < 4; ++rep) *(LAS v4u*)(R1 + (rB + 8 * rep) * 72 + 8 * pB) = pgg[rep];
        g_f32x16 xf, xb;
#pragma unroll
        for (int r = 0; r < 16; ++r) { xf[r] = 0.f; xb[r] = 0.f; }
#pragma unroll
        for (int s = 0; s < 2; ++s) { xf = __builtin_amdgcn_mfma_f32_32x32x16_bf16(kf[s], qf[s], xf, 0, 0, 0); xb = __builtin_amdgcn_mfma_f32_32x32x16_bf16(kb[s], qb[s], xb, 0, 0, 0); }
        unsigned xw[8];
#pragma unroll
        for (int rp = 0; rp < 8; ++rp) { float t[2];
#pragma unroll
            for (int u = 0; u < 2; ++u) { const int r = 2 * rp + u, j = (r & 3) + 8 * (r >> 2) + 4 * half; t[u] = ((dk >= j) ? xf[r] : 0.f) + ((dk <= j) ? xb[r] : 0.f); }
            xw[rp] = pk2(t[0], t[1]); }
#pragma unroll
        for (int s = 0; s < 2; ++s) { const g_bf16x8 xa = g_frag(xw[4 * s], xw[4 * s + 1], xw[4 * s + 2], xw[4 * s + 3]);
#pragma unroll
            for (int blk = 0; blk < 2; ++blk) o[blk] = __builtin_amdgcn_mfma_f32_32x32x16_bf16(xa, vfr[s][blk], o[blk], 0, 0, 0); }
    }
#pragma unroll
    for (int dir = 0; dir < 2; ++dir)
#pragma unroll
        for (int s = 0; s < 2; ++s)
#pragma unroll
            for (int blk = 0; blk < 2; ++blk) o[blk] = __builtin_amdgcn_mfma_f32_32x32x16_bf16(dir ? qb[s] : qf[s], sfr[dir][s][blk], o[blk], 0, 0, 0);
    const float ng0 = INP(F, I_GNORM)[l * 64 + dk], ng1 = INP(F, I_GNORM)[l * 64 + 32 + dk];
    LDS_WAIT(); asm volatile("" ::: "memory");
#pragma unroll
    for (int r4 = 0; r4 < 4; ++r4) {
        float g0[4], g1[4], ss[4];
#pragma unroll
        for (int k = 0; k < 4; ++k) { const int row = k + 8 * r4 + 4 * half; g0[k] = bf2f(R1[row * 72 + dk]); g1[k] = bf2f(R1[row * 72 + 32 + dk]); ss[k] = o[0][4 * r4 + k] * o[0][4 * r4 + k] + o[1][4 * r4 + k] * o[1][4 * r4 + k]; }
#pragma unroll
        for (int k = 0; k < 4; ++k) ss[k] = half_sum(ss[k]);
#pragma unroll
        for (int k = 0; k < 4; ++k) { const int row = k + 8 * r4 + 4 * half; const float rstd = rsq(ss[k] * (1.0f / 64.0f) + EPS);
            R2[row * 72 + dk] = (bf16)f2bf(o[0][4 * r4 + k] * rstd * ng0 * siluf(g0[k])); R2[row * 72 + 32 + dk] = (bf16)f2bf(o[1][4 * r4 + k] * rstd * ng1 * siluf(g1[k])); }
    }
    LDS_WAIT(); asm volatile("" ::: "memory");
    GAS bf16* cat = (GAS bf16*)(F.ws + WS_CAT) + m0 * DM + h * 64 + 8 * pB;
#pragma unroll
    for (int rep = 0; rep < 4; ++rep) *(GAS v4u*)(cat + (size_t)(rB + 8 * rep) * DM) = *(const LAS v4u*)(R2 + (rB + 8 * rep) * 72 + 8 * pB);
}
__device__ __forceinline__ void hy_out_item(Frame& F, int l, int item, LAS unsigned char* lb) {
    int tid = F.tid; asm volatile("" : "+v"(tid));
    const int b = item >> 6, t0 = (item & 63) * 64, cg = tid & 31, tq = tid >> 5, tq0 = t0 + 4 * tq;
    LAS float* ys = (LAS float*)lb;
    {   const GAS bf16* yc = (const GAS bf16*)(F.ws + WS_YC);
#pragma unroll
        for (int k = 0; k < 8; ++k) { const int i = tid + NTHR * k, cc = i >> 4, q = i & 15; const v2u w_ = *(const GAS v2u*)(yc + ((size_t)cc * BATCH + b) * SEQ + t0 + 4 * q);
            const f32x4 v = (f32x4){__uint_as_float(w_.x << 16), __uint_as_float(w_.x & 0xffff0000u), __uint_as_float(w_.y << 16), __uint_as_float(w_.y & 0xffff0000u)};
            ys[(4 * q) * 260 + cc] = v[0]; ys[(4 * q + 1) * 260 + cc] = v[1]; ys[(4 * q + 2) * 260 + cc] = v[2]; ys[(4 * q + 3) * 260 + cc] = v[3]; } }
    const GAS bf16* p = (const GAS bf16*)(F.ws + WS_PROJ) + ((size_t)b * SEQ + tq0) * NPROJ + PC_HX0 + 8 * cg;
    const GAS float* cw = INP(F, I_HCW) + l * 3 * 768 + 8 * cg; const GAS float* cb = INP(F, I_HCB) + l * 768 + 8 * cg;
    __builtin_amdgcn_sched_barrier(0);
    unsigned zp[4][4];
    {   v4u r1[6], r2[6]; hy_rows(p + 256, tq0, r1); hy_rows(p + 512, tq0, r2); hy_z_half<0>(r1, r2, cw, cb, zp); hy_z_half<1>(r1, r2, cw, cb, zp); }
    float x0[4][8];
    {   v4u r0[6]; hy_rows(p, tq0, r0); float h0[4][4], h1[4][4]; hy_conv4x4<0>(r0, cw, cb, h0); hy_conv4x4<1>(r0, cw, cb, h1);
#pragma unroll
        for (int i = 0; i < 4; ++i)
#pragma unroll
            for (int e = 0; e < 4; ++e) { x0[i][e] = h0[i][e]; x0[i][4 + e] = h1[i][e]; } }
    __builtin_amdgcn_sched_barrier(0);
    const GAS float* skp = INP(F, I_HSKIP) + l * 256 + 8 * cg; const f32x4 ska = *(const GAS f32x4*)skp, skb = *(const GAS f32x4*)(skp + 4);
    __syncthreads();
    GAS bf16* cat = (GAS bf16*)(F.ws + WS_CAT) + ((size_t)b * SEQ + tq0) * DM + 768 + 8 * cg;
#pragma unroll
    for (int i = 0; i < 4; ++i) { const f32x4 ya = *(LAS f32x4*)(ys + (4 * tq + i) * 260 + 8 * cg), yb = *(LAS f32x4*)(ys + (4 * tq + i) * 260 + 8 * cg + 4); float o[8];
#pragma unroll
        for (int e = 0; e < 8; ++e) { const float y = (e < 4) ? ya[e & 3] : yb[e & 3], sk = (e < 4) ? ska[e & 3] : skb[e & 3]; const float zz = __uint_as_float((e & 1) ? (zp[i][e >> 1] & 0xffff0000u) : (zp[i][e >> 1] << 16)); o[e] = x0[i][e] * (y + zz * sk); }
        v4u w; w.x = pk2(o[0], o[1]); w.y = pk2(o[2], o[3]); w.z = pk2(o[4], o[5]); w.w = pk2(o[6], o[7]); *(GAS v4u*)(cat + (size_t)i * DM) = w; }
    __syncthreads();
}
__device__ __forceinline__ void phase_mix_out(Frame& F, int l) {
    for (int it = blockIdx.x; it < 256; it += F.G) hy_out_item(F, l, it, F.lds);
    const int gw = F.vcu * NWAVES + F.wave, NGW = F.G * NWAVES;
    for (int it = gw; it < 2048; it += NGW) gla_out_item(F, l, it, (LAS bf16*)(F.lds + F.wave * 14848));
}

__device__ __forceinline__ void post_mix_front(Frame& F, int l, int m, const f32x4 (&y)[4], f32x4 (&x)[4], const LAS float* PV) {
    const int lane = F.lane, b = m >> 12; const LAS f32x4* A = (const LAS f32x4*)(PV + b * 3072); const LAS f32x4* Bv = A + 256; const LAS f32x4* Cv = A + 512;
    const float rstd = rsq(row_ss(y, lane) * (1.0f / DM) + EPS);
#pragma unroll
    for (int j = 0; j < 4; ++j) { const int c4 = lane + 64 * j; x[j] = x[j] + A[c4] * (y[j] * rstd); }
    roww_store_bf16((GAS bf16*)(F.ws + WS_XR) + (size_t)m * DM, lane, x);
    const float rstd2 = rsq(row_ss(x, lane) * (1.0f / DM) + EPS);
    v4u hw;
#pragma unroll
    for (int j = 0; j < 4; ++j) { const int c4 = lane + 64 * j; x[j] = x[j] * rstd2 * Bv[c4] + Cv[c4]; hw[j] = pk4_f8(x[j][0], x[j][1], x[j][2], x[j][3]); }
    ((GAS v4u*)((GAS unsigned char*)(F.ws + WS_HN) + (size_t)m * DM))[lane] = hw;
}
__device__ __forceinline__ void post_mix_route(Frame& F, int m, float (&lg)[16]) {
    const int lane = F.lane, b = m >> 12, t = m & (SEQ - 1);
    const bool b5 = (lane & 32) != 0, b4 = (lane & 16) != 0, b3 = (lane & 8) != 0, b2 = (lane & 4) != 0;
    float a8[8], a4[4], a2[2];
#pragma unroll
    for (int e = 0; e < 8; ++e) a8[e] = swap32_sum(lg[e], lg[8 + e]);
#pragma unroll
    for (int e = 0; e < 4; ++e) a4[e] = swap16_sum(a8[e], a8[4 + e]);
#pragma unroll
    for (int e = 0; e < 2; ++e) { const float keep = b3 ? a4[2 + e] : a4[e], send = b3 ? a4[e] : a4[2 + e]; a2[e] = keep + dpp_f<DPP_ROR8>(send); }
    float v = (b2 ? a2[1] : a2[0]) + dpp_f<DPP_HMIR>(b2 ? a2[0] : a2[1]);
    v += dpp_f<DPP_X2>(v); v += dpp_f<DPP_X1>(v);
    float mx = fmaxf(v, dpp_f<DPP_HMIR>(v)); mx = fmaxf(mx, dpp_f<DPP_ROR8>(mx)); mx = swap16_max(mx); mx = swap32_max(mx);
    const float ex = expf(v - mx); float den = ex + dpp_f<DPP_HMIR>(ex); den += dpp_f<DPP_ROR8>(den); den = swap16_sum(den, den); den = swap32_sum(den, den);
    const int e = (b5 ? 8 : 0) + (b4 ? 4 : 0) + (b3 ? 2 : 0) + (b2 ? 1 : 0);
    if ((lane & 3) == 0) ((GAS float*)(F.ws + WS_AFF))[((size_t)b * NEXP + e) * SEQ + t] = ex / den;
}
__device__ __forceinline__ void phase_post_mix(Frame& F, int l) {
    LAS float* rws = (LAS float*)F.lds;
    for (int i = F.tid; i < DM * NEXP / 4; i += NTHR) { const int k = i >> 2, part = i & 3, g = k >> 2, slot_ = (g >> 2) + 64 * (g & 3);
        *(LAS f32x4*)(rws + slot_ * 68 + (k & 3) * 16 + part * 4) = ((const GAS f32x4*)(INP(F, I_ROUTER) + (size_t)l * DM * NEXP))[i]; }
    const GAS float* mod = (const GAS float*)(F.ws + WS_MOD) + (size_t)l * 4 * 6144;
    LAS float* PV = (LAS float*)(F.lds + 69632);
    for (int i = F.tid; i < 4 * 256; i += NTHR) { const int b = i >> 8, c4 = i & 255; const GAS float* mb = mod + (size_t)b * 6144;
        const f32x4 gm = ((const GAS f32x4*)(mb + 2048))[c4], pg = ((const GAS f32x4*)(INP(F, I_MPOST) + l * DM))[c4], gg = ((const GAS f32x4*)(INP(F, I_FPRE) + l * DM))[c4], s1 = ((const GAS f32x4*)(mb + 4096))[c4], s0 = ((const GAS f32x4*)(mb + 3072))[c4];
        LAS f32x4* pv = (LAS f32x4*)(PV + b * 3072) + ((c4 >> 2) + 64 * (c4 & 3)); pv[0] = gm * pg; pv[256] = gg * (1.0f + s1); pv[512] = s0; }
    __syncthreads();
    const int gw = F.vcu * NWAVES + F.wave, NGW = F.G * NWAVES, lane = F.lane;
    const GAS float* xin = INP(F, I_X); const GAS bf16* xr = (const GAS bf16*)(F.ws + WS_XR); const GAS bf16* Y = (const GAS bf16*)(F.ws + WS_Y);
    for (int m0 = gw; m0 < M; m0 += 4 * NGW) {
        int mm[4]; f32x4 xx[4][4];
#pragma unroll
        for (int q = 0; q < 4; ++q) mm[q] = (m0 + q * NGW < M) ? m0 + q * NGW : m0;
#pragma unroll
        for (int q = 0; q < 4; q += 2) { f32x4 ya[4], yb[4];
            roww_load_bf16(Y + (size_t)mm[q] * DM, lane, ya); roww_load_bf16(Y + (size_t)mm[q + 1] * DM, lane, yb);
            if (l == 0) { roww_load(xin + (size_t)mm[q] * DM, lane, xx[q]); roww_load(xin + (size_t)mm[q + 1] * DM, lane, xx[q + 1]); }
            else { roww_load_bf16(xr + (size_t)mm[q] * DM, lane, xx[q]); roww_load_bf16(xr + (size_t)mm[q + 1] * DM, lane, xx[q + 1]); }
            post_mix_front(F, l, mm[q], ya, xx[q], PV); post_mix_front(F, l, mm[q + 1], yb, xx[q + 1], PV); }
        float lg[4][16];
#pragma unroll
        for (int q = 0; q < 4; ++q)
#pragma unroll
            for (int e = 0; e < 16; ++e) lg[q][e] = 0.f;
#pragma unroll
        for (int j = 0; j < 4; ++j) { const LAS float* wg = rws + (lane + 64 * j) * 68;
#pragma unroll
            for (int i = 0; i < 4; ++i) { const f32x4 w0 = *(const LAS f32x4*)(wg + 16 * i), w1 = *(const LAS f32x4*)(wg + 16 * i + 4), w2 = *(const LAS f32x4*)(wg + 16 * i + 8), w3 = *(const LAS f32x4*)(wg + 16 * i + 12);
#pragma unroll
                for (int q = 0; q < 4; ++q) { const float h = xx[q][j][i];
#pragma unroll
                    for (int e = 0; e < 4; ++e) { lg[q][e] += h * w0[e]; lg[q][4 + e] += h * w1[e]; lg[q][8 + e] += h * w2[e]; lg[q][12 + e] += h * w3[e]; } }
#pragma unroll
                for (int q = 0; q < 4; ++q)
                    asm volatile("" : "+v"(lg[q][0]), "+v"(lg[q][1]), "+v"(lg[q][2]), "+v"(lg[q][3]), "+v"(lg[q][4]), "+v"(lg[q][5]), "+v"(lg[q][6]), "+v"(lg[q][7]),
                                      "+v"(lg[q][8]), "+v"(lg[q][9]), "+v"(lg[q][10]), "+v"(lg[q][11]), "+v"(lg[q][12]), "+v"(lg[q][13]), "+v"(lg[q][14]), "+v"(lg[q][15]));
                } }
#pragma unroll
        for (int q = 0; q < 4; ++q) if (q == 0 || mm[q] != m0) post_mix_route(F, mm[q], lg[q]);
    }
    __syncthreads();
}

__device__ __forceinline__ unsigned block_excl_scan(unsigned v, LAS unsigned* wsum, int lane, int wave) {
    unsigned inc = v;
#pragma unroll
    for (int o = 1; o < 64; o <<= 1) { const unsigned t = lane_getu(inc, lane - o); if (lane >= o) inc += t; }
    if (lane == 63) wsum[wave] = inc;
    __syncthreads();
    unsigned base = 0;
#pragma unroll
    for (int w = 0; w < 8; ++w) base += (w < wave) ? wsum[w] : 0u;
    __syncthreads();
    return base + inc - v;
}
__device__ __forceinline__ void phase_topk(Frame& F) {
    const int tid = F.tid, lane = F.lane, wave = F.wave;
    LAS unsigned* hist = (LAS unsigned*)F.lds;
    LAS unsigned* ctl = hist + 256;
    LAS unsigned* lst = hist + 512;
    const GAS float* aff = (const GAS float*)(F.ws + WS_AFF); GAS int* slotp = (GAS int*)(F.ws + WS_SLOT); GAS float* gate = (GAS float*)(F.ws + WS_GATE);
    const GAS unsigned char* hn8 = (const GAS unsigned char*)(F.ws + WS_HN); GAS unsigned char* xg8 = (GAS unsigned char*)(F.ws + WS_XG);
    for (int it = F.vcu; it < BATCH * NEXP * 4; it += F.G) { const int be = it >> 2, qu = it & 3, b = be >> 4, e = be & 15;
        const GAS f32x4* ap = (const GAS f32x4*)(aff + (size_t)be * SEQ + 8 * tid); const f32x4 v0 = ap[0], v1 = ap[1];
        unsigned key[8];
#pragma unroll
        for (int j = 0; j < 4; ++j) { key[j] = __float_as_uint(v0[j]); key[4 + j] = __float_as_uint(v1[j]); }
        unsigned prefix = 0u, mask = 0u, kk = CAP;
        if (tid == 0) ctl[2] = 0u;
#pragma unroll 1
        for (int pass = 0; pass < 4; ++pass) { const int shift = 24 - 8 * pass;
            if (tid < 256) hist[tid] = 0u;
            __syncthreads();
#pragma unroll
            for (int j = 0; j < 8; ++j) if ((key[j] & mask) == prefix) __hip_atomic_fetch_add(&hist[(key[j] >> shift) & 255u], 1u, __ATOMIC_RELAXED, __HIP_MEMORY_SCOPE_WORKGROUP);
            __syncthreads();
            if (wave == 0) { const unsigned h0 = hist[4 * lane], h1 = hist[4 * lane + 1], h2 = hist[4 * lane + 2], h3 = hist[4 * lane + 3]; const unsigned loc = h0 + h1 + h2 + h3;
                unsigned suf = loc;
#pragma unroll
                for (int o = 1; o < 64; o <<= 1) { const unsigned t = lane_getu(suf, lane + o); if (lane + o < 64) suf += t; }
                const unsigned above = suf - loc;
                if (above < kk && kk <= suf) { unsigned c = above; int d;
                    if (c + h3 >= kk) d = 3; else { c += h3; if (c + h2 >= kk) d = 2; else { c += h2; if (c + h1 >= kk) d = 1; else { c += h1; d = 0; } } }
                    ctl[0] = prefix | ((unsigned)(4 * lane + d) << shift); ctl[1] = kk - c; } }
            __syncthreads();
            prefix = ctl[0]; kk = ctl[1]; mask |= 255u << shift;
        }
        unsigned eqc = 0u;
#pragma unroll
        for (int j = 0; j < 8; ++j) eqc += (key[j] == prefix) ? 1u : 0u;
        unsigned eqr = block_excl_scan(eqc, ctl + 8, lane, wave);
        unsigned selm = 0u, selc = 0u;
#pragma unroll
        for (int j = 0; j < 8; ++j) { bool s = key[j] > prefix; if (key[j] == prefix) { s = eqr < kk; ++eqr; } selm |= s ? (1u << j) : 0u; selc += s ? 1u : 0u; }
        unsigned sl = block_excl_scan(selc, ctl + 8, lane, wave);
        if ((tid >> 7) == qu) { int so[8];
#pragma unroll
            for (int j = 0; j < 8; ++j) { const bool s = (selm >> j) & 1u; so[j] = s ? (int)sl : -1;
                if (s) { gate[e * EROWS + b * CAP + sl] = __uint_as_float(key[j]); const unsigned p = __hip_atomic_fetch_add(&ctl[2], 1u, __ATOMIC_RELAXED, __HIP_MEMORY_SCOPE_WORKGROUP); lst[p] = (unsigned)(8 * tid + j) | (sl << 16); ++sl; } }
            GAS int* sp = slotp + (size_t)be * SEQ + 8 * tid;
            typedef int v4i __attribute__((ext_vector_type(4))); *(GAS v4i*)sp = (v4i){so[0], so[1], so[2], so[3]}; *(GAS v4i*)(sp + 4) = (v4i){so[4], so[5], so[6], so[7]}; }
        __syncthreads();
        const int nsel = (int)ctl[2];
        for (int i0 = wave * 8; i0 < nsel; i0 += 64) {
            v4u r0[8]; unsigned en[8];
#pragma unroll
            for (int q = 0; q < 8; ++q) { const int i = (i0 + q < nsel) ? i0 + q : i0; en[q] = lst[i]; r0[q] = ((const GAS v4u*)(hn8 + ((size_t)b * SEQ + (en[q] & 0xffffu)) * DM))[lane]; }
#pragma unroll
            for (int q = 0; q < 8; ++q) if (i0 + q < nsel) ((GAS v4u*)(xg8 + ((size_t)e * EROWS + b * CAP + (en[q] >> 16)) * DM))[lane] = r0[q];
        }
        __syncthreads();
    }
}

__device__ __forceinline__ void phase_combine(Frame& F, int l) {
    const int gw = F.vcu * NWAVES + F.wave, NGW = F.G * NWAVES, lane = F.lane;
    const GAS float* modl = (const GAS float*)(F.ws + WS_MOD) + (size_t)l * 4 * 6144;
    const GAS int* slot = (const GAS int*)(F.ws + WS_SLOT); const GAS bf16* ye = (const GAS bf16*)(F.ws + WS_YE);
    LAS float* PV = (LAS float*)F.lds;
    for (int i = F.tid; i < 4 * 256; i += NTHR) { const int b = i >> 8, c4 = i & 255; const GAS float* mb = modl + (size_t)b * 6144;
        const f32x4 gf = ((const GAS f32x4*)(mb + 5120))[c4], pg = ((const GAS f32x4*)(INP(F, I_FPOST) + l * DM))[c4];
        LAS f32x4* pv = (LAS f32x4*)(PV + b * 3072) + ((c4 >> 2) + 64 * (c4 & 3)); pv[0] = gf * pg;
        if (l + 1 < DEPTH) { const GAS float* mn = modl + 4 * 6144 + (size_t)b * 6144; const f32x4 gg = ((const GAS f32x4*)(INP(F, I_MPRE) + (l + 1) * DM))[c4], s1 = ((const GAS f32x4*)(mn + 1024))[c4], s0 = ((const GAS f32x4*)mn)[c4];
            pv[256] = gg * (1.0f + s1); pv[512] = s0; } }
    __syncthreads();
    for (int m0 = gw; m0 < M; m0 += 2 * NGW) {
        int mm[2]; mm[0] = m0; mm[1] = (m0 + NGW < M) ? m0 + NGW : m0;
        int sl[2]; unsigned long long mask[2]; f32x4 y[2][4], x[2][4];
#pragma unroll
        for (int q = 0; q < 2; ++q) { const int b = mm[q] >> 12, t = mm[q] & (SEQ - 1); sl[q] = -1; if (lane < 16) sl[q] = slot[((size_t)b * NEXP + lane) * SEQ + t];
            roww_load_bf16((const GAS bf16*)(F.ws + WS_XR) + (size_t)mm[q] * DM, lane, x[q]);
#pragma unroll
            for (int j = 0; j < 4; ++j) y[q][j] = (f32x4){0.f, 0.f, 0.f, 0.f}; }
#pragma unroll
        for (int q = 0; q < 2; ++q) mask[q] = __ballot(sl[q] >= 0);
        while (mask[0] | mask[1]) {
            f32x4 r[2][4]; bool on[2];
#pragma unroll
            for (int q = 0; q < 2; ++q) { on[q] = mask[q] != 0ull; if (on[q]) { const int e = __builtin_ctzll(mask[q]); mask[q] &= mask[q] - 1; const int s = (int)lane_getu((unsigned)sl[q], e);
                    roww_load_bf16(ye + ((size_t)e * EROWS + (mm[q] >> 12) * CAP + s) * DM, lane, r[q]); } }
#pragma unroll
            for (int q = 0; q < 2; ++q) if (on[q]) {
#pragma unroll
                for (int j = 0; j < 4; ++j) y[q][j] += r[q][j]; }
        }
#pragma unroll
        for (int q = 0; q < 2; ++q) { const int m = mm[q], b = m >> 12; const LAS f32x4* A = (const LAS f32x4*)(PV + b * 3072);
            const float rstd = rsq(row_ss(y[q], lane) * (1.0f / DM) + EPS);
#pragma unroll
            for (int j = 0; j < 4; ++j) { const int c4 = lane + 64 * j;
                x[q][j] = x[q][j] + A[c4] * (y[q][j] * rstd); if (l + 1 == DEPTH) ((GAS f32x4*)(F.out + (size_t)m * DM))[4 * lane + j] = x[q][j]; }
            if (l + 1 < DEPTH) { roww_store_bf16((GAS bf16*)(F.ws + WS_XR) + (size_t)m * DM, lane, x[q]);
                const float rstd2 = rsq(row_ss(x[q], lane) * (1.0f / DM) + EPS); f32x4 hv[4];
#pragma unroll
                for (int j = 0; j < 4; ++j) { const int c4 = lane + 64 * j; hv[j] = x[q][j] * rstd2 * A[256 + c4] + A[512 + c4]; }
                roww_store_bf16((GAS bf16*)(F.ws + WS_HN) + (size_t)m * DM, lane, hv); } }
    }
    __syncthreads();
}

__device__ __forceinline__ void frame_fence(Frame& F) {
    asm volatile("" : "+s"(F.ws), "+s"(F.out), "+s"(F.ctl));
    { int g = gridDim.x; asm volatile("" : "+s"(g)); const int bx = blockIdx.x; F.G = g; F.vcu = (g % 8 == 0) ? (bx % 8) * (g / 8) + bx / 8 : bx; }
    int t = threadIdx.x; asm volatile("" : "+v"(t)); F.tid = t; F.lane = t & 63; F.wave = __builtin_amdgcn_readfirstlane(t >> 6);
}
__device__ __forceinline__ void frame_group(Frame& F, int G_eff) { const int bx = blockIdx.x; F.G = G_eff; F.vcu = (G_eff % 8 == 0) ? (bx % 8) * (G_eff / 8) + bx / 8 : bx; }
constexpr int NCOMP = 176, NCONV = 256 - NCOMP;
constexpr int F8W_BAR0 = F8W_HOST0 + F8W_HOSTED * 2048 + F8W_IDLE * 1024;
__device__ __forceinline__ int f8w_bar_count(int wi) { return F8W_BARQ0 + ((wi >= 896) ? F8W_BARQ + 3 : F8W_BARQ - 3); }
__device__ __forceinline__ int f8w_bar_item(int wi, int i) {
    if (i < F8W_BARQ0) return F8W_HOST0 - F8W_BARQ0 * F8W_BARW + wi + F8W_BARW * i;
    return (wi < 896) ? (F8W_BAR0 + wi + 896 * (i - F8W_BARQ0)) : (F8W_BAR0 + 896 * (F8W_BARQ - 3) + (wi - 896) + 896 * (i - F8W_BARQ0)); }
__device__ __forceinline__ void xcd_barrier_host(const XcdBarrier& b, Frame& F, unsigned epoch) {
    asm volatile("s_waitcnt vmcnt(0)" ::: "memory");
    __syncthreads();
    volatile LAS unsigned* st = b.st;
    if (F.wave == 0) {
      if (threadIdx.x == 0) {
        unsigned* bar = b.bar;
        __builtin_amdgcn_s_waitcnt(0);
        unsigned nloc = b.st[0], nx = b.st[1];
        if (nloc == 0u) { xcd_barrier_complete(bar, b.x, nloc, nx); b.st[0] = nloc; b.st[1] = nx; }
        const unsigned old = xb_add(&bar[XB_XSUB(b.x)], 1u);
        const unsigned gen = old / nloc;
        if (old + 1u == (gen + 1u) * nloc) {
            __builtin_amdgcn_fence(__ATOMIC_RELEASE, "agent");
            asm volatile("s_waitcnt vmcnt(0)" ::: "memory");
            const unsigned og = xb_add(&bar[XB_TOP], 1u);
            const unsigned tg = og / nx;
            if (og + 1u == (tg + 1u) * nx) xb_add(&bar[XB_TOPGEN], 1u);
            else XB_SPIN(xb_ld(&bar[XB_TOPGEN]) == tg, bar);
            __builtin_amdgcn_fence(__ATOMIC_ACQUIRE, "agent");
            xb_add(&bar[XB_XGEN(b.x)], 1u);
            asm volatile("s_waitcnt vmcnt(0)" ::: "memory");
        } else {
            XB_SPIN(xb_ld(&bar[XB_XGEN(b.x)]) == gen, bar);
            __builtin_amdgcn_fence(__ATOMIC_ACQUIRE, "agent");
            asm volatile("s_waitcnt vmcnt(0)" ::: "memory");
        }
        st[2] = epoch;
      }
    } else {
        const int wv = F.wave, wi = (int)blockIdx.x * 7 + wv - 1;
        for (;;) {
            if (st[2] == epoch) break;
            const int i = (int)st[8 + wv];
            if (i >= f8w_bar_count(wi)) { __builtin_amdgcn_s_sleep(2); continue; }
            f8w_convert_one(F, f8w_bar_item(wi, i));
            if (F.lane == 0) st[8 + wv] = (unsigned)(i + 1);
            asm volatile("s_waitcnt lgkmcnt(0)" ::: "memory");
        }
    }
    __syncthreads();
}
__device__ __forceinline__ void f8w_bar_flush(Frame& F, volatile LAS unsigned* st, int upto) {
    if (F.wave == 0) return;
    const int wv = F.wave, wi = (int)blockIdx.x * 7 + wv - 1; int i = (int)st[8 + wv];
    if (upto > F8W_BARQ0) upto = f8w_bar_count(wi);
    if (i >= upto) return;
    for (; i < upto; ++i) f8w_convert_one(F, f8w_bar_item(wi, i));
    if (F.lane == 0) st[8 + wv] = (unsigned)upto;
}
struct Args { const float* in[28]; float* out; unsigned char* ws; int ph_lo, ph_hi; };
constexpr int PH_PER_LAYER = 10, N_PHASES = 2 + DEPTH * PH_PER_LAYER;
__global__ void __launch_bounds__(NTHR, 2) fwd_kernel(Args args) {
    extern __shared__ __attribute__((aligned(16))) unsigned char lds[];
    Frame F;
    F.lds = (LAS unsigned char*)lds;
    F.tid = threadIdx.x; F.lane = F.tid & 63; F.wave = __builtin_amdgcn_readfirstlane(F.tid >> 6);
    F.G = gridDim.x; { const int bx = blockIdx.x; F.vcu = (F.G % 8 == 0) ? (bx % 8) * (F.G / 8) + bx / 8 : bx; }
    F.ws = (GAS unsigned char*)args.ws; F.out = (GAS float*)args.out; F.ctl = (GAS unsigned*)(args.ws + WS_CTL);
    for (int u = F.tid; u < (LDS_BYTES - LDSCTL_OFF) / 4; u += NTHR) ((LAS unsigned*)(F.lds + LDSCTL_OFF))[u] = 0u;
    __syncthreads();
    if (F.tid == 0) {
#pragma unroll
        for (int i = 0; i < 28; ++i) ((LAS unsigned long long*)(F.lds + LDSCTL_OFF))[i] = (unsigned long long)args.in[i]; }
    __syncthreads();
    XcdBarrier bar = xcd_barrier_post((unsigned*)F.ctl + CW_BAR, (volatile LAS unsigned*)(F.lds + MISC_OFF) + 8);
    const int lo = args.ph_lo, hi = args.ph_hi;
    const bool hostbar = (gridDim.x == 256) && lo <= 0 && hi >= N_PHASES;
#ifndef PHMASK
#define PHMASK 0xFFF
#endif
#define EN(j) (((PHMASK) >> (j)) & 1)
#ifndef REPMASK
#define REPMASK 0
#endif
#define REPS(j) for (int rep_ = 0; rep_ < ((((REPMASK) >> (j)) & 1) ? 2 : 1); (++rep_, __syncthreads()))
#define IN(k) (lo <= (k) && (k) < hi)
#ifndef BARREP
#define BARREP 1
#endif
#define SEAM(k) do { if (IN(k) && IN((k) + 1)) { for (int br_ = 0; br_ < BARREP; ++br_) { XcdBarrier b2 = bar; asm volatile("" : "+s"(b2.bar), "+s"(b2.x)); \
        if (hostbar && (k) >= 1 && (k) <= 2 + PH_PER_LAYER + 5) xcd_barrier_host(b2, F, (unsigned)(k) + 1u); else xcd_barrier(b2); } } } while (0)

    if (EN(0) && IN(0)) REPS(0) { frame_fence(F); prologue0(F); }
    SEAM(0);
    if (EN(1) && IN(1)) REPS(1) { frame_fence(F); prologue1(F); }
    SEAM(1);
    for (int l = 0; l < DEPTH; ++l) {
        const int pb = 2 + l * PH_PER_LAYER;
        const bool split = false, conv_role = false;
        const int cidx = (int)blockIdx.x - NCOMP, ctot = (F8_NTILES - cidx + NCONV - 1) / NCONV, cq1 = 38, cq2 = 21;
        if (EN(2) && IN(pb + 0)) REPS(2) {
            frame_fence(F);
            if (conv_role) f8_convert_range(F, cidx, NCONV, cq1);
            else {
            if (split) frame_group(F, NCOMP);
            pg8::Gemm g{(const pg8::bf16_t*)(F.ws + WS_HN), (const pg8::bf16_t*)(F.ws + WS_WIN) + (size_t)l * NPROJ * DM, M, NPROJ, DM};
            pg8::StaticOrder S; S.init(M, NPROJ, F.G, (int)blockIdx.x);
            pg8::EpiBf16<0> E{(pg8::bf16_t*)(F.ws + WS_PROJ), NPROJ, nullptr, 0, 0, 1.f};
            pg8::gemm_phase<pg8::EpiBf16<0>, pg8::StaticOrder, true, true>(F.lds, g, S, E);
            if (l == 0 && F.G == 256 && (int)blockIdx.x >= 128) f8w_convert_idle(F);
            if (l == 1 && hostbar && (int)blockIdx.x >= 128) f8w_bar_flush(F, bar.st, F8W_BARQ0 + F8W_BARQ);
            }
        }
        SEAM(pb + 0);
        if (EN(3) && IN(pb + 1)) REPS(3) { frame_fence(F);
            if (conv_role) f8_convert_range(F, cidx + NCONV * cq1, NCONV, cq2);
            else { if (split) frame_group(F, NCOMP); phase_prep(F, l); } }
        SEAM(pb + 1);
        if (EN(4) && IN(pb + 2)) {
            frame_fence(F);
            if (conv_role) f8_convert_range(F, cidx + NCONV * (cq1 + cq2), NCONV, ctot - cq1 - cq2);
            else {
            if (split) frame_group(F, NCOMP);
            for (int it = blockIdx.x; it < 256; it += F.G) gla_scan_item(F, it);
            REPS(12) for (int it = F.vcu; it < 256; it += F.G) hy_conv_item(F, l, it);
            __syncthreads();
            float gq_ = fabsf(INP(F, I_QNORM)[l * 64 + F.lane]), gk_ = fabsf(INP(F, I_KNORM)[l * 64 + F.lane]);
            gq_ = fmaxf(gq_, dpp_f<DPP_X1>(gq_)); gq_ = fmaxf(gq_, dpp_f<DPP_X2>(gq_)); gq_ = fmaxf(gq_, dpp_f<DPP_HMIR>(gq_)); gq_ = fmaxf(gq_, dpp_f<DPP_MIR>(gq_)); gq_ = swap16_max(gq_); gq_ = swap32_max(gq_);
            gk_ = fmaxf(gk_, dpp_f<DPP_X1>(gk_)); gk_ = fmaxf(gk_, dpp_f<DPP_X2>(gk_)); gk_ = fmaxf(gk_, dpp_f<DPP_HMIR>(gk_)); gk_ = fmaxf(gk_, dpp_f<DPP_MIR>(gk_)); gk_ = swap16_max(gk_); gk_ = swap32_max(gk_);
            const float mfix = __uint_as_float(__builtin_amdgcn_readfirstlane(__float_as_uint(1.02f * ATT_C2 * 64.0f * gq_ * gk_)));
            const bool nomax = mfix <= 60.0f;
            REPS(13) for (int i = 0; ; ++i) { const int U = split ? F.vcu + F.G * i : 2 * F.vcu + i; if (U >= 512 || (!split && i >= 2)) break;
                    const int grp = U >> 6, j = U & 63, b = grp >> 1, h = (grp & 1) * 4 + (j >> 4), qb = j & 15;
                    if (nomax) attn_body::attn_unit<8, true>(b, h, qb, (const attn_body::bf16*)(F.ws + WS_QP), (const attn_body::bf16*)(F.ws + WS_KV), (const attn_body::bf16*)(F.ws + WS_KV) + 128,
                                            (attn_body::bf16*)(F.ws + WS_CAT) + 256, (char*)lds, mfix);
                    else attn_body::attn_unit<8>(b, h, qb, (const attn_body::bf16*)(F.ws + WS_QP), (const attn_body::bf16*)(F.ws + WS_KV), (const attn_body::bf16*)(F.ws + WS_KV) + 128,
                                            (attn_body::bf16*)(F.ws + WS_CAT) + 256, (char*)lds); }
            }
        }
        SEAM(pb + 2);
        if (EN(5) && IN(pb + 3)) REPS(5) { frame_fence(F); phase_mix_out(F, l); }
        SEAM(pb + 3);
        if (EN(6) && IN(pb + 4)) REPS(6) {
            frame_fence(F);
            pg8::Gemm g{(const pg8::bf16_t*)(F.ws + WS_CAT), (const pg8::bf16_t*)(F.ws + WS_WOUT) + (size_t)l * DM * DM, M, DM, DM};
            pg8::StaticOrder S; S.init(M, DM, F.G, (int)blockIdx.x);
            pg8::EpiBf16Row E{(pg8::bf16_t*)(F.ws + WS_Y), DM, nullptr, 1.0f};
            pg8::gemm_phase<pg8::EpiBf16Row, pg8::StaticOrder, true, true>(F.lds, g, S, E);
        }
        SEAM(pb + 4);
        if (EN(7) && IN(pb + 5)) { if (l == 0) { REPS(7) { frame_fence(F); phase_post_mix(F, l); } } else { frame_fence(F); phase_post_mix(F, l); } }
        SEAM(pb + 5);
        if (EN(8) && IN(pb + 6)) REPS(8) { frame_fence(F); phase_topk(F); }
        if (hostbar) { frame_fence(F); f8w_bar_flush(F, bar.st, l == 0 ? F8W_BARQ0 : F8W_BARQ0 + F8W_BARQ); }
        SEAM(pb + 6);
        if (EN(9) && IN(pb + 7)) REPS(9) {
            frame_fence(F);
            pg8::Gemm g{(const pg8::bf16_t*)(F.ws + WS_XG), (const pg8::bf16_t*)(F.ws + WS_WGU + (size_t)l * NEXP * 5632 * DM), NEXP * EROWS, NEXP * 5632, DM / 2};
            pg8::MoeOrder S; S.init(22, F.G, F.vcu);
            pg8::EpiSwiGLU8 E{(unsigned char*)(F.ws + WS_H), FF / 128, 1.0f / W8_SCALE};
            pg8::gemm_phase<pg8::EpiSwiGLU8, pg8::MoeOrder, true, true, true, true>(F.lds, g, S, E);
        }
        SEAM(pb + 7);
        if (EN(10) && IN(pb + 8)) REPS(10) {
            frame_fence(F);
            pg8::Gemm g{(const pg8::bf16_t*)(F.ws + WS_H), (const pg8::bf16_t*)(F.ws + WS_WD + (size_t)l * NEXP * DM * FF), NEXP * EROWS, NEXP * DM, FF / 2};
            pg8::MoeOrder S; S.init(4, F.G, F.vcu);
            pg8::EpiBf16Row E{(pg8::bf16_t*)(F.ws + WS_YE), DM, (const float*)(F.ws + WS_GATE), 1.0f / W8_SCALE};
            pg8::gemm_phase<pg8::EpiBf16Row, pg8::MoeOrder, true, true, true, true, true>(F.lds, g, S, E);
        }
        SEAM(pb + 8);
        if (EN(11) && IN(pb + 9)) { frame_fence(F); phase_combine(F, l); }
        SEAM(pb + 9);
    }
#undef IN
#undef SEAM
}

#ifndef MK_N_LAUNCHES
#define MK_N_LAUNCHES 1
#endif
extern "C" void kernel_launch(void* const* d_in, const int* in_sizes, int n_in, void* d_out, int out_size, void* d_ws, size_t ws_size, hipStream_t stream) {
    static int grid = 0;
    if (grid == 0) {
        if (n_in != 28 || out_size != M * DM || ws_size < WS_END) { fprintf(stderr, "kernel_launch: unexpected shapes (n_in %d, out %d, ws %zu < %zu); nothing launched\n", n_in, out_size, ws_size, (size_t)WS_END); grid = -1; return; }
        int dev = 0, cus = 0, per_cu = 0;
        if (hipGetDevice(&dev) != hipSuccess || hipDeviceGetAttribute(&cus, hipDeviceAttributeMultiprocessorCount, dev) != hipSuccess) { grid = -1; return; }
        if (hipFuncSetAttribute((const void*)fwd_kernel, hipFuncAttributeMaxDynamicSharedMemorySize, LDS_BYTES) != hipSuccess) { fprintf(stderr, "kernel_launch: hipFuncSetAttribute failed\n"); grid = -1; return; }
        if (hipOccupancyMaxActiveBlocksPerMultiprocessor(&per_cu, (const void*)fwd_kernel, NTHR, LDS_BYTES) != hipSuccess || per_cu < 1) fprintf(stderr, "kernel_launch: occupancy query says %d\n", per_cu);
        (void)hipGetLastError();
        grid = cus;
    }
    if (grid < 0) return;
    (void)hipMemsetAsync((char*)d_ws + WS_CTL, 0, CTL_ZERO_BYTES, stream);
    Args a{};
    for (int i = 0; i < 28; ++i) a.in[i] = (const float*)d_in[i];
    a.out = (float*)d_out; a.ws = (unsigned char*)d_ws;
#if MK_N_LAUNCHES == 1
    a.ph_lo = 0; a.ph_hi = N_PHASES;
    hipLaunchKernelGGL(fwd_kernel, dim3(grid), dim3(NTHR), LDS_BYTES, stream, a);
#else
    for (int p = 0; p < N_PHASES; ++p) { a.ph_lo = p; a.ph_hi = p + 1; hipLaunchKernelGGL(fwd_kernel, dim3(grid), dim3(NTHR), LDS_BYTES, stream, a); }
#endif
}
```

```cpp
#include <hip/hip_runtime.h>
#include <hip/hip_bf16.h>
#include <cstdio>
#include <cstdint>
#include <cmath>
namespace pg8 {
#define PG8_LAS __attribute__((address_space(3)))
typedef unsigned short bf16_t;
typedef short bf16x8 __attribute__((ext_vector_type(8)));
typedef float f32x4 __attribute__((ext_vector_type(4)));
typedef unsigned u32x4 __attribute__((ext_vector_type(4)));
constexpr int BM = 256, BK = 64, HALF = 128, HTB = HALF * BK * 2  , STAGE_BYTES = 8 * HTB, NXCD = 8, WGM = 8;

__host__ __device__ __forceinline__ int lds_byte(int r, int c) { const int st = (r >> 4) * 2 + (c >> 5), rr = r & 15, cc = c & 31, ob = rr * 64 + cc * 2; return st * 1024 + (ob ^ (((ob >> 9) & 1) << 5)); }
__host__ __device__ __forceinline__ void stage_rc(int b, int& R, int& C) { const int st = b / 1024, sb = b % 1024, swz = sb ^ (((sb >> 9) & 1) << 5); R = (st >> 1) * 16 + swz / 64; C = (st & 1) * 32 + (swz % 64) / 2; }
__host__ __device__ __forceinline__ int perm32(int rho) { const int n = rho >> 4, i = rho & 15; return 8 * (i >> 2) + 4 * n + (i & 3); }

struct Unit { int pm, pn, pc; };
struct Gemm { const bf16_t* A; const bf16_t* Bt; int M, N, K; };

struct StaticOrder {
    int nM, nN, nwg, G, c;
    __host__ __device__ void init(int M, int N, int G_, int c_) { nM = M / BM; nN = N / BM; nwg = nM * nN; G = G_; c = c_; }
    __host__ __device__ bool next(int i, Unit& u) const {
        const long L = (long)i * G + c; if (L >= nwg) return false;
        int wgid = (int)L; { const int q = nwg / NXCD, r = nwg % NXCD, xcd = wgid % NXCD, off = wgid / NXCD; wgid = (xcd < r ? xcd * (q + 1) : r * (q + 1) + (xcd - r) * q) + off; }
        const int nig = WGM * nN, gid = wgid / nig, fm = gid * WGM, gsz = (nM - fm) < WGM ? (nM - fm) : WGM;
        u.pm = fm + ((wgid % nig) % gsz); u.pn = (wgid % nig) / gsz; u.pc = u.pn; return true;
    }
    __device__ __forceinline__ void a_ready(const Unit&) const {}
    __device__ __forceinline__ void done(const Unit&) const {}
};

__device__ __forceinline__ unsigned cvt_pk_bf16(float lo, float hi) { unsigned r; asm volatile("v_cvt_pk_bf16_f32 %0, %1, %2" : "=v"(r) : "v"(lo), "v"(hi)); return r; }
typedef float f32x2 __attribute__((ext_vector_type(2)));
__device__ __forceinline__ f32x2 gelu_pk(f32x2 v) {
    const f32x2 av = __builtin_elementwise_abs(v), d = av * 0.2316418882f + 1.0f;
    f32x2 t; t.x = __builtin_amdgcn_rcpf(d.x); t.y = __builtin_amdgcn_rcpf(d.y);
    f32x2 q = t * 0.5307027145f + (-0.7265760135f); q = q * t + 0.7107068705f; q = q * t + (-0.142248368f); q = q * t + 0.127414796f; q = q * t;
    const f32x2 s = (v * v) * (-0.72134752044f);
    f32x2 e; e.x = __builtin_amdgcn_exp2f(s.x); e.y = __builtin_amdgcn_exp2f(s.y);
    const f32x2 m = v * (q * e), r = v - m;
    f32x2 o; o.x = v.x < 0.f ? m.x : r.x; o.y = v.y < 0.f ? m.y : r.y; return o;
}

template <int ACT  > struct EpiBf16 {
    static constexpr bool PERM = true, AFTER_DRAIN = false; static_assert(ACT == 0 || ACT == 1, "EpiBf16: ACT is 0 (none) or 1 (gelu_pk)");
    bf16_t* O; int ldc; const float* bias; int split_cols; size_t split_stride; float scale0;
    __device__ __forceinline__ void operator()(const f32x4 (&acc)[2][2][4][2], const Unit& u, int wr, int wc, int fr, int fq) const {
        const int row0 = u.pm * BM + wr * 64 + fr; int colt = u.pc * BM; bf16_t* base = O;
        float sc = 1.f; if (split_cols) { const int t = colt / split_cols; base += (size_t)t * split_stride; colt -= t * split_cols; if (t == 0) sc = scale0; }
        const int col0 = colt + wc * 32 + 8 * fq, bcol0 = u.pc * BM + wc * 32 + 8 * fq;
        f32x4 bv[2][2];
#pragma unroll
        for (int bj = 0; bj < 2; ++bj)
#pragma unroll
            for (int n = 0; n < 2; ++n) bv[bj][n] = bias ? *(const f32x4*)(bias + bcol0 + bj * HALF + 4 * n) : (f32x4){0.f, 0.f, 0.f, 0.f};
#pragma unroll
        for (int ai = 0; ai < 2; ++ai)
#pragma unroll
            for (int m = 0; m < 4; ++m) { bf16_t* rowp = base + (size_t)(row0 + ai * HALF + m * 16) * ldc + col0;
#pragma unroll
                for (int bj = 0; bj < 2; ++bj) { f32x4 v0 = acc[ai][bj][m][0] + bv[bj][0], v1 = acc[ai][bj][m][1] + bv[bj][1];
                    if (ACT == 1) { f32x2 a = gelu_pk((f32x2){v0[0], v0[1]}), b = gelu_pk((f32x2){v0[2], v0[3]}), c = gelu_pk((f32x2){v1[0], v1[1]}), d = gelu_pk((f32x2){v1[2], v1[3]});
                        v0 = (f32x4){a.x, a.y, b.x, b.y}; v1 = (f32x4){c.x, c.y, d.x, d.y}; }
                    v0 = v0 * sc; v1 = v1 * sc; u32x4 w; w.x = cvt_pk_bf16(v0[0], v0[1]); w.y = cvt_pk_bf16(v0[2], v0[3]); w.z = cvt_pk_bf16(v1[0], v1[1]); w.w = cvt_pk_bf16(v1[2], v1[3]);
                    *(u32x4*)(rowp + bj * HALF) = w; } }
    }
};

struct EpiF32 {
    static constexpr bool PERM = false, AFTER_DRAIN = false;
    float* O; int ldc; const float* rowscale; float mul;
    __device__ __forceinline__ void operator()(const f32x4 (&acc)[2][2][4][2], const Unit& u, int wr, int wc, int fr, int fq) const {
        const int row0 = u.pm * BM + wr * 64 + fr, col0 = u.pc * BM + wc * 32 + 4 * fq;
#pragma unroll
        for (int ai = 0; ai < 2; ++ai)
#pragma unroll
            for (int m = 0; m < 4; ++m) { const int row = row0 + ai * HALF + m * 16; const float s = (rowscale ? rowscale[row] : 1.f) * mul; float* rowp = O + (size_t)row * ldc + col0;
#pragma unroll
                for (int bj = 0; bj < 2; ++bj)
#pragma unroll
                    for (int n = 0; n < 2; ++n) *(f32x4*)(rowp + bj * HALF + n * 16) = acc[ai][bj][m][n] * s; }
    }
};
struct EpiBf16Row {
    static constexpr bool PERM = true, AFTER_DRAIN = false;
    bf16_t* O; int ldc; const float* rowscale; float mul;
    __device__ __forceinline__ void operator()(const f32x4 (&acc)[2][2][4][2], const Unit& u, int wr, int wc, int fr, int fq) const {
        const int row0 = u.pm * BM + wr * 64 + fr, col0 = u.pc * BM + wc * 32 + 8 * fq;
#pragma unroll
        for (int ai = 0; ai < 2; ++ai)
#pragma unroll
            for (int m = 0; m < 4; ++m) { const int row = row0 + ai * HALF + m * 16; const float s = (rowscale ? rowscale[row] : 1.f) * mul; bf16_t* rowp = O + (size_t)row * ldc + col0;
#pragma unroll
                for (int bj = 0; bj < 2; ++bj) { const f32x4 v0 = acc[ai][bj][m][0] * s, v1 = acc[ai][bj][m][1] * s;
                    u32x4 w; w.x = cvt_pk_bf16(v0[0], v0[1]); w.y = cvt_pk_bf16(v0[2], v0[3]); w.z = cvt_pk_bf16(v1[0], v1[1]); w.w = cvt_pk_bf16(v1[2], v1[3]);
                    *(u32x4*)(rowp + bj * HALF) = w; } }
    }
};
__device__ __forceinline__ float silu_mul(float g, float u) { return g * u * __builtin_amdgcn_rcpf(1.0f + __builtin_amdgcn_exp2f(-1.44269504089f * g)); }
struct EpiSwiGLU {
    static constexpr bool PERM = true, AFTER_DRAIN = false;
    bf16_t* O; int ldc;
    __device__ __forceinline__ void operator()(const f32x4 (&acc)[2][2][4][2], const Unit& u, int wr, int wc, int fr, int fq) const {
        const int row0 = u.pm * BM + wr * 64 + fr, col0 = u.pc * HALF + wc * 32 + 8 * fq;
#pragma unroll
        for (int ai = 0; ai < 2; ++ai)
#pragma unroll
            for (int m = 0; m < 4; ++m) { bf16_t* rowp = O + (size_t)(row0 + ai * HALF + m * 16) * ldc + col0;
                const f32x4 g0 = acc[ai][0][m][0], g1 = acc[ai][0][m][1], u0 = acc[ai][1][m][0], u1 = acc[ai][1][m][1];
                u32x4 w; w.x = cvt_pk_bf16(silu_mul(g0[0], u0[0]), silu_mul(g0[1], u0[1])); w.y = cvt_pk_bf16(silu_mul(g0[2], u0[2]), silu_mul(g0[3], u0[3]));
                w.z = cvt_pk_bf16(silu_mul(g1[0], u1[0]), silu_mul(g1[1], u1[1])); w.w = cvt_pk_bf16(silu_mul(g1[2], u1[2]), silu_mul(g1[3], u1[3]));
                *(u32x4*)rowp = w; }
    }
};
__device__ __forceinline__ unsigned pk4_fp8(float a, float b, float c, float d) {
    a = __builtin_amdgcn_fmed3f(a, -448.f, 448.f); b = __builtin_amdgcn_fmed3f(b, -448.f, 448.f); c = __builtin_amdgcn_fmed3f(c, -448.f, 448.f); d = __builtin_amdgcn_fmed3f(d, -448.f, 448.f);
    unsigned r = 0u; r = __builtin_amdgcn_cvt_pk_fp8_f32(a, b, r, false); r = __builtin_amdgcn_cvt_pk_fp8_f32(c, d, r, true); return r; }
struct EpiSwiGLU8 {
    static constexpr bool PERM = true, AFTER_DRAIN = false;
    unsigned char* O; int ntk; float isc;
    __device__ __forceinline__ f32x2 silu_mul2(f32x2 G, f32x2 U, float ka, float ks) const {
        const f32x2 a = G * ka; f32x2 ex; ex.x = __builtin_amdgcn_exp2f(a.x); ex.y = __builtin_amdgcn_exp2f(a.y);
        const f32x2 d = ex * ks + ks; f32x2 r; r.x = __builtin_amdgcn_rcpf(d.x); r.y = __builtin_amdgcn_rcpf(d.y);
        return (G * U) * r; }
    __device__ __forceinline__ void operator()(const f32x4 (&acc)[2][2][4][2], const Unit& u, int wr, int wc, int fr, int fq) const {
        typedef unsigned u32x2 __attribute__((ext_vector_type(2)));
        const int c = wc * 32 + 8 * fq;
        unsigned char* blk = O + ((size_t)u.pm * ntk + u.pc) * 32768 + (c >> 6) * 16384 + (c & 63) + (size_t)(wr * 64 + fr) * 64;
        const float ka = -1.44269504089f * isc, ks = 1.0f / (isc * isc);
#pragma unroll
        for (int ai = 0; ai < 2; ++ai)
#pragma unroll
            for (int m = 0; m < 4; ++m) { unsigned char* rowp = blk + (ai * HALF + m * 16) * 64;
                const f32x4 g0 = acc[ai][0][m][0], g1 = acc[ai][0][m][1], u0 = acc[ai][1][m][0], u1 = acc[ai][1][m][1];
                const f32x2 h0 = silu_mul2((f32x2){g0[0], g0[1]}, (f32x2){u0[0], u0[1]}, ka, ks), h1 = silu_mul2((f32x2){g0[2], g0[3]}, (f32x2){u0[2], u0[3]}, ka, ks);
                const f32x2 h2 = silu_mul2((f32x2){g1[0], g1[1]}, (f32x2){u1[0], u1[1]}, ka, ks), h3 = silu_mul2((f32x2){g1[2], g1[3]}, (f32x2){u1[2], u1[3]}, ka, ks);
                u32x2 w; w.x = pk4_fp8(h0.x, h0.y, h1.x, h1.y); w.y = pk4_fp8(h2.x, h2.y, h3.x, h3.y);
                *(u32x2*)rowp = w; __builtin_amdgcn_sched_barrier(0); }
    }
};
struct EpiF8Row {
    static constexpr bool PERM = true, AFTER_DRAIN = false;
    unsigned char* O; int ldc; const float* rowscale; float mul;
    __device__ __forceinline__ void operator()(const f32x4 (&acc)[2][2][4][2], const Unit& u, int wr, int wc, int fr, int fq) const {
        typedef unsigned u32x2 __attribute__((ext_vector_type(2)));
        const int row0 = u.pm * BM + wr * 64 + fr, col0 = u.pc * BM + wc * 32 + 8 * fq;
#pragma unroll
        for (int ai = 0; ai < 2; ++ai)
#pragma unroll
            for (int m = 0; m < 4; ++m) { const int row = row0 + ai * HALF + m * 16; const float s = (rowscale ? rowscale[row] : 1.f) * mul; unsigned char* rowp = O + (size_t)row * ldc + col0;
#pragma unroll
                for (int bj = 0; bj < 2; ++bj) { const f32x4 v0 = acc[ai][bj][m][0] * s, v1 = acc[ai][bj][m][1] * s;
                    u32x2 w; w.x = pk4_fp8(v0[0], v0[1], v0[2], v0[3]); w.y = pk4_fp8(v1[0], v1[1], v1[2], v1[3]);
                    *(u32x2*)(rowp + bj * HALF) = w; } }
    }
};
struct MoeOrder {
    int npn, per_e, total, G, c;
    __host__ __device__ void init(int npn_, int G_, int c_) { npn = npn_; per_e = 8 * npn_; total = 16 * per_e; G = G_; c = c_; }
    __host__ __device__ bool next(int i, Unit& u) const {
        const long L = (long)i * G + c; if (L >= total) return false;
        const int e = (int)L / per_e, r = (int)L % per_e; u.pm = 8 * e + (r & 7); u.pc = r >> 3; u.pn = npn * e + u.pc; return true;
    }
    __device__ __forceinline__ void a_ready(const Unit&) const {}
    __device__ __forceinline__ void done(const Unit&) const {}
};

typedef int pg8_v4i __attribute__((ext_vector_type(4)));
typedef int pg8_v8i __attribute__((ext_vector_type(8)));
__device__ __forceinline__ pg8_v8i cat8(bf16x8 lo, bf16x8 hi) { return __builtin_shufflevector(__builtin_bit_cast(pg8_v4i, lo), __builtin_bit_cast(pg8_v4i, hi), 0, 1, 2, 3, 4, 5, 6, 7); }
__device__ __forceinline__ void mfma_f8_inplace(f32x4& acc, pg8_v8i a, pg8_v8i b) { asm volatile("v_mfma_f32_16x16x128_f8f6f4 %0, %1, %2, %0" : "+v"(acc) : "v"(a), "v"(b)); }
template <class Epi, class Sched, bool ALIGN_EPI = false, bool SP2 = false, bool F8 = false, bool BTILED = false, bool ATILED = false>
__device__ __forceinline__ void gemm_phase(PG8_LAS unsigned char* lds, const Gemm g, const Sched& S, const Epi& E) {
    int tid_ = threadIdx.x; asm volatile("" : "+v"(tid_));
    const int tid = tid_, wid = __builtin_amdgcn_readfirstlane(tid >> 6), lane = tid & 63, wr = wid >> 2, wc = wid & 3, fr = lane & 15, fq = lane >> 4;
    const int K = g.K, nt = K / BK;
    unsigned voffA[2], voffB[2];
#pragma unroll
    for (int i = 0; i < 2; ++i) { int R, C; stage_rc(tid * 16 + i * 8192, R, C); const int Rb = Epi::PERM ? ((R & ~31) + perm32(R & 31)) : R;
        voffA[i] = ATILED ? (unsigned)((C >> 5) * 16384 + R * 64 + (C & 31) * 2) : (unsigned)(R * K + C) * 2u; voffB[i] = BTILED ? (unsigned)((C >> 5) * 16384 + Rb * 64 + (C & 31) * 2) : (unsigned)(Rb * K + C) * 2u; }
    const size_t kstep = (size_t)(BK * 2);
    const size_t hstep = (size_t)HALF * K * 2;
    const size_t tstep = 2 * hstep;
    const size_t kstepB = BTILED ? (size_t)32768 : kstep, hstepB = BTILED ? (size_t)8192 : hstep;
    const size_t kstepA = ATILED ? (size_t)32768 : kstep, hstepA = ATILED ? (size_t)8192 : hstep;
    const unsigned ldsw = (unsigned)wid * 1024u;
    const int aoff = lds_byte(wr * 64 + fr, fq * 8), boff = lds_byte(wc * 32 + fr, fq * 8);
#define PG8_SA(b, h) (((b) * 2 + (h)) * HTB)
#define PG8_SB(b, h) ((4 + (b) * 2 + (h)) * HTB)
#define PG8_STAGE(bufoff, gbase, voff) do { _Pragma("unroll") for (int _i = 0; _i < 2; ++_i) \
        __builtin_amdgcn_global_load_lds((const unsigned*)((const char*)(gbase) + (voff)[_i]), (PG8_LAS unsigned*)(lds + (bufoff) + ldsw + _i * 8192), 16, 0, 0); } while (0)
#define PG8_LDA(dst, b, h) do { _Pragma("unroll") for (int m = 0; m < 4; ++m) _Pragma("unroll") for (int k = 0; k < 2; ++k) dst[m][k] = *(const PG8_LAS bf16x8*)(lds + PG8_SA(b, h) + aoff + m * 2048 + k * 1024); } while (0)
#define PG8_LDB(dst, b, h) do { _Pragma("unroll") for (int n = 0; n < 2; ++n) _Pragma("unroll") for (int k = 0; k < 2; ++k) dst[n][k] = *(const PG8_LAS bf16x8*)(lds + PG8_SB(b, h) + boff + n * 2048 + k * 1024); } while (0)
#define PG8_MMA(ai, bj, At, Bt) do { __builtin_amdgcn_s_setprio(1); _Pragma("unroll") for (int m = 0; m < 4; ++m) _Pragma("unroll") for (int n = 0; n < 2; ++n) { \
        if constexpr (F8) mfma_f8_inplace(acc[ai][bj][m][n], cat8(Bt[n][0], Bt[n][1]), cat8(At[m][0], At[m][1])); \
        else { _Pragma("unroll") for (int k = 0; k < 2; ++k) acc[ai][bj][m][n] = __builtin_amdgcn_mfma_f32_16x16x32_bf16(Bt[n][k], At[m][k], acc[ai][bj][m][n], 0, 0, 0); } } \
        __builtin_amdgcn_s_setprio(0); } while (0)
#define PG8_WAIT_V(n) asm volatile("s_waitcnt vmcnt(" #n ")" ::: "memory")
#define PG8_WAIT_L(n) asm volatile("s_waitcnt lgkmcnt(" #n ")" ::: "memory")
#define PG8_BAR __builtin_amdgcn_s_barrier()
#define PG8_SCHED __builtin_amdgcn_sched_barrier(0)
    Unit cur, nxt; int ui = 0;
    if (!S.next(0, cur)) return;
    f32x4 acc[2][2][4][2];
#pragma unroll
    for (int a = 0; a < 2; ++a)
#pragma unroll
        for (int b = 0; b < 2; ++b)
#pragma unroll
            for (int m = 0; m < 4; ++m)
#pragma unroll
                for (int n = 0; n < 2; ++n) acc[a][b][m][n] = (f32x4){0.f, 0.f, 0.f, 0.f};
    bf16x8 At[4][2], B0[2][2], B1[2][2];
    const char* cA = (const char*)g.A + (size_t)cur.pm * tstep; const char* cB = (const char*)g.Bt + (size_t)cur.pn * tstep;
    S.a_ready(cur);
    if constexpr (SP2) {
        PG8_STAGE(PG8_SB(0, 0), cB, voffB); PG8_STAGE(PG8_SB(0, 1), cB + hstepB, voffB); PG8_STAGE(PG8_SA(0, 0), cA, voffA); PG8_STAGE(PG8_SA(0, 1), cA + hstepA, voffA);
        if (wr == 1) PG8_BAR;
        PG8_WAIT_V(2); PG8_BAR;
        PG8_STAGE(PG8_SB(1, 0), cB + kstepB, voffB); PG8_STAGE(PG8_SA(1, 0), cA + kstepA, voffA); PG8_STAGE(PG8_SB(1, 1), cB + hstepB + kstepB, voffB);
        PG8_WAIT_V(6); PG8_BAR;
    } else {
        PG8_STAGE(PG8_SB(0, 0), cB, voffB); PG8_STAGE(PG8_SA(0, 0), cA, voffA); PG8_STAGE(PG8_SB(0, 1), cB + hstepB, voffB); PG8_STAGE(PG8_SA(0, 1), cA + hstepA, voffA);
        if (wr == 1) PG8_BAR;
        PG8_WAIT_V(4); PG8_BAR;
        PG8_STAGE(PG8_SB(1, 0), cB + kstepB, voffB); PG8_STAGE(PG8_SA(1, 0), cA + kstepA, voffA); PG8_STAGE(PG8_SB(1, 1), cB + hstepB + kstepB, voffB);
        PG8_WAIT_V(6); PG8_BAR;
    }
    for (;;) {
        const bool has_next = S.next(ui + 1, nxt);
        const char* nA = has_next ? (const char*)g.A + (size_t)nxt.pm * tstep : cA; const char* nB = has_next ? (const char*)g.Bt + (size_t)nxt.pn * tstep : cB;
#pragma unroll 1
        for (int t = 0; t < nt; t += 2) {
            const bool last = (t == nt - 2);
            const char* a1 = cA + (size_t)(t + 1) * kstepA;
            const char* a2 = last ? nA : cA + (size_t)(t + 2) * kstepA; const char* b2 = last ? nB : cB + (size_t)(t + 2) * kstepB;
            const char* a3 = a2 + kstepA; const char* b3 = b2 + kstepB;
            if (last && has_next) S.a_ready(nxt);
            if constexpr (SP2) {
            PG8_LDB(B0, 0, 0); PG8_LDB(B1, 0, 1); PG8_SCHED; PG8_LDA(At, 0, 0); PG8_STAGE(PG8_SA(1, 1), a1 + hstepA, voffA);
            PG8_WAIT_V(8); PG8_WAIT_L(0); PG8_BAR; PG8_MMA(0, 0, At, B0); PG8_MMA(0, 1, At, B1); PG8_BAR; PG8_SCHED;
            PG8_LDA(At, 0, 1); PG8_STAGE(PG8_SB(0, 0), b2, voffB); PG8_STAGE(PG8_SB(0, 1), b2 + hstepB, voffB); PG8_STAGE(PG8_SA(0, 0), a2, voffA);
            PG8_WAIT_V(8); PG8_WAIT_L(0); PG8_BAR; PG8_MMA(1, 0, At, B0); PG8_MMA(1, 1, At, B1); PG8_BAR; PG8_SCHED;
            PG8_LDB(B0, 1, 0); PG8_LDB(B1, 1, 1); PG8_SCHED; PG8_LDA(At, 1, 0); PG8_STAGE(PG8_SA(0, 1), a2 + hstepA, voffA);
            PG8_WAIT_V(8); PG8_WAIT_L(0); PG8_BAR; PG8_MMA(0, 0, At, B0); PG8_MMA(0, 1, At, B1); PG8_BAR; PG8_SCHED;
            PG8_LDA(At, 1, 1); PG8_STAGE(PG8_SB(1, 0), b3, voffB); PG8_STAGE(PG8_SB(1, 1), b3 + hstepB, voffB); PG8_STAGE(PG8_SA(1, 0), a3, voffA);
            PG8_WAIT_V(8); PG8_WAIT_L(0); PG8_BAR; PG8_MMA(1, 0, At, B0); PG8_MMA(1, 1, At, B1); PG8_BAR; PG8_SCHED;
            } else {
            PG8_LDB(B0, 0, 0); PG8_SCHED; PG8_LDA(At, 0, 0); PG8_STAGE(PG8_SA(1, 1), a1 + hstepA, voffA);
            PG8_WAIT_L(8); PG8_BAR; PG8_WAIT_L(0); PG8_MMA(0, 0, At, B0); PG8_BAR; PG8_SCHED;
            PG8_LDB(B1, 0, 1); PG8_STAGE(PG8_SB(0, 0), b2, voffB);
            PG8_BAR; PG8_WAIT_L(0); PG8_MMA(0, 1, At, B1); PG8_BAR;
            PG8_LDA(At, 0, 1); PG8_STAGE(PG8_SA(0, 0), a2, voffA);
            PG8_BAR; PG8_WAIT_L(0); PG8_MMA(1, 0, At, B0); PG8_BAR; PG8_SCHED;
            PG8_STAGE(PG8_SB(0, 1), b2 + hstepB, voffB);
            PG8_WAIT_V(6); PG8_BAR; PG8_MMA(1, 1, At, B1); PG8_BAR;
            PG8_LDB(B0, 1, 0); PG8_SCHED; PG8_LDA(At, 1, 0); PG8_STAGE(PG8_SA(0, 1), a2 + hstepA, voffA);
            PG8_WAIT_L(8); PG8_BAR; PG8_WAIT_L(0); PG8_MMA(0, 0, At, B0); PG8_BAR; PG8_SCHED;
            PG8_LDB(B1, 1, 1); PG8_STAGE(PG8_SB(1, 0), b3, voffB);
            PG8_BAR; PG8_WAIT_L(0); PG8_MMA(0, 1, At, B1); PG8_BAR;
            PG8_LDA(At, 1, 1); PG8_STAGE(PG8_SA(1, 0), a3, voffA);
            PG8_BAR; PG8_WAIT_L(0); PG8_MMA(1, 0, At, B0); PG8_BAR; PG8_SCHED;
            PG8_STAGE(PG8_SB(1, 1), b3 + hstepB, voffB);
            PG8_WAIT_V(6); PG8_BAR; PG8_MMA(1, 1, At, B1); PG8_BAR;
            }
        }
        if constexpr (ALIGN_EPI) { if (wr == 0) PG8_BAR; }
        if constexpr (F8) asm volatile("s_nop 15\n\ts_nop 15" ::: "memory");
        if constexpr (!Epi::AFTER_DRAIN) { E(acc, cur, wr, wc, fr, fq); S.done(cur); }
        if (!has_next) break;
#pragma unroll
        for (int a = 0; a < 2; ++a)
#pragma unroll
            for (int b = 0; b < 2; ++b)
#pragma unroll
                for (int m = 0; m < 4; ++m)
#pragma unroll
                    for (int n = 0; n < 2; ++n) acc[a][b][m][n] = (f32x4){0.f, 0.f, 0.f, 0.f};
        cur = nxt; cA = nA; cB = nB; ++ui;
        if constexpr (ALIGN_EPI) { if (wr == 1) PG8_BAR; }
    }
    PG8_WAIT_V(0);
    if constexpr (!ALIGN_EPI) { if (wr == 0) PG8_BAR; }
    PG8_BAR;
    if constexpr (Epi::AFTER_DRAIN) { E.fused(acc, cur, wr, wc, fr, fq, lds, wid, lane); S.done(cur); }
#undef PG8_SA
#undef PG8_SB
#undef PG8_STAGE
#undef PG8_LDA
#undef PG8_LDB
#undef PG8_MMA
#undef PG8_WAIT_V
#undef PG8_WAIT_L
#undef PG8_BAR
#undef PG8_SCHED
}
}
namespace attn_body {
using bf16=__hip_bfloat16;
using bf16x8=__attribute__((ext_vector_type(8)))short;
using s16x4=__attribute__((ext_vector_type(4)))short;
using f32x16=__attribute__((ext_vector_type(16)))float;
using u32x4=__attribute__((ext_vector_type(4)))unsigned;
constexpr int BATCH=4,NHEAD=8,SEQ=4096,D=64,QP=512,KVP=256,OP=1024;
constexpr int NW=8,QBLK=32,QB=QBLK*NW,KVBLK=64,NQB=SEQ/QB;
constexpr int ATTN_UNIT_ROWS=QB;
__device__ __forceinline__ int crow(int r,int hi){return (r&3)+8*(r>>2)+4*hi;}
#define SBAR() __builtin_amdgcn_sched_barrier(0)
__device__ __forceinline__ void cmask(f32x16&p0,f32x16&p1,int jb,int qrel,int hi){
  const float NEG=-INFINITY; int kb=64*jb+4*hi;
  #pragma unroll
  for(int r=0;r<16;++r){int kv=kb+(r&3)+8*(r>>2); if(kv>qrel)p0[r]=NEG; if(kv+32>qrel)p1[r]=NEG;}
}

constexpr int NSLOT=3, SLOTB=8192;
constexpr int LDS_K=0, LDS_V=NSLOT*SLOTB, LDS_WS=2*NSLOT*SLOTB, LDS_OST=LDS_WS+NW*64*4, LDS_BYTES=LDS_OST+NW*4096;
constexpr float C2=0.125f*1.4426950408889634f;
__device__ __forceinline__ void glds16(const void*gsrc,unsigned lds_dst){unsigned keep;
  asm volatile("s_mov_b32 %0, m0\n\ts_mov_b32 m0, %2\n\ts_nop 0\n\tglobal_load_lds_dwordx4 %1, off\n\ts_mov_b32 m0, %0":"=&s"(keep):"v"(gsrc),"s"(lds_dst):"memory");}
__device__ __forceinline__ float max3f(float a,float b,float c){float r;asm("v_max3_f32 %0, %1, %2, %3":"=v"(r):"v"(a),"v"(b),"v"(c));return r;}
__device__ __forceinline__ float max2f(float a,float b){float r;asm("v_max_f32_e32 %0, %1, %2":"=v"(r):"v"(a),"v"(b));return r;}
__device__ __forceinline__ float fadd_s(float a,float b){float r;asm("v_add_f32_e32 %0, %1, %2":"=v"(r):"v"(a),"v"(b));return r;}
__device__ __forceinline__ float fsub_s(float a,float b){float r;asm("v_sub_f32_e32 %0, %1, %2":"=v"(r):"v"(a),"v"(b));return r;}
typedef float f32x2_t __attribute__((ext_vector_type(2))); typedef __bf16 bf16x2_t __attribute__((ext_vector_type(2)));
__device__ __forceinline__ unsigned cvtpk_s(float lo,float hi){f32x2_t v={lo,hi};bf16x2_t b=__builtin_convertvector(v,bf16x2_t);return __builtin_bit_cast(unsigned,b);}
#define WAIT_BAR(N) asm volatile("s_waitcnt vmcnt(" #N ") lgkmcnt(0)\n\ts_barrier":::"memory")

__device__ __forceinline__ void qkt(f32x16&p0,f32x16&p1,const char*Kslot,const bf16x8*qr,const f32x16&negm,int r32,int hi){
  const char*kb=Kslot+hi*1024+r32*16;
  #pragma unroll
  for(int d0=0;d0<4;++d0){
    const bf16x8 b0=*reinterpret_cast<const bf16x8*>(kb+d0*2048);
    const bf16x8 b1=*reinterpret_cast<const bf16x8*>(kb+d0*2048+512);
    if(d0==0){p0=__builtin_amdgcn_mfma_f32_32x32x16_bf16(b0,qr[0],negm,0,0,0);p1=__builtin_amdgcn_mfma_f32_32x32x16_bf16(b1,qr[0],negm,0,0,0);}
    else{p0=__builtin_amdgcn_mfma_f32_32x32x16_bf16(b0,qr[d0],p0,0,0,0);p1=__builtin_amdgcn_mfma_f32_32x32x16_bf16(b1,qr[d0],p1,0,0,0);}}
}
typedef __attribute__((address_space(3))) const char* lds_cptr;
typedef short v4i16_t __attribute__((ext_vector_type(4)));
__device__ __forceinline__ void kload8(bf16x8*kf,lds_cptr kp){
  kf[0]=*(const __attribute__((address_space(3))) bf16x8*)(kp);      kf[1]=*(const __attribute__((address_space(3))) bf16x8*)(kp+512);
  kf[2]=*(const __attribute__((address_space(3))) bf16x8*)(kp+2048); kf[3]=*(const __attribute__((address_space(3))) bf16x8*)(kp+2560);
  kf[4]=*(const __attribute__((address_space(3))) bf16x8*)(kp+4096); kf[5]=*(const __attribute__((address_space(3))) bf16x8*)(kp+4608);
  kf[6]=*(const __attribute__((address_space(3))) bf16x8*)(kp+6144); kf[7]=*(const __attribute__((address_space(3))) bf16x8*)(kp+6656);
}
__device__ __forceinline__ void kload2(bf16x8*kf,lds_cptr kp,int j){ kf[2*j]=*(const __attribute__((address_space(3))) bf16x8*)(kp+j*2048); kf[2*j+1]=*(const __attribute__((address_space(3))) bf16x8*)(kp+j*2048+512); }
__device__ __forceinline__ s16x4 vtr(lds_cptr p){ return __builtin_bit_cast(s16x4,__builtin_amdgcn_ds_read_tr16_b64_v4i16((__attribute__((address_space(3))) v4i16_t*)p)); }
__device__ __forceinline__ float rowmax(const f32x16&p0,const f32x16&p1){
  float a=max3f(p0[0],p0[1],p1[0]),b=max3f(p0[2],p0[3],p1[1]);a=max3f(a,p1[2],p1[3]);
  #pragma unroll
  for(int r=4;r<16;r+=4){a=max3f(a,p0[r],p0[r+1]);b=max3f(b,p0[r+2],p0[r+3]);a=max3f(a,p1[r],p1[r+1]);b=max3f(b,p1[r+2],p1[r+3]);}
  const float m=max2f(a,b);
  auto rr=__builtin_amdgcn_permlane32_swap(__float_as_uint(m),__float_as_uint(m),false,false);
  return max2f(__uint_as_float(rr[0]),__uint_as_float(rr[1]));
}
__device__ __forceinline__ void pv(f32x16*o,int vb,bf16x8 pa0,bf16x8 pa1,bf16x8 pa2,bf16x8 pa3){
  #pragma unroll
  for(int d0=0;d0<2;++d0){s16x4 lo[4],hi[4];
    #pragma unroll
    for(int ks=0;ks<4;++ks){
      asm volatile("ds_read_b64_tr_b16 %0,%1 offset:%c2":"=&v"(lo[ks]):"v"(vb),"i"(d0*4096+ks*1024):"memory");
      asm volatile("ds_read_b64_tr_b16 %0,%1 offset:%c2":"=&v"(hi[ks]):"v"(vb),"i"(d0*4096+ks*1024+512):"memory");}
    asm volatile("s_waitcnt lgkmcnt(0)":::"memory");SBAR();
    #define PK(k) (bf16x8){lo[k][0],lo[k][1],lo[k][2],lo[k][3],hi[k][0],hi[k][1],hi[k][2],hi[k][3]}
    o[d0]=__builtin_amdgcn_mfma_f32_32x32x16_bf16(pa0,PK(0),o[d0],0,0,0);
    o[d0]=__builtin_amdgcn_mfma_f32_32x32x16_bf16(pa1,PK(1),o[d0],0,0,0);
    o[d0]=__builtin_amdgcn_mfma_f32_32x32x16_bf16(pa2,PK(2),o[d0],0,0,0);
    o[d0]=__builtin_amdgcn_mfma_f32_32x32x16_bf16(pa3,PK(3),o[d0],0,0,0);
    #undef PK
  }
}

#ifndef ATTN_STORE16
#define ATTN_STORE16(p,v) (*(u32x4*)(p)=(v))
#endif
  template<int THRL,bool NOMAX=false> __device__ __forceinline__ void attn_unit(int b,int h,int qb,const bf16*Q,const bf16*__restrict__ K,const bf16*__restrict__ V,bf16*O,char*shm,float mfix=0.f){
  int tid_=threadIdx.x; asm volatile("":"+v"(tid_)); const int tid=tid_,lane=tid&63,r32=lane&31,hi=lane>>5; const int wid=__builtin_amdgcn_readfirstlane(tid>>6);
  const long rowbase=(long)b*SEQ; const int q0=qb*QB;
  const bf16*Qw=Q+(rowbase+q0+wid*QBLK)*QP+h*D;
  const bf16*Kh=K+rowbase*KVP+(h>>2)*D,*Vh=V+rowbase*KVP+(h>>2)*D;
  const unsigned lds0=(unsigned)(uintptr_t)shm;
  float*wsf=(float*)(shm+LDS_WS)+wid*64;
  const bf16*ksrc=Kh+(long)lane*KVP+wid*8;
  const bf16*vsrc=Vh+(long)(16*(wid&3)+(lane>>2))*KVP+(wid>>2)*32+(lane&3)*8;
  const unsigned kdst=lds0+LDS_K+wid*1024, vdst=lds0+LDS_V+wid*1024;
  #define DMA_K(t,slot) glds16(ksrc+(long)(t)*KVBLK*KVP,(unsigned)__builtin_amdgcn_readfirstlane(kdst+(slot)))
  #define DMA_V(t,slot) glds16(vsrc+(long)(t)*KVBLK*KVP,(unsigned)__builtin_amdgcn_readfirstlane(vdst+(slot)))
  const int vb0=(int)(lds0+LDS_V)+((lane>>4)&1)*32+(lane&3)*8+(4*hi+((lane&15)>>2))*64;
  const char*Kbase=shm+LDS_K; bf16x8 kf[8];
  const lds_cptr shm3=(lds_cptr)shm; const lds_cptr kp0=shm3+LDS_K+hi*1024+r32*16; const lds_cptr vp0=shm3+LDS_V+((lane>>4)&1)*32+(lane&3)*8+(4*hi+((lane&15)>>2))*64;
  const int NT=SEQ/KVBLK;
  DMA_K(0,0);DMA_V(0,0);DMA_K(1,SLOTB);
  bf16x8 qr[4];
  #pragma unroll
  for(int d0=0;d0<4;++d0)qr[d0]=*reinterpret_cast<const bf16x8*>(&Qw[(long)r32*QP+d0*16+hi*8]);
  float mhat=0.f,l_reg=0.f;f32x16 o[2];o[0]=f32x16{};o[1]=f32x16{};f32x16 negm=f32x16{};asm volatile("":"+v"(negm));
  const int qrel=wid*QBLK+r32;
  #define CMASK(P0,P1,t) do{}while(0)
  bool resc=false;
  #define START(P0,P1) do{ float rm; if constexpr(NOMAX) rm=mfix; else rm=rowmax(P0,P1); resc=false; \
    { const float dl=rm; mhat=fadd_s(mhat,dl); \
      _Pragma("unroll") for(int r=0;r<16;++r){P0[r]=fsub_s(P0[r],dl);P1[r]=fsub_s(P1[r],dl);} \
      _Pragma("unroll") for(int r=0;r<16;++r)negm[r]=-mhat; asm volatile("":"+v"(negm)); } \
    _Pragma("unroll") for(int r=0;r<16;++r)P0[r]=__builtin_amdgcn_exp2f(P0[r]); }while(0)
  #define RESC() do{ if(resc){ asm volatile("s_waitcnt lgkmcnt(0)":::"memory"); \
      _Pragma("unroll") for(int d_=0;d_<2;++d_) _Pragma("unroll") for(int r=0;r<16;++r)o[d_][r]*=wsf[crow(r,hi)]; } }while(0)
  f32x16 pA0,pA1,pB0,pB1;
  int sl_prev=0,sl_cur=0,sl_next=SLOTB;
  #define ROT() do{sl_prev=sl_cur;sl_cur=sl_next;sl_next=(sl_next==(NSLOT-1)*SLOTB)?0:sl_next+SLOTB;}while(0)
  DMA_K(2,2*SLOTB);
  WAIT_BAR(3);
  qkt(pA0,pA1,Kbase,qr,negm,r32,hi);asm volatile("s_nop 15\n\ts_nop 7":"+v"(pA0),"+v"(pA1));CMASK(pA0,pA1,0);
  START(pA0,pA1);
  _Pragma("unroll") for(int r=0;r<16;++r)pA1[r]=__builtin_amdgcn_exp2f(pA1[r]);
  WAIT_BAR(0);
  DMA_K(3,0);DMA_V(1,SLOTB);
  ROT();
  kload8(kf,kp0+sl_cur);
  WAIT_BAR(2);
  s16x4 vlo[8],vhi[8]; u32x4 pw0,pw1,pw2,pw3;
  #define PKW(P,B) cvtpk_s(P[B],P[B+1])
  #define PAF(k) __builtin_bit_cast(bf16x8,pw##k)
  #define VFR(i) (bf16x8){vlo[i][0],vlo[i][1],vlo[i][2],vlo[i][3],vhi[i][0],vhi[i][1],vhi[i][2],vhi[i][3]}
  #define PIN(x) asm volatile("":"+v"(x))
  #define MX3(a,b,c) __builtin_fmaxf(__builtin_fmaxf((a),(b)),(c))
  #define GAPA(MF,A0,A1,A2,A3,W0,W1,PW) do{ MF; sacc+=A0; sacc+=A1; sacc+=A2; sacc+=A3; PIN(sacc); W0; W1; PIN(PW); SBAR(); }while(0)
  #define EX(v) __builtin_amdgcn_exp2f(v)
  #define GAPB(MF,X,B) do{ MF; X[B]=EX(X[B]); X[B+1]=EX(X[B+1]); X[B+2]=EX(X[B+2]); X[B+3]=EX(X[B+3]); PIN(X); SBAR(); }while(0)
  #define VRD(i) do{ vlo[i]=vtr(vp_+(((i)>>2)*4096+((i)&3)*1024)); vhi[i]=vtr(vp_+(((i)>>2)*4096+((i)&3)*1024+512)); }while(0)
  #define KRD(G,j) do{ if(G){ kload2(kf,kp0+sl_next,j); SBAR(); } }while(0)
  #define STEP(C0,C1,P0,P1,t,GK,GV,GL) do{ SBAR(); \
    const lds_cptr vp_=vp0+sl_prev; \
    VRD(0); SBAR(); float sacc=(P0[0]+P0[1]); \
    GAPA(C0=__builtin_amdgcn_mfma_f32_32x32x16_bf16(kf[0],qr[0],negm,0,0,0), P0[2],P0[3],P0[4],P0[5],     pw0[0]=PKW(P0,0), pw0[1]=PKW(P0,2), pw0); \
    VRD(4); SBAR(); GAPA(C1=__builtin_amdgcn_mfma_f32_32x32x16_bf16(kf[1],qr[0],negm,0,0,0), P0[6],P0[7],P0[8],P0[9],     pw0[2]=PKW(P0,4), pw0[3]=PKW(P0,6), pw0); \
    VRD(1); SBAR(); GAPA(C0=__builtin_amdgcn_mfma_f32_32x32x16_bf16(kf[2],qr[1],C0,0,0,0),   P0[10],P0[11],P0[12],P0[13], pw1[0]=PKW(P0,8), pw1[1]=PKW(P0,10), pw1); \
    VRD(5); SBAR(); GAPA(C1=__builtin_amdgcn_mfma_f32_32x32x16_bf16(kf[3],qr[1],C1,0,0,0),   P0[14],P0[15],P1[0],P1[1],   pw1[2]=PKW(P0,12),pw1[3]=PKW(P0,14), pw1); \
    VRD(2); SBAR(); GAPA(C0=__builtin_amdgcn_mfma_f32_32x32x16_bf16(kf[4],qr[2],C0,0,0,0),   P1[2],P1[3],P1[4],P1[5],     pw2[0]=PKW(P1,0), pw2[1]=PKW(P1,2), pw2); \
    VRD(6); SBAR(); GAPA(C1=__builtin_amdgcn_mfma_f32_32x32x16_bf16(kf[5],qr[2],C1,0,0,0),   P1[6],P1[7],P1[8],P1[9],     pw2[2]=PKW(P1,4), pw2[3]=PKW(P1,6), pw2); \
    VRD(3); SBAR(); GAPA(C0=__builtin_amdgcn_mfma_f32_32x32x16_bf16(kf[6],qr[3],C0,0,0,0),   P1[10],P1[11],P1[12],P1[13], pw3[0]=PKW(P1,8), pw3[1]=PKW(P1,10), pw3); \
    VRD(7); SBAR(); GAPA(C1=__builtin_amdgcn_mfma_f32_32x32x16_bf16(kf[7],qr[3],C1,0,0,0),   P1[14],P1[15],0.f,0.f,       pw3[2]=PKW(P1,12),pw3[3]=PKW(P1,14), pw3); \
    l_reg+=sacc; \
    if(GK){DMA_K((t)+3,sl_cur);} if(GV){DMA_V((t)+1,sl_next);} \
    CMASK(C0,C1,t); \
    if constexpr(!NOMAX){ float a=MX3(C0[0],C0[1],C1[0]),b=MX3(C0[2],C0[3],C1[1]); a=MX3(a,C1[2],C1[3]); \
      _Pragma("unroll") for(int r=4;r<16;r+=4){a=MX3(a,C0[r],C0[r+1]);b=MX3(b,C0[r+2],C0[r+3]);a=MX3(a,C1[r],C1[r+1]);b=MX3(b,C1[r+2],C1[r+3]);} \
      float rm=__builtin_fmaxf(a,b); { auto rr=__builtin_amdgcn_permlane32_swap(__float_as_uint(rm),__float_as_uint(rm),false,false); rm=__builtin_fmaxf(__uint_as_float(rr[0]),__uint_as_float(rr[1])); } \
      resc=false; \
      if(__builtin_expect(__any(rm>(float)THRL),0)){ const float dl=__builtin_fmaxf(rm,0.f); mhat+=dl; \
        _Pragma("unroll") for(int r=0;r<16;++r){C0[r]-=dl;C1[r]-=dl;} \
        _Pragma("unroll") for(int r=0;r<16;++r)negm[r]=-mhat; asm volatile("":"+v"(negm)); \
        const float f=__builtin_amdgcn_exp2f(-dl); l_reg*=f; if(hi==0)wsf[r32]=f; resc=true; } } \
    SBAR(); \
    GAPB(o[0]=__builtin_amdgcn_mfma_f32_32x32x16_bf16(PAF(0),VFR(0),o[0],0,0,0), C0,0); \
    GAPB(o[1]=__builtin_amdgcn_mfma_f32_32x32x16_bf16(PAF(0),VFR(4),o[1],0,0,0), C0,4); \
    KRD(GL,0); GAPB(o[0]=__builtin_amdgcn_mfma_f32_32x32x16_bf16(PAF(1),VFR(1),o[0],0,0,0), C0,8); \
    KRD(GL,1); GAPB(o[1]=__builtin_amdgcn_mfma_f32_32x32x16_bf16(PAF(1),VFR(5),o[1],0,0,0), C0,12); \
    KRD(GL,2); GAPB(o[0]=__builtin_amdgcn_mfma_f32_32x32x16_bf16(PAF(2),VFR(2),o[0],0,0,0), C1,0); \
    KRD(GL,3); GAPB(o[1]=__builtin_amdgcn_mfma_f32_32x32x16_bf16(PAF(2),VFR(6),o[1],0,0,0), C1,4); \
    GAPB(o[0]=__builtin_amdgcn_mfma_f32_32x32x16_bf16(PAF(3),VFR(3),o[0],0,0,0), C1,8); \
    GAPB(o[1]=__builtin_amdgcn_mfma_f32_32x32x16_bf16(PAF(3),VFR(7),o[1],0,0,0), C1,12); \
    }while(0)
  int t=1;
  #undef CMASK
  #define CMASK(P0,P1,t) do{}while(0)
  for(;t+5<NT;t+=2){
    STEP(pB0,pB1,pA0,pA1,t,true,true,true);     WAIT_BAR(2); RESC(); ROT();
    STEP(pA0,pA1,pB0,pB1,t+1,true,true,true);   WAIT_BAR(2); RESC(); ROT();
  }
  #undef CMASK
  #define CMASK(P0,P1,t) do{}while(0)
  #define ENDW(tt) do{ if((tt)+3<NT){WAIT_BAR(2);} else if((tt)+2<NT){WAIT_BAR(1);} else {WAIT_BAR(0);} }while(0)
  for(;t+1<NT;t+=2){
    STEP(pB0,pB1,pA0,pA1,t,(t+3<NT),(t+1<NT),(t+1<NT));       ENDW(t);   RESC(); ROT();
    STEP(pA0,pA1,pB0,pB1,t+1,(t+4<NT),(t+2<NT),(t+2<NT));     ENDW(t+1); RESC(); ROT();
  }
  STEP(pB0,pB1,pA0,pA1,NT-1,false,false,false); RESC();
  { float sacc=pB0[0]+pB0[1]; _Pragma("unroll") for(int r=2;r<16;++r)sacc+=pB0[r]; _Pragma("unroll") for(int r=0;r<16;++r)sacc+=pB1[r]; l_reg+=sacc;
    pw0=(u32x4){PKW(pB0,0),PKW(pB0,2),PKW(pB0,4),PKW(pB0,6)};pw1=(u32x4){PKW(pB0,8),PKW(pB0,10),PKW(pB0,12),PKW(pB0,14)};pw2=(u32x4){PKW(pB1,0),PKW(pB1,2),PKW(pB1,4),PKW(pB1,6)};pw3=(u32x4){PKW(pB1,8),PKW(pB1,10),PKW(pB1,12),PKW(pB1,14)};
    SBAR(); pv(o,vb0+sl_cur,PAF(0),PAF(1),PAF(2),PAF(3)); }
  #undef PKW
  #undef PAF
  #undef VFR
  #undef PIN
  #undef MX3
  #undef GAPA
  #undef GAPB
  #undef EX
  #undef VRD
  #undef KRD
  #undef STEP
  #undef ENDW
  {auto rr=__builtin_amdgcn_permlane32_swap(__float_as_uint(l_reg),__float_as_uint(l_reg),false,false);l_reg=__uint_as_float(rr[0])+__uint_as_float(rr[1]);}
  if(hi==0)wsf[32+r32]=l_reg;asm volatile("s_waitcnt lgkmcnt(0)":::"memory");
  float rli[16];
  #pragma unroll
  for(int r=0;r<16;++r)rli[r]=__builtin_amdgcn_rcpf(wsf[32+crow(r,hi)]);
  bf16*Ow=O+(rowbase+q0+wid*QBLK)*OP+h*D;
  { bf16*stg=(bf16*)(shm+LDS_OST)+wid*2048;
    #pragma unroll
    for(int r=0;r<16;++r){const int orow=crow(r,hi);
      #pragma unroll
      for(int d0=0;d0<2;++d0)stg[orow*64+d0*32+r32]=__float2bfloat16(o[d0][r]*rli[r]);}
    asm volatile("s_waitcnt lgkmcnt(0)":::"memory");
    #pragma unroll
    for(int i=0;i<4;++i){const int row=i*8+(lane>>3),ch=lane&7; const u32x4 v=*(const u32x4*)(stg+row*64+ch*8); ATTN_STORE16(Ow+(long)row*OP+ch*8,v);} }
  asm volatile("s_waitcnt lgkmcnt(0)\n\ts_barrier":::"memory");
  #undef DMA_K
  #undef DMA_V
  #undef CMASK
  #undef START
  #undef RESC
  #undef ROT
}
#undef SBAR
#undef WAIT_BAR
}
constexpr int NWAVES = 8, NTHR = 512;
constexpr int BATCH = 4, SEQ = 4096, DM = 1024, M = BATCH * SEQ, DEPTH = 2;
constexpr int NPROJ = 2560, NIN = 2336;
constexpr int PC_GQ = 0, PC_GK = 128, PC_GV = 256, PC_GG = 512, PC_LAF = 768, PC_LAB = 896, PC_AQ = 1024, PC_AK = 1536, PC_AV = 1664, PC_HX0 = 1792, PC_HX1 = 2048, PC_HV = 2304;
constexpr int NEXP = 16, CAP = 512, FF = 2816, EROWS = BATCH * CAP;
constexpr int NCHUNK = SEQ / 32;
constexpr float EPS = 1e-6f;
constexpr float YE8_SCALE = 16.0f;
constexpr float W8_SCALE = 64.0f;
constexpr float ATT_C2 = 0.125f * 1.4426950408889634f;

constexpr size_t MiB = 1u << 20;
constexpr size_t WS_CTL = 0, CTL_ZERO_BYTES = 32768;
constexpr size_t WS_MOD = 1 * MiB, WS_AFF = 2 * MiB, WS_SLOT = 3 * MiB, WS_GATE = 4 * MiB, WS_ALAST = 5 * MiB, WS_HF = 6 * MiB;
constexpr size_t WS_WIN = 22 * MiB, WS_WOUT = 32 * MiB, WS_HN = 36 * MiB, WS_PROJ = 68 * MiB, WS_QP = 148 * MiB, WS_KV = 164 * MiB, WS_CAT = 172 * MiB;
constexpr size_t WS_GKV = 204 * MiB, WS_ZT = 236 * MiB, WS_YC = 244 * MiB, WS_Y = 260 * MiB, WS_XG = 324 * MiB, WS_H = 388 * MiB, WS_YE = 564 * MiB;
constexpr size_t WS_WGU = 692 * MiB, WS_WD = 1044 * MiB, WS_END = 1220 * MiB;
constexpr size_t WS_XR = 628 * MiB;
constexpr int CW_BAR = 4096;

constexpr int RING_BYTES = 131072, LDSCTL_OFF = RING_BYTES, MISC_OFF = LDSCTL_OFF + 320, LDS_BYTES = 147456;

#define GAS __attribute__((address_space(1)))
#define LAS __attribute__((address_space(3)))
typedef unsigned short bf16;
typedef unsigned v4u __attribute__((ext_vector_type(4)));
typedef unsigned v2u __attribute__((ext_vector_type(2)));
typedef float f32x4 __attribute__((ext_vector_type(4)));
#define LDS_WAIT() asm volatile("s_waitcnt lgkmcnt(0)" ::: "memory")
#define VM_WAIT() asm volatile("s_waitcnt vmcnt(0)" ::: "memory")
typedef float m_f32x2 __attribute__((ext_vector_type(2))); typedef __bf16 m_bf16x2 __attribute__((ext_vector_type(2)));
__device__ __forceinline__ unsigned pk2(float lo, float hi) { const m_f32x2 v = {lo, hi}; return __builtin_bit_cast(unsigned, __builtin_convertvector(v, m_bf16x2)); }
__device__ __forceinline__ unsigned f2bf(float f) { return pk2(f, f); }
__device__ __forceinline__ float bf2f(bf16 u) { return __uint_as_float((unsigned)u << 16); }
__device__ __forceinline__ float lane_get(float v, int src) { return __uint_as_float((unsigned)__builtin_amdgcn_ds_bpermute(src << 2, (int)__float_as_uint(v))); }
__device__ __forceinline__ unsigned lane_getu(unsigned v, int src) { return (unsigned)__builtin_amdgcn_ds_bpermute(src << 2, (int)v); }
template <int CTRL> __device__ __forceinline__ float dpp_f(float v) { return __uint_as_float((unsigned)__builtin_amdgcn_update_dpp(0, (int)__float_as_uint(v), CTRL, 0xF, 0xF, true)); }
constexpr int DPP_X1 = 0xB1, DPP_X2 = 0x4E, DPP_HMIR = 0x141, DPP_MIR = 0x140, DPP_ROR8 = 0x128;
__device__ __forceinline__ float swap16_sum(float a, float b) { const auto r = __builtin_amdgcn_permlane16_swap(__float_as_uint(a), __float_as_uint(b), false, false); return __uint_as_float(r[0]) + __uint_as_float(r[1]); }
__device__ __forceinline__ float swap32_sum(float a, float b) { const auto r = __builtin_amdgcn_permlane32_swap(__float_as_uint(a), __float_as_uint(b), false, false); return __uint_as_float(r[0]) + __uint_as_float(r[1]); }
__device__ __forceinline__ float swap16_max(float a) { const auto r = __builtin_amdgcn_permlane16_swap(__float_as_uint(a), __float_as_uint(a), false, false); return fmaxf(__uint_as_float(r[0]), __uint_as_float(r[1])); }
__device__ __forceinline__ float swap32_max(float a) { const auto r = __builtin_amdgcn_permlane32_swap(__float_as_uint(a), __float_as_uint(a), false, false); return fmaxf(__uint_as_float(r[0]), __uint_as_float(r[1])); }
__device__ __forceinline__ float row16_sum(float v) { v += dpp_f<DPP_X1>(v); v += dpp_f<DPP_X2>(v); v += dpp_f<DPP_HMIR>(v); v += dpp_f<DPP_MIR>(v); return v; }
__device__ __forceinline__ float half_sum(float v) { v = row16_sum(v); return swap16_sum(v, v); }
__device__ __forceinline__ float wave_sum(float v, int) { v = half_sum(v); return swap32_sum(v, v); }
__device__ __forceinline__ float siluf(float x) { return x / (1.0f + __expf(-x)); }
__device__ __forceinline__ float logsigf(float x) { return fminf(x, 0.f) - __logf(1.0f + __expf(-fabsf(x))); }
__device__ __forceinline__ float rsq(float x) { return __builtin_amdgcn_rsqf(x); }
#define XB_TMO      128
#define XB_XCNT(j)  (256  + 64 * (j))
#define XB_XSUB(j)  (1280 + 64 * (j))
#define XB_XGEN(j)  (2304 + 64 * (j))
#define XB_TOP      3328
#define XB_TOPGEN   3392
#define XCD_BAR_WORDS 3456
#define XB_SPIN_CAP (1u << 18)

__device__ __forceinline__ unsigned xb_ld(unsigned* p)              { return __hip_atomic_load(p, __ATOMIC_RELAXED, __HIP_MEMORY_SCOPE_AGENT); }
__device__ __forceinline__ unsigned xb_add(unsigned* p, unsigned v) { return __hip_atomic_fetch_add(p, v, __ATOMIC_RELAXED, __HIP_MEMORY_SCOPE_AGENT); }
__device__ __forceinline__ unsigned xb_xcc_id() { return (unsigned)__builtin_amdgcn_s_getreg((3 << 11) | 20) & 0xFu; }
#define XB_SPIN(cond, bar) do { unsigned _sp = 0; while (cond) { __builtin_amdgcn_s_sleep(1); \
    if ((++_sp & 255u) == 0u) { if (xb_ld(&(bar)[XB_TMO])) break; if (_sp > XB_SPIN_CAP) { atomicAdd(&(bar)[XB_TMO], 1u); break; } } } } while (0)

struct XcdBarrier {
    unsigned* bar; unsigned x;
    volatile LAS unsigned* st;
};

__device__ __forceinline__ XcdBarrier xcd_barrier_post(unsigned* bar, volatile LAS unsigned* st) {
    XcdBarrier b; b.bar = bar; b.x = xb_xcc_id(); b.st = st;
    if (threadIdx.x == 0) (void)xb_add(&bar[XB_XCNT(b.x)], 1u);
    return b;
}
__device__ __forceinline__ void xcd_barrier_complete(unsigned* bar, unsigned x, unsigned& nloc, unsigned& nx) {
    const unsigned G = gridDim.x * gridDim.y * gridDim.z;
    unsigned sum, cnt, mine, sp = 0u;
    for (;;) {
        sum = 0u; cnt = 0u; mine = 0u;
#pragma unroll
        for (unsigned j = 0; j < 16; ++j) { const unsigned c = xb_ld(&bar[XB_XCNT(j)]); sum += c; cnt += (c > 0u) ? 1u : 0u; mine = (j == x) ? c : mine; }
        if (sum == G) break;
        __builtin_amdgcn_s_sleep(1);
        if ((++sp & 255u) == 0u) { if (xb_ld(&bar[XB_TMO])) break; if (sp > XB_SPIN_CAP) { atomicAdd(&bar[XB_TMO], 1u); break; } }
    }
    nloc = mine > 0u ? mine : 1u; nx = cnt > 0u ? cnt : 1u;
}

__device__ __forceinline__ void xcd_barrier(const XcdBarrier& b) {
    asm volatile("s_waitcnt vmcnt(0)" ::: "memory");
    __syncthreads();
    if (threadIdx.x == 0) {
        unsigned* bar = b.bar;
        __builtin_amdgcn_s_waitcnt(0);
        unsigned nloc = b.st[0], nx = b.st[1];
        if (nloc == 0u) { xcd_barrier_complete(bar, b.x, nloc, nx); b.st[0] = nloc; b.st[1] = nx; }
        const unsigned old = xb_add(&bar[XB_XSUB(b.x)], 1u);
        const unsigned gen = old / nloc;
        if (old + 1u == (gen + 1u) * nloc) {
            __builtin_amdgcn_fence(__ATOMIC_RELEASE, "agent");
            asm volatile("s_waitcnt vmcnt(0)" ::: "memory");
            const unsigned og = xb_add(&bar[XB_TOP], 1u);
            const unsigned tg = og / nx;
            if (og + 1u == (tg + 1u) * nx) xb_add(&bar[XB_TOPGEN], 1u);
            else XB_SPIN(xb_ld(&bar[XB_TOPGEN]) == tg, bar);
            __builtin_amdgcn_fence(__ATOMIC_ACQUIRE, "agent");
            xb_add(&bar[XB_XGEN(b.x)], 1u);
            asm volatile("s_waitcnt vmcnt(0)" ::: "memory");
        } else {
            XB_SPIN(xb_ld(&bar[XB_XGEN(b.x)]) == gen, bar);
            __builtin_amdgcn_fence(__ATOMIC_ACQUIRE, "agent");
            asm volatile("s_waitcnt vmcnt(0)" ::: "memory");
        }
    }
    __syncthreads();
}

struct Frame {
    LAS unsigned char* lds;
    GAS unsigned* ctl;
    int tid, lane, wave, vcu, G;
    GAS float* out; GAS unsigned char* ws;
};
__device__ __forceinline__ const GAS float* INP(const Frame& F, int i) {
    const LAS unsigned* p = (const LAS unsigned*)(F.lds + LDSCTL_OFF) + 2 * i;
    const unsigned lo = __builtin_amdgcn_readfirstlane(p[0]), hi = __builtin_amdgcn_readfirstlane(p[1]);
    return (const GAS float*)(((unsigned long long)hi << 32) | lo);
}
enum { I_X = 0, I_C, I_ADAW, I_ADAB, I_MPRE, I_MPOST, I_WIN, I_GWDEC, I_GBDEC, I_GNORM, I_QNORM, I_KNORM, I_HCW, I_HCB, I_HW1, I_HB1, I_HW2, I_HB2, I_HW3, I_HFREQ, I_HSKIP,
       I_WOUT, I_FPRE, I_FPOST, I_ROUTER, I_EG, I_EU, I_ED };

__device__ __forceinline__ void transpose_item(const GAS float* src, size_t src_ld, GAS bf16* dst, size_t dst_ld, int lane) {
    const GAS float* s = src + lane; float v[32];
#pragma unroll
    for (int i = 0; i < 32; ++i) v[i] = __builtin_nontemporal_load(s + (size_t)i * src_ld);
    GAS v4u* d = (GAS v4u*)(dst + (size_t)lane * dst_ld);
#pragma unroll
    for (int q = 0; q < 4; ++q) { v4u o; o.x = pk2(v[8 * q], v[8 * q + 1]); o.y = pk2(v[8 * q + 2], v[8 * q + 3]); o.z = pk2(v[8 * q + 4], v[8 * q + 5]); o.w = pk2(v[8 * q + 6], v[8 * q + 7]); d[q] = o; }
}
__device__ __forceinline__ unsigned pk4_f8(float a, float b, float c, float d) {
    a = fminf(fmaxf(a, -448.f), 448.f); b = fminf(fmaxf(b, -448.f), 448.f); c = fminf(fmaxf(c, -448.f), 448.f); d = fminf(fmaxf(d, -448.f), 448.f);
    unsigned r = 0u; r = __builtin_amdgcn_cvt_pk_fp8_f32(a, b, r, false); r = __builtin_amdgcn_cvt_pk_fp8_f32(c, d, r, true); return r; }
struct F8Tile { const GAS float* src; size_t ld; GAS unsigned char* dst; };
__device__ __forceinline__ F8Tile f8_tile(Frame& F, int tile) {
    const int le = tile / 528; int r = tile % 528; const int which = r / 176; r %= 176; const int nn = F.tid >> 1, hh = F.tid & 1; F8Tile t;
    if (which < 2) { const int kb = r & 15, nb = r >> 4, n = 256 * nb + nn, pn = n >> 7, row = (n & 127) + which * 128;
        t.src = INP(F, which == 0 ? I_EG : I_EU) + (size_t)le * DM * FF + (size_t)(64 * kb + 8 * F.wave) * FF + 256 * nb + 4 * F.lane; t.ld = FF;
        t.dst = (GAS unsigned char*)(F.ws + WS_WGU) + (size_t)le * 5632 * DM + (size_t)(((pn * 8 + (kb >> 1)) * 2 + (kb & 1)) * 16384 + row * 64 + 32 * hh); }
    else { const int kb = r % 44, nb = r / 44;
        t.src = INP(F, I_ED) + (size_t)le * FF * DM + (size_t)(64 * kb + 8 * F.wave) * DM + 256 * nb + 4 * F.lane; t.ld = DM;
        t.dst = (GAS unsigned char*)(F.ws + WS_WD) + (size_t)le * DM * FF + (size_t)(((nb * 22 + (kb >> 1)) * 2 + (kb & 1)) * 16384 + nn * 64 + 32 * hh); }
    return t;
}
__device__ __forceinline__ void f8_tile_load(const F8Tile& t, f32x4 (&v)[8]) {
#pragma unroll
    for (int i = 0; i < 8; ++i) { const GAS float* a = t.src + (size_t)i * t.ld; asm volatile("global_load_dwordx4 %0, %1, off nt" : "=v"(v[i]) : "v"(a) : "memory"); }
}
__device__ __forceinline__ void f8_tile_wait(f32x4 (&v)[8]) {
    asm volatile("s_waitcnt vmcnt(16)" : "+v"(v[0]), "+v"(v[1]), "+v"(v[2]), "+v"(v[3]), "+v"(v[4]), "+v"(v[5]), "+v"(v[6]), "+v"(v[7]) :: "memory");
}
__device__ __forceinline__ void f8_tile_finish(Frame& F, const F8Tile& t, f32x4 (&v)[8], LAS unsigned char* img) {
    f8_tile_wait(v);
#pragma unroll
    for (int j = 0; j < 4; ++j) { v2u o; o.x = pk4_f8(v[0][j] * W8_SCALE, v[1][j] * W8_SCALE, v[2][j] * W8_SCALE, v[3][j] * W8_SCALE); o.y = pk4_f8(v[4][j] * W8_SCALE, v[5][j] * W8_SCALE, v[6][j] * W8_SCALE, v[7][j] * W8_SCALE);
        *(LAS v2u*)(img + (4 * F.lane + j) * 80 + 8 * F.wave) = o; }
    asm volatile("s_waitcnt lgkmcnt(0)" ::: "memory"); __builtin_amdgcn_s_barrier(); asm volatile("" ::: "memory");
    const LAS unsigned char* rp = img + (F.tid >> 1) * 80 + 32 * (F.tid & 1);
    const v4u a = *(const LAS v4u*)rp, b = *(const LAS v4u*)(rp + 16);
    *(GAS v4u*)t.dst = a; *(GAS v4u*)(t.dst + 16) = b;
}
__device__ __forceinline__ void f8_convert_range(Frame& F, int first, int stride, int count) {
    if (count <= 0) return;
    LAS unsigned char* img0 = F.lds; LAS unsigned char* img1 = F.lds + 256 * 80; LAS unsigned char* img2 = F.lds + 2 * 256 * 80;
#define F8_TIDX(i) (first + stride * (((i) < count) ? (i) : count - 1))
    F8Tile ta = f8_tile(F, F8_TIDX(0)), tb = f8_tile(F, F8_TIDX(1)), tc; f32x4 va[8], vb[8], vc[8];
    f8_tile_load(ta, va); f8_tile_load(tb, vb);
#pragma unroll 1
    for (int i = 0; i < count; i += 3) {
        tc = f8_tile(F, F8_TIDX(i + 2)); f8_tile_load(tc, vc);
        f8_tile_finish(F, ta, va, img0);
        ta = f8_tile(F, F8_TIDX(i + 3)); f8_tile_load(ta, va);
        f8_tile_finish(F, tb, vb, img1);
        tb = f8_tile(F, F8_TIDX(i + 4)); f8_tile_load(tb, vb);
        f8_tile_finish(F, tc, vc, img2);
    }
#undef F8_TIDX
    __syncthreads();
}
constexpr int F8_NTILES = 32 * 528;
struct F8WItem { const GAS float* src; int ld; GAS unsigned char* dst; };
__device__ __forceinline__ F8WItem f8w_item(Frame& F, int q) {
    const int tile = q >> 2, quarter = q & 3, le = tile / 528; int r = tile % 528; const int which = r / 176; r %= 176;
    const int n4 = F.lane & 15, kq = F.lane >> 4; F8WItem it;
    if (which < 2) { const int kb = r & 15, nb = (r >> 4) * 4 + quarter, n = 64 * nb + 4 * n4, pn = n >> 7, row = (n & 127) + which * 128;
        it.src = INP(F, which == 0 ? I_EG : I_EU) + (size_t)le * DM * FF + (size_t)(64 * kb + 16 * kq) * FF + n; it.ld = FF;
        it.dst = (GAS unsigned char*)(F.ws + WS_WGU) + (size_t)le * 5632 * DM + (size_t)(((pn * 8 + (kb >> 1)) * 2 + (kb & 1)) * 16384 + row * 64 + 16 * kq); }
    else { const int kb = r % 44, nb = (r / 44) * 4 + quarter, n = 64 * nb + 4 * n4, pn = n >> 8, row = n & 255;
        it.src = INP(F, I_ED) + (size_t)le * FF * DM + (size_t)(64 * kb + 16 * kq) * DM + n; it.ld = DM;
        it.dst = (GAS unsigned char*)(F.ws + WS_WD) + (size_t)le * DM * FF + (size_t)(((pn * 22 + (kb >> 1)) * 2 + (kb & 1)) * 16384 + row * 64 + 16 * kq); }
    return it;
}
#ifndef MK_N_LAUNCHES
#define MK_N_LAUNCHES 1
#endif
constexpr int F8W_HOSTED = 4, F8W_IDLE = 5, F8W_BARQ = (MK_N_LAUNCHES == 1) ? 11 : 0, F8W_BARQ0 = (MK_N_LAUNCHES == 1) ? 15 : 0, F8W_BARW = 256 * 7, F8W_HOST0 = 2 * F8_NTILES;
__device__ __forceinline__ void f8w_load(const F8WItem& it, f32x4 (&v)[16]) {
#pragma unroll
    for (int i = 0; i < 16; ++i) { const GAS float* a = it.src + (size_t)i * it.ld; asm volatile("global_load_dwordx4 %0, %1, off nt" : "=v"(v[i]) : "v"(a) : "memory"); }
}
__device__ __forceinline__ void f8w_finish(const F8WItem& it, f32x4 (&v)[16]) {
    asm volatile("s_waitcnt vmcnt(0)" : "+v"(v[0]), "+v"(v[1]), "+v"(v[2]), "+v"(v[3]), "+v"(v[4]), "+v"(v[5]), "+v"(v[6]), "+v"(v[7]),
                 "+v"(v[8]), "+v"(v[9]), "+v"(v[10]), "+v"(v[11]), "+v"(v[12]), "+v"(v[13]), "+v"(v[14]), "+v"(v[15]) :: "memory");
#pragma unroll
    for (int j = 0; j < 4; ++j) { v4u o;
        o.x = pk4_f8(v[0][j] * W8_SCALE, v[1][j] * W8_SCALE, v[2][j] * W8_SCALE, v[3][j] * W8_SCALE); o.y = pk4_f8(v[4][j] * W8_SCALE, v[5][j] * W8_SCALE, v[6][j] * W8_SCALE, v[7][j] * W8_SCALE);
        o.z = pk4_f8(v[8][j] * W8_SCALE, v[9][j] * W8_SCALE, v[10][j] * W8_SCALE, v[11][j] * W8_SCALE); o.w = pk4_f8(v[12][j] * W8_SCALE, v[13][j] * W8_SCALE, v[14][j] * W8_SCALE, v[15][j] * W8_SCALE);
        *(GAS v4u*)(it.dst + j * 64) = o; }
}
__device__ __forceinline__ void f8w_convert_all(Frame& F) {
    const int gw = F.vcu * NWAVES + F.wave, NGW = F.G * NWAVES;
    const int h0 = (F.G == 256) ? F8W_HOST0 : 4 * F8_NTILES, h1 = h0 + F8W_HOSTED * NGW + F8W_IDLE * 1024 + F8W_BARQ * F8W_BARW;
    const int g0 = (F.G == 256) ? F8W_HOST0 - F8W_BARQ0 * F8W_BARW : 4 * F8_NTILES;
    for (int q = gw; q < 4 * F8_NTILES; q += NGW) { if (q >= g0 && q < h1) continue; const F8WItem it = f8w_item(F, q); f32x4 v[16];
#pragma unroll
        for (int i = 0; i < 16; ++i) v[i] = __builtin_nontemporal_load((const GAS f32x4*)(it.src + (size_t)i * it.ld));
#pragma unroll
        for (int j = 0; j < 4; ++j) { v4u o;
            o.x = pk4_f8(v[0][j] * W8_SCALE, v[1][j] * W8_SCALE, v[2][j] * W8_SCALE, v[3][j] * W8_SCALE); o.y = pk4_f8(v[4][j] * W8_SCALE, v[5][j] * W8_SCALE, v[6][j] * W8_SCALE, v[7][j] * W8_SCALE);
            o.z = pk4_f8(v[8][j] * W8_SCALE, v[9][j] * W8_SCALE, v[10][j] * W8_SCALE, v[11][j] * W8_SCALE); o.w = pk4_f8(v[12][j] * W8_SCALE, v[13][j] * W8_SCALE, v[14][j] * W8_SCALE, v[15][j] * W8_SCALE);
            *(GAS v4u*)(it.dst + j * 64) = o; } }
}

__device__ __forceinline__ void f8w_convert_one(Frame& F, int q) {
    const F8WItem it = f8w_item(F, q); f32x4 v[16];
#pragma unroll
    for (int k = 0; k < 16; ++k) v[k] = __builtin_nontemporal_load((const GAS f32x4*)(it.src + (size_t)k * it.ld));
#pragma unroll
    for (int j = 0; j < 4; ++j) { v4u o;
        o.x = pk4_f8(v[0][j] * W8_SCALE, v[1][j] * W8_SCALE, v[2][j] * W8_SCALE, v[3][j] * W8_SCALE); o.y = pk4_f8(v[4][j] * W8_SCALE, v[5][j] * W8_SCALE, v[6][j] * W8_SCALE, v[7][j] * W8_SCALE);
        o.z = pk4_f8(v[8][j] * W8_SCALE, v[9][j] * W8_SCALE, v[10][j] * W8_SCALE, v[11][j] * W8_SCALE); o.w = pk4_f8(v[12][j] * W8_SCALE, v[13][j] * W8_SCALE, v[14][j] * W8_SCALE, v[15][j] * W8_SCALE);
        *(GAS v4u*)(it.dst + j * 64) = o; }
}
__device__ __forceinline__ void f8w_convert_idle(Frame& F) {
    const int iw = ((int)blockIdx.x - 128) * NWAVES + F.wave;
    for (int i = 0; i < F8W_IDLE; ++i) { const F8WItem it = f8w_item(F, F8W_HOST0 + F8W_HOSTED * 2048 + iw + 1024 * i); f32x4 v[16];
#pragma unroll
        for (int k = 0; k < 16; ++k) v[k] = __builtin_nontemporal_load((const GAS f32x4*)(it.src + (size_t)k * it.ld));
#pragma unroll
        for (int j = 0; j < 4; ++j) { v4u o;
            o.x = pk4_f8(v[0][j] * W8_SCALE, v[1][j] * W8_SCALE, v[2][j] * W8_SCALE, v[3][j] * W8_SCALE); o.y = pk4_f8(v[4][j] * W8_SCALE, v[5][j] * W8_SCALE, v[6][j] * W8_SCALE, v[7][j] * W8_SCALE);
            o.z = pk4_f8(v[8][j] * W8_SCALE, v[9][j] * W8_SCALE, v[10][j] * W8_SCALE, v[11][j] * W8_SCALE); o.w = pk4_f8(v[12][j] * W8_SCALE, v[13][j] * W8_SCALE, v[14][j] * W8_SCALE, v[15][j] * W8_SCALE);
            *(GAS v4u*)(it.dst + j * 64) = o; } }
}
__device__ __forceinline__ void mod_item(Frame& F, int it) {
    const int l = it / 96, cg = it % 96, tid = F.tid;
    LAS float* cond = (LAS float*)F.lds; LAS float* part = (LAS float*)(F.lds + 16384);
    const GAS float* c = INP(F, I_C);
    for (int i = tid; i < BATCH * DM; i += NTHR) cond[i] = siluf(c[i]);
    __syncthreads();
    const int cl = tid & 15, kq = tid >> 4;
    const GAS float* W = INP(F, I_ADAW) + (size_t)l * DM * 6144 + cg * 64 + cl * 4;
    f32x4 acc[4];
#pragma unroll
    for (int b = 0; b < 4; ++b) acc[b] = (f32x4){0.f, 0.f, 0.f, 0.f};
#pragma unroll 4
    for (int kk = 0; kk < 32; ++kk) { const int k = kq * 32 + kk; const f32x4 w = *(const GAS f32x4*)(W + (size_t)k * 6144);
#pragma unroll
        for (int b = 0; b < 4; ++b) acc[b] += w * cond[b * DM + k]; }
#pragma unroll
    for (int b = 0; b < 4; ++b) *(LAS f32x4*)(part + (kq * 4 + b) * 64 + cl * 4) = acc[b];
    __syncthreads();
    if (tid < 256) { const int b = tid >> 6, col = tid & 63; float s = 0.f;
        for (int q = 0; q < 32; ++q) s += part[(q * 4 + b) * 64 + col];
        GAS float* mod = (GAS float*)(F.ws + WS_MOD);
        mod[(size_t)(l * 4 + b) * 6144 + cg * 64 + col] = s + INP(F, I_ADAB)[l * 6144 + cg * 64 + col]; }
    __syncthreads();
}
constexpr float HY_MIN_DECAY = -3.0701134573253943f, HY_MAX_DECAY = -15.350567286626972f;
__device__ __forceinline__ void filter_item(Frame& F, int it) {
    const int l = it >> 7, pg = it & 127, p0 = pg * 32, tid = F.tid, lane = F.lane, w = F.wave;
    LAS float* L = (LAS float*)F.lds;
    LAS float* W1 = L;
    LAS float* B1 = W1 + 33 * 64;
    LAS float* W2 = B1 + 64;
    LAS float* B2 = W2 + 2 * 64 * 64;
    LAS float* FR = B2 + 128;
    LAS float* EMB = FR + 64;
    LAS float* HB = EMB + 8 * 64;
    LAS float* H3 = HB + 8 * 64;
    for (int i = tid; i < 33 * 64; i += NTHR) W1[i] = INP(F, I_HW1)[l * 33 * 64 + i];
    for (int i = tid; i < 2 * 64 * 64; i += NTHR) W2[i] = INP(F, I_HW2)[l * 2 * 64 * 64 + i];
    if (tid < 64) { B1[tid] = INP(F, I_HB1)[l * 64 + tid]; FR[tid] = INP(F, I_HFREQ)[l * 64 + tid]; }
    if (tid < 128) B2[tid] = INP(F, I_HB2)[l * 128 + tid];
    __syncthreads();
    const float fr = FR[lane];
    for (int pj = 0; pj < 4; ++pj) {
        const int pl = w * 4 + pj, p = p0 + pl;
        if (lane < 16) { const float f = 1e-4f + (float)lane * ((15.0f - 1e-4f) / 15.0f); const float ang = (6.283185307179586f * (float)p / (float)SEQ) * f;
            EMB[w * 64 + 1 + lane] = cosf(ang); EMB[w * 64 + 17 + lane] = -sinf(ang); }
        if (lane == 0) EMB[w * 64] = (float)p / (float)(SEQ - 1);
        LDS_WAIT(); asm volatile("" ::: "memory");
        float a = B1[lane];
        for (int k = 0; k < 33; ++k) a += EMB[w * 64 + k] * W1[k * 64 + lane];
        float h = sinf(fr * a);
#pragma unroll
        for (int i = 0; i < 2; ++i) {
            LDS_WAIT(); asm volatile("" ::: "memory");
            HB[w * 64 + lane] = h;
            LDS_WAIT(); asm volatile("" ::: "memory");
            float a2 = B2[i * 64 + lane];
            for (int k = 0; k < 64; ++k) a2 += HB[w * 64 + k] * W2[(i * 64 + k) * 64 + lane];
            h = sinf(fr * a2);
        }
        H3[pl * 64 + lane] = h;
        LDS_WAIT(); asm volatile("" ::: "memory");
    }
    __syncthreads();
    {
        const int oc = tid, c = oc & 255; const GAS float* w3 = INP(F, I_HW3) + (size_t)l * 64 * 512 + oc;
        float wc[64];
#pragma unroll
        for (int k = 0; k < 64; ++k) wc[k] = w3[k * 512];
        const float delta = fabsf(HY_MIN_DECAY + (float)c * ((HY_MAX_DECAY - HY_MIN_DECAY) / 255.0f));
        GAS float* hf = (GAS float*)(F.ws + WS_HF) + ((size_t)l * 256 + c) * 8192;
        for (int pl = 0; pl < 32; ++pl) { const int p = p0 + pl; float a = 0.f;
#pragma unroll
            for (int k4 = 0; k4 < 16; ++k4) { const f32x4 hv = *(LAS f32x4*)(H3 + pl * 64 + 4 * k4); a += hv[0] * wc[4 * k4] + hv[1] * wc[4 * k4 + 1] + hv[2] * wc[4 * k4 + 2] + hv[3] * wc[4 * k4 + 3]; }
            const float t = (float)p / (float)(SEQ - 1); a *= __expf(-t * delta);
            if (oc < 256) hf[4096 + p]= a; else if (p > 0) hf[4096 - p] = a; }
        if (pg == 0 && oc < 256) hf[0] = 0.f;
    }
    __syncthreads();
}
__device__ __forceinline__ void row_load(const GAS float* row, int lane, f32x4 (&v)[4]) {
#pragma unroll
    for (int j = 0; j < 4; ++j) v[j] = ((const GAS f32x4*)row)[lane + 64 * j];
}
__device__ __forceinline__ void row_load_bf16(const GAS bf16* row, int lane, f32x4 (&v)[4]) {
#pragma unroll
    for (int j = 0; j < 4; ++j) { const v2u w = ((const GAS v2u*)row)[lane + 64 * j]; v[j] = (f32x4){__uint_as_float(w.x << 16), __uint_as_float(w.x & 0xffff0000u), __uint_as_float(w.y << 16), __uint_as_float(w.y & 0xffff0000u)}; }
}
__device__ __forceinline__ void row_load_f8(const GAS unsigned char* row, int lane, float scale, f32x4 (&v)[4]) {
    typedef float f32x2_ __attribute__((ext_vector_type(2)));
#pragma unroll
    for (int j = 0; j < 4; ++j) { const unsigned w = ((const GAS unsigned*)row)[lane + 64 * j]; const f32x2_ lo = __builtin_amdgcn_cvt_pk_f32_fp8(w, false), hi = __builtin_amdgcn_cvt_pk_f32_fp8(w, true);
        v[j] = (f32x4){lo.x * scale, lo.y * scale, hi.x * scale, hi.y * scale}; }
}
__device__ __forceinline__ float row_ss(const f32x4 (&v)[4], int lane) { float s = 0.f;
#pragma unroll
    for (int j = 0; j < 4; ++j) s += (v[j][0] * v[j][0] + v[j][1] * v[j][1]) + (v[j][2] * v[j][2] + v[j][3] * v[j][3]);
    return wave_sum(s, lane); }
__device__ __forceinline__ void row_modnorm(f32x4 (&v)[4], int lane, const GAS float* g, const GAS float* sc, const GAS float* sh, GAS bf16* orow) {
    const float rstd = rsq(row_ss(v, lane) * (1.0f / DM) + EPS);
#pragma unroll
    for (int j = 0; j < 4; ++j) { const int c4 = lane + 64 * j; const f32x4 gg = ((const GAS f32x4*)g)[c4], s1 = ((const GAS f32x4*)sc)[c4], s0 = ((const GAS f32x4*)sh)[c4];
        v[j] = v[j] * rstd * gg * (1.0f + s1) + s0;
        v2u o; o.x = pk2(v[j][0], v[j][1]); o.y = pk2(v[j][2], v[j][3]); ((GAS v2u*)orow)[c4] = o; }
}

__device__ __forceinline__ void row_modnorm_f8(f32x4 (&v)[4], int lane, const GAS float* g, const GAS float* sc, const GAS float* sh, GAS unsigned char* orow) {
    const float rstd = rsq(row_ss(v, lane) * (1.0f / DM) + EPS);
#pragma unroll
    for (int j = 0; j < 4; ++j) { const int c4 = lane + 64 * j; const f32x4 gg = ((const GAS f32x4*)g)[c4], s1 = ((const GAS f32x4*)sc)[c4], s0 = ((const GAS f32x4*)sh)[c4];
        v[j] = v[j] * rstd * gg * (1.0f + s1) + s0;
        ((GAS unsigned*)orow)[c4] = pk4_f8(v[j][0], v[j][1], v[j][2], v[j][3]); }
}
__device__ __forceinline__ void row_store_bf16(GAS bf16* row, int lane, const f32x4 (&v)[4]) {
#pragma unroll
    for (int j = 0; j < 4; ++j) { v2u o; o.x = pk2(v[j][0], v[j][1]); o.y = pk2(v[j][2], v[j][3]); ((GAS v2u*)row)[lane + 64 * j] = o; }
}
__device__ __forceinline__ void bf8_to_f32(const v4u& w, f32x4& lo, f32x4& hi) {
    lo = (f32x4){__uint_as_float(w.x << 16), __uint_as_float(w.x & 0xffff0000u), __uint_as_float(w.y << 16), __uint_as_float(w.y & 0xffff0000u)};
    hi = (f32x4){__uint_as_float(w.z << 16), __uint_as_float(w.z & 0xffff0000u), __uint_as_float(w.w << 16), __uint_as_float(w.w & 0xffff0000u)}; }
__device__ __forceinline__ void roww_load_bf16(const GAS bf16* row, int lane, f32x4 (&v)[4]) {
    const v4u a = ((const GAS v4u*)row)[2 * lane], b = ((const GAS v4u*)row)[2 * lane + 1]; bf8_to_f32(a, v[0], v[1]); bf8_to_f32(b, v[2], v[3]); }
__device__ __forceinline__ void roww_load(const GAS float* row, int lane, f32x4 (&v)[4]) {
#pragma unroll
    for (int j = 0; j < 4; ++j) v[j] = ((const GAS f32x4*)row)[4 * lane + j]; }
__device__ __forceinline__ void roww_store_bf16(GAS bf16* row, int lane, const f32x4 (&v)[4]) {
    v4u a, b; a.x = pk2(v[0][0], v[0][1]); a.y = pk2(v[0][2], v[0][3]); a.z = pk2(v[1][0], v[1][1]); a.w = pk2(v[1][2], v[1][3]);
    b.x = pk2(v[2][0], v[2][1]); b.y = pk2(v[2][2], v[2][3]); b.z = pk2(v[3][0], v[3][1]); b.w = pk2(v[3][2], v[3][3]);
    ((GAS v4u*)row)[2 * lane] = a; ((GAS v4u*)row)[2 * lane + 1] = b; }
__device__ __forceinline__ void prologue0(Frame& F) {
    for (int it = blockIdx.x; it < 192; it += F.G) mod_item(F, it);
}
__device__ __forceinline__ void prologue2(Frame& F);
__device__ __forceinline__ void prologue1(Frame& F) {
    for (int it = blockIdx.x; it < 256; it += F.G) filter_item(F, it);
    prologue2(F);
    {   GAS bf16* WIN = (GAS bf16*)(F.ws + WS_WIN);
        for (int it = blockIdx.x * NTHR + F.tid; it < DEPTH * 256 * DM; it += F.G * NTHR) {
            const int k = it & 1023, n = (it >> 10) & 255, l = it >> 18, dir = n >> 7, j = n & 127;
            const GAS float* wi = INP(F, I_WIN) + ((size_t)l * DM + k) * NIN + 768 + 16 * dir; const GAS float* wd = INP(F, I_GWDEC) + ((size_t)(l * 2 + dir) * 16) * 128 + j;
            float s = 0.f;
#pragma unroll
            for (int r = 0; r < 16; ++r) s += wi[r] * wd[r * 128];
            WIN[((size_t)l * NPROJ + 768 + n) * DM + k] = (bf16)f2bf(s); } }
    const int gw = F.vcu * NWAVES + F.wave, NGW = F.G * NWAVES;
    constexpr int N_WIN = 2 * 1152, N_WOUT = 2 * 512;
    for (int it0 = gw; it0 < N_WIN + N_WOUT; it0 += NGW) {
        int it = it0;
        if (it < N_WIN) { const int l = it / 1152; int r = it % 1152; int kb, srccol, dstrow;
            if (r < 384) { kb = r / 12; const int nb = r % 12; srccol = 64 * nb; dstrow = 64 * nb; } else { r -= 384; kb = r / 24; const int nb = r % 24; srccol = 800 + 64 * nb; dstrow = 1024 + 64 * nb; }
            transpose_item(INP(F, I_WIN) + ((size_t)l * DM + 32 * kb) * NIN + srccol, NIN, (GAS bf16*)(F.ws + WS_WIN) + ((size_t)l * NPROJ + dstrow) * DM + 32 * kb, DM, F.lane); continue; }
        it -= N_WIN;
        {   const int l = it / 512, r = it % 512, kb = r / 16, nb = r % 16;
            transpose_item(INP(F, I_WOUT) + ((size_t)l * DM + 32 * kb) * DM + 64 * nb, DM, (GAS bf16*)(F.ws + WS_WOUT) + ((size_t)l * DM + 64 * nb) * DM + 32 * kb, DM, F.lane); }
    }
    __syncthreads();
    f8w_convert_all(F);
}
__device__ __forceinline__ void prologue2(Frame& F) {
    const int gw = F.vcu * NWAVES + F.wave, NGW = F.G * NWAVES, lane = F.lane; const GAS float* mod = (const GAS float*)(F.ws + WS_MOD);
    LAS float* PV = (LAS float*)F.lds;
    for (int i = F.tid; i < 4 * 256; i += NTHR) { const int b = i >> 8, c4 = i & 255; const GAS float* mb = mod + (size_t)b * 6144;
        const f32x4 gg = ((const GAS f32x4*)INP(F, I_MPRE))[c4], s1 = ((const GAS f32x4*)(mb + 1024))[c4], s0 = ((const GAS f32x4*)mb)[c4];
        LAS f32x4* pv = (LAS f32x4*)(PV + b * 2048) + c4; pv[0] = gg * (1.0f + s1); pv[256] = s0; }
    __syncthreads();
    for (int m = gw; m < M; m += NGW) { const int b = m >> 12; f32x4 v[4]; row_load(INP(F, I_X) + (size_t)m * DM, lane, v);
        const LAS f32x4* Bv = (const LAS f32x4*)(PV + b * 2048); const float rstd = rsq(row_ss(v, lane) * (1.0f / DM) + EPS); GAS v2u* orow = (GAS v2u*)((GAS bf16*)(F.ws + WS_HN) + (size_t)m * DM);
#pragma unroll
        for (int j = 0; j < 4; ++j) { const int c4 = lane + 64 * j; const f32x4 o4 = v[j] * rstd * Bv[c4] + Bv[256 + c4]; v2u o; o.x = pk2(o4[0], o4[1]); o.y = pk2(o4[2], o4[3]); orow[c4] = o; } }
    __syncthreads();
}

__device__ __forceinline__ void gla_cumsums(const GAS bf16* proj_chunk  , int h, const GAS float* bdec  , int lane, float (&pf)[16], float (&sb)[16], float& totf, float& totb) {
    const int dk = lane & 31, half = lane >> 5;
    const float bf_ = bdec[h * 32 + dk], bb_ = bdec[128 + h * 32 + dk];
    const GAS bf16* pr = proj_chunk + (size_t)(16 * half) * NPROJ + h * 32 + dk;
    float accf = 0.f;
#pragma unroll
    for (int ii = 0; ii < 16; ++ii) { accf += logsigf(bf2f(pr[(size_t)ii * NPROJ + PC_LAF]) + bf_) * (1.0f / 16.0f); pf[ii] = accf; }
    float accb = 0.f;
#pragma unroll
    for (int ii = 15; ii >= 0; --ii) { accb += logsigf(bf2f(pr[(size_t)ii * NPROJ + PC_LAB]) + bb_) * (1.0f / 16.0f); sb[ii] = accb; }
    const float of = lane_get(accf, lane ^ 32), ob = lane_get(accb, lane ^ 32);
    totf = accf + of; totb = accb + ob;
    if (half == 1) {
#pragma unroll
        for (int ii = 0; ii < 16; ++ii) pf[ii] += of; }
    else {
#pragma unroll
        for (int ii = 0; ii < 16; ++ii) sb[ii] += ob; }
}
typedef short g_bf16x8 __attribute__((ext_vector_type(8)));
typedef float g_f32x16 __attribute__((ext_vector_type(16)));
__device__ __forceinline__ g_bf16x8 g_frag(unsigned a, unsigned b, unsigned c, unsigned d) { v4u w; w.x = a; w.y = b; w.z = c; w.w = d; return __builtin_bit_cast(g_bf16x8, w); }
__device__ __forceinline__ g_bf16x8 g_col8(const GAS bf16* p, size_t st) {
    unsigned e[8];
#pragma unroll
    for (int j = 0; j < 8; ++j) e[j] = p[(size_t)j * st];
    return g_frag(e[0] | (e[1] << 16), e[2] | (e[3] << 16), e[4] | (e[5] << 16), e[6] | (e[7] << 16));
}
__device__ __forceinline__ void gla_chunk_kv(Frame& F, int l, int item) {
    int lane = F.lane; asm volatile("" : "+v"(lane));
    const int n = item & 127, h = (item >> 7) & 3, b = item >> 9, dk = lane & 31, half = lane >> 5;
    const GAS bf16* proj = (const GAS bf16*)(F.ws + WS_PROJ) + (size_t)(b * SEQ + 32 * n) * NPROJ;
    g_bf16x8 vb[2][2];
#pragma unroll
    for (int s = 0; s < 2; ++s)
#pragma unroll
        for (int blk = 0; blk < 2; ++blk) vb[s][blk] = g_col8(proj + (size_t)(16 * half + 8 * s) * NPROJ + PC_GV + h * 64 + blk * 32 + dk, NPROJ);
    float pf[16], sb[16], totf, totb;
    gla_cumsums(proj, h, INP(F, I_GBDEC) + l * 256, lane, pf, sb, totf, totb);
    unsigned wf[8], wb[8];
#pragma unroll
    for (int ip = 0; ip < 8; ++ip) {
        const float k0 = bf2f(proj[(size_t)(16 * half + 2 * ip) * NPROJ + PC_GK + h * 32 + dk]), k1 = bf2f(proj[(size_t)(16 * half + 2 * ip + 1) * NPROJ + PC_GK + h * 32 + dk]);
        wf[ip] = pk2(k0 * __expf(totf - pf[2 * ip]), k1 * __expf(totf - pf[2 * ip + 1])); wb[ip] = pk2(k0 * __expf(totb - sb[2 * ip]), k1 * __expf(totb - sb[2 * ip + 1])); }
    GAS float* alast = (GAS float*)(F.ws + WS_ALAST);
    if (half == 0) { alast[(size_t)(((b * 4 + h) * 2 + 0) * NCHUNK + n) * 32 + dk] = __expf(totf); alast[(size_t)(((b * 4 + h) * 2 + 1) * NCHUNK + n) * 32 + dk] = __expf(totb); }
    g_f32x16 accf[2], accb[2];
#pragma unroll
    for (int blk = 0; blk < 2; ++blk)
#pragma unroll
        for (int r = 0; r < 16; ++r) { accf[blk][r] = 0.f; accb[blk][r] = 0.f; }
#pragma unroll
    for (int s = 0; s < 2; ++s) { const g_bf16x8 af = g_frag(wf[4 * s], wf[4 * s + 1], wf[4 * s + 2], wf[4 * s + 3]), ab = g_frag(wb[4 * s], wb[4 * s + 1], wb[4 * s + 2], wb[4 * s + 3]);
#pragma unroll
        for (int blk = 0; blk < 2; ++blk) { accf[blk] = __builtin_amdgcn_mfma_f32_32x32x16_bf16(af, vb[s][blk], accf[blk], 0, 0, 0); accb[blk] = __builtin_amdgcn_mfma_f32_32x32x16_bf16(ab, vb[s][blk], accb[blk], 0, 0, 0); } }
    GAS bf16* gkv = (GAS bf16*)(F.ws + WS_GKV);
    GAS bf16* of_ = gkv + (size_t)(((b * 4 + h) * 2 + 0) * NCHUNK + n) * 2048 + dk * 8 + 4 * half; GAS bf16* ob_ = gkv + (size_t)(((b * 4 + h) * 2 + 1) * NCHUNK + n) * 2048 + dk * 8 + 4 * half;
#pragma unroll
    for (int blk = 0; blk < 2; ++blk)
#pragma unroll
        for (int g = 0; g < 4; ++g) { const int f = ((((g >> 1) * 2 + blk) * 2 + (g & 1)) * 32) * 8;
            v2u wf_, wb_; wf_.x = pk2(accf[blk][4 * g], accf[blk][4 * g + 1]); wf_.y = pk2(accf[blk][4 * g + 2], accf[blk][4 * g + 3]); wb_.x = pk2(accb[blk][4 * g], accb[blk][4 * g + 1]); wb_.y = pk2(accb[blk][4 * g + 2], accb[blk][4 * g + 3]);
            *(GAS v2u*)(of_ + f) = wf_; *(GAS v2u*)(ob_ + f) = wb_; }
}
__device__ __forceinline__ void qk_prep_rows4(Frame& F, int l, int m0, int mstep, const LAS float* tab) {
    const int lane = F.lane;
    const LAS float* gt = tab + 2048;
    const GAS bf16* proj = (const GAS bf16*)(F.ws + WS_PROJ);
    v2u xa[5], xb[5];
#pragma unroll
    for (int i = 0; i < 5; ++i) { const int T = lane + 64 * i, q = (T * 205) >> 14, r = T - 80 * q, head = r >> 3, hf = (r >> 2) & 1, jj = r & 3, d1 = hf * 32 + 4 * jj;
        const GAS bf16* pr = proj + (size_t)(m0 + q * mstep) * NPROJ + ((head < 8) ? (PC_AQ + head * 64) : (PC_AK + (head - 8) * 64)) + d1;
        xa[i] = *(const GAS v2u*)pr; xb[i] = *(const GAS v2u*)(pr + 16); }
    const int mv = m0 + (lane >> 4) * mstep;
    const v4u vv = *(const GAS v4u*)(proj + (size_t)mv * NPROJ + PC_AV + 8 * (lane & 15));
#pragma unroll
    for (int i = 0; i < 5; ++i) { const int T = lane + 64 * i, q = (T * 205) >> 14, r = T - 80 * q, head = r >> 3, hf = (r >> 2) & 1, jj = r & 3, d1 = hf * 32 + 4 * jj;
        const int m = m0 + q * mstep, t = m & (SEQ - 1), pos = hf ? (t & 63) : (t >> 6);
        const float x1[4] = {__uint_as_float(xa[i].x << 16), __uint_as_float(xa[i].x & 0xffff0000u), __uint_as_float(xa[i].y << 16), __uint_as_float(xa[i].y & 0xffff0000u)};
        const float x2[4] = {__uint_as_float(xb[i].x << 16), __uint_as_float(xb[i].x & 0xffff0000u), __uint_as_float(xb[i].y << 16), __uint_as_float(xb[i].y & 0xffff0000u)};
        float ss = (x1[0] * x1[0] + x1[1] * x1[1]) + (x1[2] * x1[2] + x1[3] * x1[3]) + (x2[0] * x2[0] + x2[1] * x2[1]) + (x2[2] * x2[2] + x2[3] * x2[3]);
        ss += dpp_f<DPP_X1>(ss); ss += dpp_f<DPP_X2>(ss); ss += dpp_f<DPP_HMIR>(ss);
        const float rstd = rsq(ss * (1.0f / 64.0f) + EPS);
        const LAS float* g = gt + ((head < 8) ? 0 : 64) + d1; const f32x4 ga = *(const LAS f32x4*)g, gb = *(const LAS f32x4*)(g + 16);
        const LAS f32x4* tp = (const LAS f32x4*)(tab + (pos * 16 + 4 * jj) * 2); const f32x4 c0 = tp[0], c1 = tp[1];
        const float sc = (head < 8) ? rstd * ATT_C2 : rstd;
        float o1[4], o2[4];
#pragma unroll
        for (int e = 0; e < 4; ++e) { const float y1 = x1[e] * sc * ga[e], y2 = x2[e] * sc * gb[e]; const float cs = (e < 2) ? c0[2 * e] : c1[2 * e - 4], sn = (e < 2) ? c0[2 * e + 1] : c1[2 * e - 3];
            o1[e] = y1 * cs - y2 * sn; o2[e] = y2 * cs + y1 * sn; }
        GAS bf16* op = (head < 8) ? ((GAS bf16*)(F.ws + WS_QP) + (size_t)m * 512 + head * 64 + d1) : ((GAS bf16*)(F.ws + WS_KV) + (size_t)m * 256 + (head - 8) * 64 + d1);
        v2u w1, w2; w1.x = pk2(o1[0], o1[1]); w1.y = pk2(o1[2], o1[3]); w2.x = pk2(o2[0], o2[1]); w2.y = pk2(o2[2], o2[3]);
        *(GAS v2u*)op = w1; *(GAS v2u*)(op + 16) = w2; }
    *(GAS v4u*)((GAS bf16*)(F.ws + WS_KV) + (size_t)mv * 256 + 128 + 8 * (lane & 15)) = vv;
}
__device__ __forceinline__ float bfe(const v4u& w, int e) { const unsigned u = (e & 1) ? (w[e >> 1] & 0xffff0000u) : (w[e >> 1] << 16); return __uint_as_float(u); }
__device__ __forceinline__ void hy_rows(const GAS bf16* p, int tq0, v4u (&rows)[6]) {
#pragma unroll
    for (int r = 0; r < 6; ++r) { const int t = tq0 - 1 + r; rows[r] = (t >= 0 && t < SEQ) ? *(const GAS v4u*)(p + (ptrdiff_t)(r - 1) * NPROJ) : (v4u){0u, 0u, 0u, 0u}; }
}
template <int EH> __device__ __forceinline__ void hy_conv4x4(const v4u (&rows)[6], const GAS float* w, const GAS float* bias, float (&u)[4][4]) {
    const f32x4 w0 = *(const GAS f32x4*)(w + 4 * EH), w1 = *(const GAS f32x4*)(w + 768 + 4 * EH), w2 = *(const GAS f32x4*)(w + 1536 + 4 * EH), bs = *(const GAS f32x4*)(bias + 4 * EH);
#pragma unroll
    for (int e = 0; e < 4; ++e)
#pragma unroll
        for (int i = 0; i < 4; ++i) u[i][e] = bfe(rows[i], 4 * EH + e) * w0[e] + bfe(rows[i + 1], 4 * EH + e) * w1[e] + bfe(rows[i + 2], 4 * EH + e) * w2[e] + bs[e];
}
template <int EH> __device__ __forceinline__ void hy_z_half(const v4u (&r1)[6], const v4u (&r2)[6], const GAS float* cw, const GAS float* cb, unsigned (&zp)[4][4]) {
    float x1[4][4], vv[4][4]; hy_conv4x4<EH>(r1, cw + 256, cb + 256, x1); hy_conv4x4<EH>(r2, cw + 512, cb + 512, vv);
#pragma unroll
    for (int i = 0; i < 4; ++i) { zp[i][2 * EH] = pk2(x1[i][0] * vv[i][0], x1[i][1] * vv[i][1]); zp[i][2 * EH + 1] = pk2(x1[i][2] * vv[i][2], x1[i][3] * vv[i][3]); }
    __builtin_amdgcn_sched_barrier(0);
}
__device__ __forceinline__ void hy_prep_item(Frame& F, int l, int item, LAS unsigned char* lb) {
    int tid = F.tid; asm volatile("" : "+v"(tid));
    const int b = item >> 6, t0 = (item & 63) * 64, cg = tid & 31, tq = tid >> 5, tq0 = t0 + 4 * tq;
    const GAS bf16* p = (const GAS bf16*)(F.ws + WS_PROJ) + ((size_t)b * SEQ + tq0) * NPROJ + PC_HX1 + 8 * cg;
    const GAS float* cw = INP(F, I_HCW) + l * 3 * 768 + 8 * cg; const GAS float* cb = INP(F, I_HCB) + l * 768 + 8 * cg;
    v4u r1[6], r2[6]; hy_rows(p, tq0, r1); hy_rows(p + 256, tq0, r2);
    unsigned zp[4][4]; hy_z_half<0>(r1, r2, cw, cb, zp); hy_z_half<1>(r1, r2, cw, cb, zp);
    LAS bf16* zs = (LAS bf16*)lb;
#pragma unroll
    for (int e = 0; e < 8; ++e) { const int sh = (e & 1) * 16; v2u o;
        o.x = ((zp[0][e >> 1] >> sh) & 0xffffu) | (((zp[1][e >> 1] >> sh) & 0xffffu) << 16); o.y = ((zp[2][e >> 1] >> sh) & 0xffffu) | (((zp[3][e >> 1] >> sh) & 0xffffu) << 16);
        *(LAS v2u*)(zs + (8 * cg + e) * 72 + 4 * tq) = o; }
    __syncthreads();
    {   const int cc = tid >> 1, hh = tid & 1; GAS bf16* zt = (GAS bf16*)(F.ws + WS_ZT) + ((size_t)cc * BATCH + b) * SEQ + t0 + hh * 32;
#pragma unroll
        for (int q = 0; q < 4; ++q) *(GAS v4u*)(zt + 8 * q) = *(LAS v4u*)(zs + cc * 72 + hh * 32 + 8 * q); }
    __syncthreads();
}
__device__ __forceinline__ void phase_prep(Frame& F, int l) {
    LAS float* tab = (LAS float*)F.lds;
    for (int i = F.tid; i < 1024; i += NTHR) { const int pos = i >> 4, j = i & 15; const float inv = exp2f(-(float)j * (13.287712379549449f / 16.0f)); float sn, cs; sincosf((float)pos * inv, &sn, &cs); tab[2 * i] = cs; tab[2 * i + 1] = sn; }
    if (F.tid < 128) tab[2048 + F.tid] = (F.tid < 64) ? INP(F, I_QNORM)[l * 64 + F.tid] : INP(F, I_KNORM)[l * 64 + F.tid - 64];
    __syncthreads();
    for (int it = blockIdx.x; it < 256; it += F.G) hy_prep_item(F, l, it, F.lds + 8192 + 512);
    const int gw = F.vcu * NWAVES + F.wave, NGW = F.G * NWAVES;
    for (int it = gw; it < 2048; it += NGW) gla_chunk_kv(F, l, it);
    for (int m = gw; m + 3 * NGW < M; m += 4 * NGW) qk_prep_rows4(F, l, m, NGW, tab);
    if ((M / NGW) % 4 != 0 || M % NGW != 0) { for (int m = gw + (M / NGW / 4) * 4 * NGW; m < M; m += NGW) qk_prep_rows4(F, l, m, 0, tab); }
}

__device__ __forceinline__ void gla_scan_item(Frame& F, int item) {
    const int sub = item & 7, bhd = item >> 3, dir = bhd & 1, lane = F.lane, w = F.wave, dk0 = 16 * (sub >> 2) + 8 * (sub & 1) + 4 * (lane & 1);
    GAS bf16* kv = (GAS bf16*)(F.ws + WS_GKV) + (size_t)bhd * NCHUNK * 2048 + sub * 256 + 4 * lane;
    const GAS float* al = (const GAS float*)(F.ws + WS_ALAST) + (size_t)bhd * NCHUNK * 32 + dk0;
    LAS f32x4* AB = (LAS f32x4*)F.lds;
    v2u x[16]; f32x4 a[16];
#pragma unroll
    for (int q = 0; q < 16; ++q) { const int p = 16 * w + q, n = dir ? (NCHUNK - 1 - p) : p; x[q] = *(const GAS v2u*)(kv + (size_t)n * 2048); a[q] = *(const GAS f32x4*)(al + n * 32); }
    f32x4 A = (f32x4){1.f, 1.f, 1.f, 1.f}, B = (f32x4){0.f, 0.f, 0.f, 0.f};
#pragma unroll
    for (int q = 0; q < 16; ++q) { const f32x4 xv = (f32x4){__uint_as_float(x[q].x << 16), __uint_as_float(x[q].x & 0xffff0000u), __uint_as_float(x[q].y << 16), __uint_as_float(x[q].y & 0xffff0000u)};
        B = a[q] * B + xv; A = A * a[q]; }
    AB[(w * 2 + 0) * 64 + lane] = A; AB[(w * 2 + 1) * 64 + lane] = B;
    __syncthreads();
    f32x4 S = (f32x4){0.f, 0.f, 0.f, 0.f};
    for (int v = 0; v < w; ++v) S = AB[(v * 2 + 0) * 64 + lane] * S + AB[(v * 2 + 1) * 64 + lane];
#pragma unroll
    for (int q = 0; q < 16; ++q) { const int p = 16 * w + q, n = dir ? (NCHUNK - 1 - p) : p;
        v2u o; o.x = pk2(S[0], S[1]); o.y = pk2(S[2], S[3]); *(GAS v2u*)(kv + (size_t)n * 2048) = o;
        const f32x4 xv = (f32x4){__uint_as_float(x[q].x << 16), __uint_as_float(x[q].x & 0xffff0000u), __uint_as_float(x[q].y << 16), __uint_as_float(x[q].y & 0xffff0000u)};
        S = a[q] * S + xv; }
    __syncthreads();
}
typedef short hy_bf16x8 __attribute__((ext_vector_type(8)));
typedef short hy_bf16x8_a8 __attribute__((ext_vector_type(8), aligned(8)));
typedef float hy_f32x16 __attribute__((ext_vector_type(16)));
constexpr int HYC_CST = 8224, HYC_Z_OFF = 4 * HYC_CST * 2, HYC_ZROW = 144;
__device__ __forceinline__ void hy_conv_item(Frame& F, int l, int c) {
    const int tid = F.tid, lane = F.lane, w = F.wave;
    LAS bf16* G = (LAS bf16*)F.lds; LAS unsigned char* Z = F.lds + HYC_Z_OFF;
    const GAS float* hf = (const GAS float*)(F.ws + WS_HF) + ((size_t)l * 256 + c) * 8192;
    {
        LAS float* HS = (LAS float*)Z;
        for (int i = tid; i < 2048; i += NTHR) *(LAS f32x4*)(HS + 4 * i) = *(const GAS f32x4*)(hf + 4 * i);
        __syncthreads();
        for (int i = tid; i < 4 * HYC_CST / 2; i += NTHR) { const int q = i / (HYC_CST / 2), u = 2 * (i % (HYC_CST / 2)); const int i0 = 8192 + q - u, i1 = i0 - 1;
            const float v0 = (i0 >= 1 && i0 <= 8191) ? HS[i0] : 0.f, v1 = (i1 >= 1 && i1 <= 8191) ? HS[i1] : 0.f;
            ((LAS unsigned*)G)[i] = pk2(v0, v1); }
        __syncthreads(); }
    const GAS bf16* zt = (const GAS bf16*)(F.ws + WS_ZT) + (size_t)c * BATCH * SEQ;
    for (int i = tid; i < BATCH * SEQ / 8; i += NTHR) { const int b = i >> 9, s8 = i & 511, S = s8 >> 3, j8 = s8 & 7;
        *(LAS v4u*)(Z + (S * 4 + b) * HYC_ZROW + j8 * 16) = *(const GAS v4u*)(zt + (size_t)b * SEQ + s8 * 8); }
    if (tid < 36) ((LAS unsigned*)(Z + 256 * HYC_ZROW))[tid] = 0u;
    __syncthreads();
    const int r = lane & 31, h = lane >> 5, q = r & 3, nT = 8 * w + (r >> 2), nb = r & 3;
    hy_f32x16 acc0, acc1;
#pragma unroll
    for (int i = 0; i < 16; ++i) { acc0[i] = 0.f; acc1[i] = 0.f; }
    const int a_base = q * HYC_CST + 4096 + 8 * h - (r - q);
    hy_bf16x8 c2, c3;
    {   const LAS bf16* ap = G + (a_base - 64 * (8 * w - 63)); c2 = *(const LAS hy_bf16x8_a8*)(ap + 32); c3 = *(const LAS hy_bf16x8_a8*)(ap + 48); }
    const bool host = (l == 0) && (F.G == 256) && (c == F.vcu);
    const int hq0 = F8W_HOST0 + F.vcu * NWAVES + w; F8WItem hit; f32x4 hv[16]; int di = 0;
#define HYC_LOAD(DD, A00, A01, A10, A11, B0, B1, B2, B3) do { const int S_ = nT - (DD); const int zr_ = (S_ >= 0 && S_ < 64) ? (S_ * 4 + nb) : 256; \
        const LAS unsigned char* zp_ = Z + zr_ * HYC_ZROW + h * 16; const LAS bf16* ap_ = G + (a_base - 64 * (DD)); \
        B0 = *(const LAS hy_bf16x8*)(zp_); B1 = *(const LAS hy_bf16x8*)(zp_ + 32); B2 = *(const LAS hy_bf16x8*)(zp_ + 64); B3 = *(const LAS hy_bf16x8*)(zp_ + 96); \
        A00 = *(const LAS hy_bf16x8_a8*)(ap_); A01 = *(const LAS hy_bf16x8_a8*)(ap_ + 16); A10 = *(const LAS hy_bf16x8_a8*)(ap_ - 32); A11 = *(const LAS hy_bf16x8_a8*)(ap_ - 16); } while (0)
    hy_bf16x8 a00, a01, a10, a11, b0, b1, b2, b3;
    HYC_LOAD(8 * w - 63, a00, a01, a10, a11, b0, b1, b2, b3);
    for (int D = 8 * w - 63; D <= 8 * w + 7; ++D, ++di) {
        if (host && (di & 15) == 0) {
            if (di > 0) f8w_finish(hit, hv);
            if (di < 16 * F8W_HOSTED) { hit = f8w_item(F, hq0 + (di >> 4) * (F.G * NWAVES)); f8w_load(hit, hv); } }
        hy_bf16x8 n00, n01, n10, n11, m0, m1, m2, m3;
        HYC_LOAD((D < 8 * w + 7) ? D + 1 : D, n00, n01, n10, n11, m0, m1, m2, m3);
        acc0 = __builtin_amdgcn_mfma_f32_32x32x16_bf16(a00, b0, acc0, 0, 0, 0); acc1 = __builtin_amdgcn_mfma_f32_32x32x16_bf16(a10, b0, acc1, 0, 0, 0);
        acc0 = __builtin_amdgcn_mfma_f32_32x32x16_bf16(a01, b1, acc0, 0, 0, 0); acc1 = __builtin_amdgcn_mfma_f32_32x32x16_bf16(a11, b1, acc1, 0, 0, 0);
        acc0 = __builtin_amdgcn_mfma_f32_32x32x16_bf16(c2, b2, acc0, 0, 0, 0);  acc1 = __builtin_amdgcn_mfma_f32_32x32x16_bf16(a00, b2, acc1, 0, 0, 0);
        acc0 = __builtin_amdgcn_mfma_f32_32x32x16_bf16(c3, b3, acc0, 0, 0, 0);  acc1 = __builtin_amdgcn_mfma_f32_32x32x16_bf16(a01, b3, acc1, 0, 0, 0);
        c2 = a10; c3 = a11; a00 = n00; a01 = n01; a10 = n10; a11 = n11; b0 = m0; b1 = m1; b2 = m2; b3 = m3;
    }
#undef HYC_LOAD
    GAS bf16* yc = (GAS bf16*)(F.ws + WS_YC) + ((size_t)c * BATCH + nb) * SEQ + 64 * nT + 4 * h;
#pragma unroll
    for (int g = 0; g < 4; ++g) {
        v2u o0; o0.x = pk2(acc0[4 * g], acc0[4 * g + 1]); o0.y = pk2(acc0[4 * g + 2], acc0[4 * g + 3]); *(GAS v2u*)(yc + 8 * g) = o0;
        v2u o1; o1.x = pk2(acc1[4 * g], acc1[4 * g + 1]); o1.y = pk2(acc1[4 * g + 2], acc1[4 * g + 3]); *(GAS v2u*)(yc + 32 + 8 * g) = o1; }
    __syncthreads();
}

__device__ __forceinline__ void gla_out_item(Frame& F, int l, int item, LAS bf16* wl  ) {
    int lane = F.lane; asm volatile("" : "+v"(lane));
    const int n = item & 127, h = (item >> 7) & 3, b = item >> 9, dk = lane & 31, half = lane >> 5;
    const size_t m0 = (size_t)b * SEQ + 32 * n;
    const GAS bf16* proj = (const GAS bf16*)(F.ws + WS_PROJ) + m0 * NPROJ;
    const GAS bf16* gkv = (const GAS bf16*)(F.ws + WS_GKV);
    LAS bf16* R1 = wl; LAS bf16* R2 = wl + 5120;
    LAS bf16* QDF = wl; LAS bf16* KIF = wl + 1280; LAS bf16* QDB = wl + 2560; LAS bf16* KIB = wl + 3840;
    const int rA = lane >> 2, pA = lane & 3, rB = lane >> 3, pB = lane & 7;
    v4u pin[8], pvv[4], pgg[4];
#pragma unroll
    for (int a = 0; a < 4; ++a) { const int col = (a == 0 ? PC_LAF : a == 1 ? PC_LAB : a == 2 ? PC_GQ : PC_GK) + h * 32 + 8 * pA;
        pin[2 * a] = *(const GAS v4u*)(proj + (size_t)rA * NPROJ + col); pin[2 * a + 1] = *(const GAS v4u*)(proj + (size_t)(rA + 16) * NPROJ + col); }
#pragma unroll
    for (int rep = 0; rep < 4; ++rep) { pvv[rep] = *(const GAS v4u*)(proj + (size_t)(rB + 8 * rep) * NPROJ + PC_GV + h * 64 + 8 * pB); pgg[rep] = *(const GAS v4u*)(proj + (size_t)(rB + 8 * rep) * NPROJ + PC_GG + h * 64 + 8 * pB); }
    g_bf16x8 sfr[2][2][2];
#pragma unroll
    for (int dir = 0; dir < 2; ++dir) { const GAS bf16* Sp = gkv + (size_t)(((b * 4 + h) * 2 + dir) * NCHUNK + n) * 2048 + (half * 32 + dk) * 8;
#pragma unroll
        for (int s = 0; s < 2; ++s)
#pragma unroll
            for (int blk = 0; blk < 2; ++blk) sfr[dir][s][blk] = *(const GAS g_bf16x8*)(Sp + (s * 2 + blk) * 512); }
    const float bf_ = (INP(F, I_GBDEC) + l * 256)[h * 32 + dk], bb_ = (INP(F, I_GBDEC) + l * 256)[128 + h * 32 + dk];
    LDS_WAIT(); asm volatile("" ::: "memory");
#pragma unroll
    for (int a = 0; a < 4; ++a) { *(LAS v4u*)(R1 + a * 1280 + rA * 40 + 8 * pA) = pin[2 * a]; *(LAS v4u*)(R1 + a * 1280 + (rA + 16) * 40 + 8 * pA) = pin[2 * a + 1]; }
#pragma unroll
    for (int rep = 0; rep < 4; ++rep) *(LAS v4u*)(R2 + (rB + 8 * rep) * 72 + 8 * pB) = pvv[rep];
    LDS_WAIT(); asm volatile("" ::: "memory");
    g_f32x16 o[2];
#pragma unroll
    for (int blk = 0; blk < 2; ++blk)
#pragma unroll
        for (int r = 0; r < 16; ++r) o[blk][r] = 0.f;
    g_bf16x8 qf[2], qb[2];
    {
        g_bf16x8 kf[2], kb[2];
        g_bf16x8 vfr[2][2];
#pragma unroll
        for (int s = 0; s < 2; ++s)
#pragma unroll
            for (int blk = 0; blk < 2; ++blk) { const LAS bf16* vp = R2 + (16 * s + 4 * half) * 72 + blk * 32 + dk; unsigned ev[8];
#pragma unroll
                for (int jj = 0; jj < 8; ++jj) ev[jj] = vp[(8 * (jj >> 2) + (jj & 3)) * 72];
                vfr[s][blk] = g_frag(ev[0] | (ev[1] << 16), ev[2] | (ev[3] << 16), ev[4] | (ev[5] << 16), ev[6] | (ev[7] << 16)); }
        {
            float pf[16], sb[16], qv[16], kv[16];
            {   const LAS bf16* cp = R1 + (16 * half) * 40 + dk;
                float accf = 0.f;
#pragma unroll
                for (int ii = 0; ii < 16; ++ii) { accf += logsigf(bf2f(cp[ii * 40]) + bf_) * (1.0f / 16.0f); pf[ii] = accf; }
                float accb = 0.f;
#pragma unroll
                for (int ii = 15; ii >= 0; --ii) { accb += logsigf(bf2f(cp[1280 + ii * 40]) + bb_) * (1.0f / 16.0f); sb[ii] = accb; }
#pragma unroll
                for (int ii = 0; ii < 16; ++ii) { qv[ii] = bf2f(cp[2560 + ii * 40]) * 0.17677669529663687f; kv[ii] = bf2f(cp[3840 + ii * 40]); }
                const float of = lane_get(accf, lane ^ 32), ob = lane_get(accb, lane ^ 32);
                if (half == 1) {
#pragma unroll
                    for (int ii = 0; ii < 16; ++ii) pf[ii] += of; }
                else {
#pragma unroll
                    for (int ii = 0; ii < 16; ++ii) sb[ii] += ob; }
            }
            LDS_WAIT(); asm volatile("" ::: "memory");
#pragma unroll
            for (int ii = 0; ii < 16; ++ii) { const int i = 16 * half + ii;
                QDF[i * 40 + dk] = (bf16)f2bf(qv[ii] * __expf(pf[ii])); KIF[i * 40 + dk] = (bf16)f2bf(kv[ii] * __expf(-pf[ii]));
                QDB[i * 40 + dk] = (bf16)f2bf(qv[ii] * __expf(sb[ii])); KIB[i * 40 + dk] = (bf16)f2bf(kv[ii] * __expf(-sb[ii])); }
            LDS_WAIT(); asm volatile("" ::: "memory");
        }
#pragma unroll
        for (int s = 0; s < 2; ++s) { const int fo = dk * 40 + 16 * s + 8 * half;
            qf[s] = *(const LAS g_bf16x8*)(QDF + fo); kf[s] = *(const LAS g_bf16x8*)(KIF + fo); qb[s] = *(const LAS g_bf16x8*)(QDB + fo); kb[s] = *(const LAS g_bf16x8*)(KIB + fo); }
        LDS_WAIT(); asm volatile("" ::: "memory");
#pragma unroll
        for (int rep = 0; rep < 4; ++rep) *(LAS v4u*)(R1 + (rB + 8 * rep) * 72 + 8 * pB) = pgg[rep];
        g_f32x16 xf, xb;
#pragma unroll
        for (int r = 0; r < 16; ++r) { xf[r] = 0.f; xb[r] = 0.f; }
#pragma unroll
        for (int s = 0; s < 2; ++s) { xf = __builtin_amdgcn_mfma_f32_32x32x16_bf16(kf[s], qf[s], xf, 0, 0, 0); xb = __builtin_amdgcn_mfma_f32_32x32x16_bf16(kb[s], qb[s], xb, 0, 0, 0); }
        unsigned xw[8];
#pragma unroll
        for (int rp = 0; rp < 8; ++rp) { float t[2];
#pragma unroll
            for (int u = 0; u < 2; ++u) { const int r = 2 * rp + u, j = (r & 3) + 8 * (r >> 2) + 4 * half; t[u] = ((dk >= j) ? xf[r] : 0.f) + ((dk <= j) ? xb[r] : 0.f); }
            xw[rp] = pk2(t[0], t[1]); }
#pragma unroll
        for (int s = 0; s < 2; ++s) { const g_bf16x8 xa = g_frag(xw[4 * s], xw[4 * s + 1], xw[4 * s + 2], xw[4 * s + 3]);
#pragma unroll
            for (int blk = 0; blk < 2; ++blk) o[blk] = __builtin_amdgcn_mfma_f32_32x32x16_bf16(xa, vfr[s][blk], o[blk], 0, 0, 0); }
    }
#pragma unroll
    for (int dir = 0; dir < 2; ++dir)
#pragma unroll
        for (int s = 0; s < 2; ++s)
#pragma unroll
            for (int blk = 0; blk < 2; ++blk) o[blk] = __builtin_amdgcn_mfma_f32_32x32x16_bf16(dir ? qb[s] : qf[s], sfr[dir][s][blk], o[blk], 0, 0, 0);
    const float ng0 = INP(F, I_GNORM)[l * 64 + dk], ng1 = INP(F, I_GNORM)[l * 64 + 32 + dk];
    LDS_WAIT(); asm volatile("" ::: "memory");
#pragma unroll
    for (int r4 = 0; r4 < 4; ++r4) {
        float g0[4], g1[4], ss[4];
#pragma unroll
        for (int k = 0; k < 4; ++k) { const int row = k + 8 * r4 + 4 * half; g0[k] = bf2f(R1[row * 72 + dk]); g1[k] = bf2f(R1[row * 72 + 32 + dk]); ss[k] = o[0][4 * r4 + k] * o[0][4 * r4 + k] + o[1][4 * r4 + k] * o[1][4 * r4 + k]; }
#pragma unroll
        for (int k = 0; k < 4; ++k) ss[k] = half_sum(ss[k]);
#pragma unroll
        for (int k = 0; k < 4; ++k) { const int row = k + 8 * r4 + 4 * half; const float rstd = rsq(ss[k] * (1.0f / 64.0f) + EPS);
            R2[row * 72 + dk] = (bf16)f2bf(o[0][4 * r4 + k] * rstd * ng0 * siluf(g0[k])); R2[row * 72 + 32 + dk] = (bf16)f2bf(o[1][4 * r4 + k] * rstd * ng1 * siluf(g1[k])); }
    }
    LDS_WAIT(); asm volatile("" ::: "memory");
    GAS bf16* cat = (GAS bf16*)(F.ws + WS_CAT) + m0 * DM + h * 64 + 8 * pB;
#pragma unroll
    for (int rep = 0; rep < 4; ++rep) *(GAS v4u*)(cat + (size_t)(rB + 8 * rep) * DM) = *(const LAS v4u*)(R2 + (rB + 8 * rep) * 72 + 8 * pB);
}
__device__ __forceinline__ void hy_out_item(Frame& F, int l, int item, LAS unsigned char* lb) {
    int tid = F.tid; asm volatile("" : "+v"(tid));
    const int b = item >> 6, t0 = (item & 63) * 64, cg = tid & 31, tq = tid >> 5, tq0 = t0 + 4 * tq;
    LAS float* ys = (LAS float*)lb;
    {   const GAS bf16* yc = (const GAS bf16*)(F.ws + WS_YC);
#pragma unroll
        for (int k = 0; k < 8; ++k) { const int i = tid + NTHR * k, cc = i >> 4, q = i & 15; const v2u w_ = *(const GAS v2u*)(yc + ((size_t)cc * BATCH + b) * SEQ + t0 + 4 * q);
            const f32x4 v = (f32x4){__uint_as_float(w_.x << 16), __uint_as_float(w_.x & 0xffff0000u), __uint_as_float(w_.y << 16), __uint_as_float(w_.y & 0xffff0000u)};
            ys[(4 * q) * 260 + cc] = v[0]; ys[(4 * q + 1) * 260 + cc] = v[1]; ys[(4 * q + 2) * 260 + cc] = v[2]; ys[(4 * q + 3) * 260 + cc] = v[3]; } }
    const GAS bf16* p = (const GAS bf16*)(F.ws + WS_PROJ) + ((size_t)b * SEQ + tq0) * NPROJ + PC_HX0 + 8 * cg;
    const GAS float* cw = INP(F, I_HCW) + l * 3 * 768 + 8 * cg; const GAS float* cb = INP(F, I_HCB) + l * 768 + 8 * cg;
    __builtin_amdgcn_sched_barrier(0);
    unsigned zp[4][4];
    {   v4u r1[6], r2[6]; hy_rows(p + 256, tq0, r1); hy_rows(p + 512, tq0, r2); hy_z_half<0>(r1, r2, cw, cb, zp); hy_z_half<1>(r1, r2, cw, cb, zp); }
    float x0[4][8];
    {   v4u r0[6]; hy_rows(p, tq0, r0); float h0[4][4], h1[4][4]; hy_conv4x4<0>(r0, cw, cb, h0); hy_conv4x4<1>(r0, cw, cb, h1);
#pragma unroll
        for (int i = 0; i < 4; ++i)
#pragma unroll
            for (int e = 0; e < 4; ++e) { x0[i][e] = h0[i][e]; x0[i][4 + e] = h1[i][e]; } }
    __builtin_amdgcn_sched_barrier(0);
    const GAS float* skp = INP(F, I_HSKIP) + l * 256 + 8 * cg; const f32x4 ska = *(const GAS f32x4*)skp, skb = *(const GAS f32x4*)(skp + 4);
    __syncthreads();
    GAS bf16* cat = (GAS bf16*)(F.ws + WS_CAT) + ((size_t)b * SEQ + tq0) * DM + 768 + 8 * cg;
#pragma unroll
    for (int i = 0; i < 4; ++i) { const f32x4 ya = *(LAS f32x4*)(ys + (4 * tq + i) * 260 + 8 * cg), yb = *(LAS f32x4*)(ys + (4 * tq + i) * 260 + 8 * cg + 4); float o[8];
#pragma unroll
        for (int e = 0; e < 8; ++e) { const float y = (e < 4) ? ya[e & 3] : yb[e & 3], sk = (e < 4) ? ska[e & 3] : skb[e & 3]; const float zz = __uint_as_float((e & 1) ? (zp[i][e >> 1] & 0xffff0000u) : (zp[i][e >> 1] << 16)); o[e] = x0[i][e] * (y + zz * sk); }
        v4u w; w.x = pk2(o[0], o[1]); w.y = pk2(o[2], o[3]); w.z = pk2(o[4], o[5]); w.w = pk2(o[6], o[7]); *(GAS v4u*)(cat + (size_t)i * DM) = w; }
    __syncthreads();
}
__device__ __forceinline__ void phase_mix_out(Frame& F, int l) {
    for (int it = blockIdx.x; it < 256; it += F.G) hy_out_item(F, l, it, F.lds);
    const int gw = F.vcu * NWAVES + F.wave, NGW = F.G * NWAVES;
    for (int it = gw; it < 2048; it += NGW) gla_out_item(F, l, it, (LAS bf16*)(F.lds + F.wave * 14848));
}

__device__ __forceinline__ void post_mix_front(Frame& F, int l, int m, const f32x4 (&y)[4], f32x4 (&x)[4], const LAS float* PV) {
    const int lane = F.lane, b = m >> 12; const LAS f32x4* A = (const LAS f32x4*)(PV + b * 3072); const LAS f32x4* Bv = A + 256; const LAS f32x4* Cv = A + 512;
    const float rstd = rsq(row_ss(y, lane) * (1.0f / DM) + EPS);
#pragma unroll
    for (int j = 0; j < 4; ++j) { const int c4 = lane + 64 * j; x[j] = x[j] + A[c4] * (y[j] * rstd); }
    roww_store_bf16((GAS bf16*)(F.ws + WS_XR) + (size_t)m * DM, lane, x);
    const float rstd2 = rsq(row_ss(x, lane) * (1.0f / DM) + EPS);
    v4u hw;
#pragma unroll
    for (int j = 0; j < 4; ++j) { const int c4 = lane + 64 * j; x[j] = x[j] * rstd2 * Bv[c4] + Cv[c4]; hw[j] = pk4_f8(x[j][0], x[j][1], x[j][2], x[j][3]); }
    ((GAS v4u*)((GAS unsigned char*)(F.ws + WS_HN) + (size_t)m * DM))[lane] = hw;
}
__device__ __forceinline__ void post_mix_route(Frame& F, int m, float (&lg)[16]) {
    const int lane = F.lane, b = m >> 12, t = m & (SEQ - 1);
    const bool b5 = (lane & 32) != 0, b4 = (lane & 16) != 0, b3 = (lane & 8) != 0, b2 = (lane & 4) != 0;
    float a8[8], a4[4], a2[2];
#pragma unroll
    for (int e = 0; e < 8; ++e) a8[e] = swap32_sum(lg[e], lg[8 + e]);
#pragma unroll
    for (int e = 0; e < 4; ++e) a4[e] = swap16_sum(a8[e], a8[4 + e]);
#pragma unroll
    for (int e = 0; e < 2; ++e) { const float keep = b3 ? a4[2 + e] : a4[e], send = b3 ? a4[e] : a4[2 + e]; a2[e] = keep + dpp_f<DPP_ROR8>(send); }
    float v = (b2 ? a2[1] : a2[0]) + dpp_f<DPP_HMIR>(b2 ? a2[0] : a2[1]);
    v += dpp_f<DPP_X2>(v); v += dpp_f<DPP_X1>(v);
    float mx = fmaxf(v, dpp_f<DPP_HMIR>(v)); mx = fmaxf(mx, dpp_f<DPP_ROR8>(mx)); mx = swap16_max(mx); mx = swap32_max(mx);
    const float ex = expf(v - mx); float den = ex + dpp_f<DPP_HMIR>(ex); den += dpp_f<DPP_ROR8>(den); den = swap16_sum(den, den); den = swap32_sum(den, den);
    const int e = (b5 ? 8 : 0) + (b4 ? 4 : 0) + (b3 ? 2 : 0) + (b2 ? 1 : 0);
    if ((lane & 3) == 0) ((GAS float*)(F.ws + WS_AFF))[((size_t)b * NEXP + e) * SEQ + t] = ex / den;
}
__device__ __forceinline__ void phase_post_mix(Frame& F, int l) {
    LAS float* rws = (LAS float*)F.lds;
    for (int i = F.tid; i < DM * NEXP / 4; i += NTHR) { const int k = i >> 2, part = i & 3, g = k >> 2, slot_ = (g >> 2) + 64 * (g & 3);
        *(LAS f32x4*)(rws + slot_ * 68 + (k & 3) * 16 + part * 4) = ((const GAS f32x4*)(INP(F, I_ROUTER) + (size_t)l * DM * NEXP))[i]; }
    const GAS float* mod = (const GAS float*)(F.ws + WS_MOD) + (size_t)l * 4 * 6144;
    LAS float* PV = (LAS float*)(F.lds + 69632);
    for (int i = F.tid; i < 4 * 256; i += NTHR) { const int b = i >> 8, c4 = i & 255; const GAS float* mb = mod + (size_t)b * 6144;
        const f32x4 gm = ((const GAS f32x4*)(mb + 2048))[c4], pg = ((const GAS f32x4*)(INP(F, I_MPOST) + l * DM))[c4], gg = ((const GAS f32x4*)(INP(F, I_FPRE) + l * DM))[c4], s1 = ((const GAS f32x4*)(mb + 4096))[c4], s0 = ((const GAS f32x4*)(mb + 3072))[c4];
        LAS f32x4* pv = (LAS f32x4*)(PV + b * 3072) + ((c4 >> 2) + 64 * (c4 & 3)); pv[0] = gm * pg; pv[256] = gg * (1.0f + s1); pv[512] = s0; }
    __syncthreads();
    const int gw = F.vcu * NWAVES + F.wave, NGW = F.G * NWAVES, lane = F.lane;
    const GAS float* xin = INP(F, I_X); const GAS bf16* xr = (const GAS bf16*)(F.ws + WS_XR); const GAS bf16* Y = (const GAS bf16*)(F.ws + WS_Y);
    for (int m0 = gw; m0 < M; m0 += 4 * NGW) {
        int mm[4]; f32x4 xx[4][4];
#pragma unroll
        for (int q = 0; q < 4; ++q) mm[q] = (m0 + q * NGW < M) ? m0 + q * NGW : m0;
#pragma unroll
        for (int q = 0; q < 4; q += 2) { f32x4 ya[4], yb[4];
            roww_load_bf16(Y + (size_t)mm[q] * DM, lane, ya); roww_load_bf16(Y + (size_t)mm[q + 1] * DM, lane, yb);
            if (l == 0) { roww_load(xin + (size_t)mm[q] * DM, lane, xx[q]); roww_load(xin + (size_t)mm[q + 1] * DM, lane, xx[q + 1]); }
            else { roww_load_bf16(xr + (size_t)mm[q] * DM, lane, xx[q]); roww_load_bf16(xr + (size_t)mm[q + 1] * DM, lane, xx[q + 1]); }
            post_mix_front(F, l, mm[q], ya, xx[q], PV); post_mix_front(F, l, mm[q + 1], yb, xx[q + 1], PV); }
        float lg[4][16];
#pragma unroll
        for (int q = 0; q < 4; ++q)
#pragma unroll
            for (int e = 0; e < 16; ++e) lg[q][e] = 0.f;
#pragma unroll
        for (int j = 0; j < 4; ++j) { const LAS float* wg = rws + (lane + 64 * j) * 68;
#pragma unroll
            for (int i = 0; i < 4; ++i) { const f32x4 w0 = *(const LAS f32x4*)(wg + 16 * i), w1 = *(const LAS f32x4*)(wg + 16 * i + 4), w2 = *(const LAS f32x4*)(wg + 16 * i + 8), w3 = *(const LAS f32x4*)(wg + 16 * i + 12);
#pragma unroll
                for (int q = 0; q < 4; ++q) { const float h = xx[q][j][i];
#pragma unroll
                    for (int e = 0; e < 4; ++e) { lg[q][e] += h * w0[e]; lg[q][4 + e] += h * w1[e]; lg[q][8 + e] += h * w2[e]; lg[q][12 + e] += h * w3[e]; } }
#pragma unroll
                for (int q = 0; q < 4; ++q)
                    asm volatile("" : "+v"(lg[q][0]), "+v"(lg[q][1]), "+v"(lg[q][2]), "+v"(lg[q][3]), "+v"(lg[q][4]), "+v"(lg[q][5]), "+v"(lg[q][6]), "+v"(lg[q][7]),
                                      "+v"(lg[q][8]), "+v"(lg[q][9]), "+v"(lg[q][10]), "+v"(lg[q][11]), "+v"(lg[q][12]), "+v"(lg[q][13]), "+v"(lg[q][14]), "+v"(lg[q][15]));
                } }
#pragma unroll
        for (int q = 0; q < 4; ++q) if (q == 0 || mm[q] != m0) post_mix_route(F, mm[q], lg[q]);
    }
    __syncthreads();
}

__device__ __forceinline__ unsigned block_excl_scan(unsigned v, LAS unsigned* wsum, int lane, int wave) {
    unsigned inc = v;
#pragma unroll
    for (int o = 1; o < 64; o <<= 1) { const unsigned t = lane_getu(inc, lane - o); if (lane >= o) inc += t; }
    if (lane == 63) wsum[wave] = inc;
    __syncthreads();
    unsigned base = 0;
#pragma unroll
    for (int w = 0; w < 8; ++w) base += (w < wave) ? wsum[w] : 0u;
    __syncthreads();
    return base + inc - v;
}
__device__ __forceinline__ void phase_topk(Frame& F) {
    const int tid = F.tid, lane = F.lane, wave = F.wave;
    LAS unsigned* hist = (LAS unsigned*)F.lds;
    LAS unsigned* ctl = hist + 256;
    LAS unsigned* lst = hist + 512;
    const GAS float* aff = (const GAS float*)(F.ws + WS_AFF); GAS int* slotp = (GAS int*)(F.ws + WS_SLOT); GAS float* gate = (GAS float*)(F.ws + WS_GATE);
    const GAS unsigned char* hn8 = (const GAS unsigned char*)(F.ws + WS_HN); GAS unsigned char* xg8 = (GAS unsigned char*)(F.ws + WS_XG);
    for (int it = F.vcu; it < BATCH * NEXP * 4; it += F.G) { const int be = it >> 2, qu = it & 3, b = be >> 4, e = be & 15;
        const GAS f32x4* ap = (const GAS f32x4*)(aff + (size_t)be * SEQ + 8 * tid); const f32x4 v0 = ap[0], v1 = ap[1];
        unsigned key[8];
#pragma unroll
        for (int j = 0; j < 4; ++j) { key[j] = __float_as_uint(v0[j]); key[4 + j] = __float_as_uint(v1[j]); }
        unsigned prefix = 0u, mask = 0u, kk = CAP;
        if (tid == 0) ctl[2] = 0u;
#pragma unroll 1
        for (int pass = 0; pass < 4; ++pass) { const int shift = 24 - 8 * pass;
            if (tid < 256) hist[tid] = 0u;
            __syncthreads();
#pragma unroll
            for (int j = 0; j < 8; ++j) if ((key[j] & mask) == prefix) __hip_atomic_fetch_add(&hist[(key[j] >> shift) & 255u], 1u, __ATOMIC_RELAXED, __HIP_MEMORY_SCOPE_WORKGROUP);
            __syncthreads();
            if (wave == 0) { const unsigned h0 = hist[4 * lane], h1 = hist[4 * lane + 1], h2 = hist[4 * lane + 2], h3 = hist[4 * lane + 3]; const unsigned loc = h0 + h1 + h2 + h3;
                unsigned suf = loc;
#pragma unroll
                for (int o = 1; o < 64; o <<= 1) { const unsigned t = lane_getu(suf, lane + o); if (lane + o < 64) suf += t; }
                const unsigned above = suf - loc;
                if (above < kk && kk <= suf) { unsigned c = above; int d;
                    if (c + h3 >= kk) d = 3; else { c += h3; if (c + h2 >= kk) d = 2; else { c += h2; if (c + h1 >= kk) d = 1; else { c += h1; d = 0; } } }
                    ctl[0] = prefix | ((unsigned)(4 * lane + d) << shift); ctl[1] = kk - c; } }
            __syncthreads();
            prefix = ctl[0]; kk = ctl[1]; mask |= 255u << shift;
        }
        unsigned eqc = 0u;
#pragma unroll
        for (int j = 0; j < 8; ++j) eqc += (key[j] == prefix) ? 1u : 0u;
        unsigned eqr = block_excl_scan(eqc, ctl + 8, lane, wave);
        unsigned selm = 0u, selc = 0u;
#pragma unroll
        for (int j = 0; j < 8; ++j) { bool s = key[j] > prefix; if (key[j] == prefix) { s = eqr < kk; ++eqr; } selm |= s ? (1u << j) : 0u; selc += s ? 1u : 0u; }
        unsigned sl = block_excl_scan(selc, ctl + 8, lane, wave);
        if ((tid >> 7) == qu) { int so[8];
#pragma unroll
            for (int j = 0; j < 8; ++j) { const bool s = (selm >> j) & 1u; so[j] = s ? (int)sl : -1;
                if (s) { gate[e * EROWS + b * CAP + sl] = __uint_as_float(key[j]); const unsigned p = __hip_atomic_fetch_add(&ctl[2], 1u, __ATOMIC_RELAXED, __HIP_MEMORY_SCOPE_WORKGROUP); lst[p] = (unsigned)(8 * tid + j) | (sl << 16); ++sl; } }
            GAS int* sp = slotp + (size_t)be * SEQ + 8 * tid;
            typedef int v4i __attribute__((ext_vector_type(4))); *(GAS v4i*)sp = (v4i){so[0], so[1], so[2], so[3]}; *(GAS v4i*)(sp + 4) = (v4i){so[4], so[5], so[6], so[7]}; }
        __syncthreads();
        const int nsel = (int)ctl[2];
        for (int i0 = wave * 8; i0 < nsel; i0 += 64) {
            v4u r0[8]; unsigned en[8];
#pragma unroll
            for (int q = 0; q < 8; ++q) { const int i = (i0 + q < nsel) ? i0 + q : i0; en[q] = lst[i]; r0[q] = ((const GAS v4u*)(hn8 + ((size_t)b * SEQ + (en[q] & 0xffffu)) * DM))[lane]; }
#pragma unroll
            for (int q = 0; q < 8; ++q) if (i0 + q < nsel) ((GAS v4u*)(xg8 + ((size_t)e * EROWS + b * CAP + (en[q] >> 16)) * DM))[lane] = r0[q];
        }
        __syncthreads();
    }
}

__device__ __forceinline__ void phase_combine(Frame& F, int l) {
    const int gw = F.vcu * NWAVES + F.wave, NGW = F.G * NWAVES, lane = F.lane;
    const GAS float* modl = (const GAS float*)(F.ws + WS_MOD) + (size_t)l * 4 * 6144;
    const GAS int* slot = (const GAS int*)(F.ws + WS_SLOT); const GAS bf16* ye = (const GAS bf16*)(F.ws + WS_YE);
    LAS float* PV = (LAS float*)F.lds;
    for (int i = F.tid; i < 4 * 256; i += NTHR) { const int b = i >> 8, c4 = i & 255; const GAS float* mb = modl + (size_t)b * 6144;
        const f32x4 gf = ((const GAS f32x4*)(mb + 5120))[c4], pg = ((const GAS f32x4*)(INP(F, I_FPOST) + l * DM))[c4];
        LAS f32x4* pv = (LAS f32x4*)(PV + b * 3072) + ((c4 >> 2) + 64 * (c4 & 3)); pv[0] = gf * pg;
        if (l + 1 < DEPTH) { const GAS float* mn = modl + 4 * 6144 + (size_t)b * 6144; const f32x4 gg = ((const GAS f32x4*)(INP(F, I_MPRE) + (l + 1) * DM))[c4], s1 = ((const GAS f32x4*)(mn + 1024))[c4], s0 = ((const GAS f32x4*)mn)[c4];
            pv[256] = gg * (1.0f + s1); pv[512] = s0; } }
    __syncthreads();
    for (int m0 = gw; m0 < M; m0 += 2 * NGW) {
        int mm[2]; mm[0] = m0; mm[1] = (m0 + NGW < M) ? m0 + NGW : m0;
        int sl[2]; unsigned long long mask[2]; f32x4 y[2][4], x[2][4];
#pragma unroll
        for (int q = 0; q < 2; ++q) { const int b = mm[q] >> 12, t = mm[q] & (SEQ - 1); sl[q] = -1; if (lane < 16) sl[q] = slot[((size_t)b * NEXP + lane) * SEQ + t];
            roww_load_bf16((const GAS bf16*)(F.ws + WS_XR) + (size_t)mm[q] * DM, lane, x[q]);
#pragma unroll
            for (int j = 0; j < 4; ++j) y[q][j] = (f32x4){0.f, 0.f, 0.f, 0.f}; }
#pragma unroll
        for (int q = 0; q < 2; ++q) mask[q] = __ballot(sl[q] >= 0);
        while (mask[0] | mask[1]) {
            f32x4 r[2][4]; bool on[2];
#pragma unroll
            for (int q = 0; q < 2; ++q) { on[q] = mask[q] != 0ull; if (on[q]) { const int e = __builtin_ctzll(mask[q]); mask[q] &= mask[q] - 1; const int s = (int)lane_getu((unsigned)sl[q], e);
                    roww_load_bf16(ye + ((size_t)e * EROWS + (mm[q] >> 12) * CAP + s) * DM, lane, r[q]); } }
#pragma unroll
            for (int q = 0; q < 2; ++q) if (on[q]) {
#pragma unroll
                for (int j = 0; j < 4; ++j) y[q][j] += r[q][j]; }
        }
#pragma unroll
        for (int q = 0; q < 2; ++q) { const int m = mm[q], b = m >> 12; const LAS f32x4* A = (const LAS f32x4*)(PV + b * 3072);
            const float rstd = rsq(row_ss(y[q], lane) * (1.0f / DM) + EPS);
#pragma unroll
            for (int j = 0; j < 4; ++j) { const int c4 = lane + 64 * j;
                x[q][j] = x[q][j] + A[c4] * (y[q][j] * rstd); if (l + 1 == DEPTH) ((GAS f32x4*)(F.out + (size_t)m * DM))[4 * lane + j] = x[q][j]; }
            if (l + 1 < DEPTH) { roww_store_bf16((GAS bf16*)(F.ws + WS_XR) + (size_t)m * DM, lane, x[q]);
                const float rstd2 = rsq(row_ss(x[q], lane) * (1.0f / DM) + EPS); f32x4 hv[4];
#pragma unroll
                for (int j = 0; j < 4; ++j) { const int c4 = lane + 64 * j; hv[j] = x[q][j] * rstd2 * A[256 + c4] + A[512 + c4]; }
                roww_store_bf16((GAS bf16*)(F.ws + WS_HN) + (size_t)m * DM, lane, hv); } }
    }
    __syncthreads();
}

__device__ __forceinline__ void frame_fence(Frame& F) {
    asm volatile("" : "+s"(F.ws), "+s"(F.out), "+s"(F.ctl));
    { int g = gridDim.x; asm volatile("" : "+s"(g)); const int bx = blockIdx.x; F.G = g; F.vcu = (g % 8 == 0) ? (bx % 8) * (g / 8) + bx / 8 : bx; }
    int t = threadIdx.x; asm volatile("" : "+v"(t)); F.tid = t; F.lane = t & 63; F.wave = __builtin_amdgcn_readfirstlane(t >> 6);
}
__device__ __forceinline__ void frame_group(Frame& F, int G_eff) { const int bx = blockIdx.x; F.G = G_eff; F.vcu = (G_eff % 8 == 0) ? (bx % 8) * (G_eff / 8) + bx / 8 : bx; }
constexpr int NCOMP = 176, NCONV = 256 - NCOMP;
constexpr int F8W_BAR0 = F8W_HOST0 + F8W_HOSTED * 2048 + F8W_IDLE * 1024;
__device__ __forceinline__ int f8w_bar_count(int wi) { return F8W_BARQ0 + ((wi >= 896) ? F8W_BARQ + 3 : F8W_BARQ - 3); }
__device__ __forceinline__ int f8w_bar_item(int wi, int i) {
    if (i < F8W_BARQ0) return F8W_HOST0 - F8W_BARQ0 * F8W_BARW + wi + F8W_BARW * i;
    return (wi < 896) ? (F8W_BAR0 + wi + 896 * (i - F8W_BARQ0)) : (F8W_BAR0 + 896 * (F8W_BARQ - 3) + (wi - 896) + 896 * (i - F8W_BARQ0)); }
__device__ __forceinline__ void xcd_barrier_host(const XcdBarrier& b, Frame& F, unsigned epoch) {
    asm volatile("s_waitcnt vmcnt(0)" ::: "memory");
    __syncthreads();
    volatile LAS unsigned* st = b.st;
    if (F.wave == 0) {
      if (threadIdx.x == 0) {
        unsigned* bar = b.bar;
        __builtin_amdgcn_s_waitcnt(0);
        unsigned nloc = b.st[0], nx = b.st[1];
        if (nloc == 0u) { xcd_barrier_complete(bar, b.x, nloc, nx); b.st[0] = nloc; b.st[1] = nx; }
        const unsigned old = xb_add(&bar[XB_XSUB(b.x)], 1u);
        const unsigned gen = old / nloc;
        if (old + 1u == (gen + 1u) * nloc) {
            __builtin_amdgcn_fence(__ATOMIC_RELEASE, "agent");
            asm volatile("s_waitcnt vmcnt(0)" ::: "memory");
            const unsigned og = xb_add(&bar[XB_TOP], 1u);
            const unsigned tg = og / nx;
            if (og + 1u == (tg + 1u) * nx) xb_add(&bar[XB_TOPGEN], 1u);
            else XB_SPIN(xb_ld(&bar[XB_TOPGEN]) == tg, bar);
            __builtin_amdgcn_fence(__ATOMIC_ACQUIRE, "agent");
            xb_add(&bar[XB_XGEN(b.x)], 1u);
            asm volatile("s_waitcnt vmcnt(0)" ::: "memory");
        } else {
            XB_SPIN(xb_ld(&bar[XB_XGEN(b.x)]) == gen, bar);
            __builtin_amdgcn_fence(__ATOMIC_ACQUIRE, "agent");
            asm volatile("s_waitcnt vmcnt(0)" ::: "memory");
        }
        st[2] = epoch;
      }
    } else {
        const int wv = F.wave, wi = (int)blockIdx.x * 7 + wv - 1;
        for (;;) {
            if (st[2] == epoch) break;
            const int i = (int)st[8 + wv];
            if (i >= f8w_bar_count(wi)) { __builtin_amdgcn_s_sleep(2); continue; }
            f8w_convert_one(F, f8w_bar_item(wi, i));
            if (F.lane == 0) st[8 + wv] = (unsigned)(i + 1);
            asm volatile("s_waitcnt lgkmcnt(0)" ::: "memory");
        }
    }
    __syncthreads();
}
__device__ __forceinline__ void f8w_bar_flush(Frame& F, volatile LAS unsigned* st, int upto) {
    if (F.wave == 0) return;
    const int wv = F.wave, wi = (int)blockIdx.x * 7 + wv - 1; int i = (int)st[8 + wv];
    if (upto > F8W_BARQ0) upto = f8w_bar_count(wi);
    if (i >= upto) return;
    for (; i < upto; ++i) f8w_convert_one(F, f8w_bar_item(wi, i));
    if (F.lane == 0) st[8 + wv] = (unsigned)upto;
}
struct Args { const float* in[28]; float* out; unsigned char* ws; int ph_lo, ph_hi; };
constexpr int PH_PER_LAYER = 10, N_PHASES = 2 + DEPTH * PH_PER_LAYER;
__global__ void __launch_bounds__(NTHR, 2) fwd_kernel(Args args) {
    extern __shared__ __attribute__((aligned(16))) unsigned char lds[];
    Frame F;
    F.lds = (LAS unsigned char*)lds;
    F.tid = threadIdx.x; F.lane = F.tid & 63; F.wave = __builtin_amdgcn_readfirstlane(F.tid >> 6);
    F.G = gridDim.x; { const int bx = blockIdx.x; F.vcu = (F.G % 8 == 0) ? (bx % 8) * (F.G / 8) + bx / 8 : bx; }
    F.ws = (GAS unsigned char*)args.ws; F.out = (GAS float*)args.out; F.ctl = (GAS unsigned*)(args.ws + WS_CTL);
    for (int u = F.tid; u < (LDS_BYTES - LDSCTL_OFF) / 4; u += NTHR) ((LAS unsigned*)(F.lds + LDSCTL_OFF))[u] = 0u;
    __syncthreads();
    if (F.tid == 0) {
#pragma unroll
        for (int i = 0; i < 28; ++i) ((LAS unsigned long long*)(F.lds + LDSCTL_OFF))[i] = (unsigned long long)args.in[i]; }
    __syncthreads();
    XcdBarrier bar = xcd_barrier_post((unsigned*)F.ctl + CW_BAR, (volatile LAS unsigned*)(F.lds + MISC_OFF) + 8);
    const int lo = args.ph_lo, hi = args.ph_hi;
    const bool hostbar = (gridDim.x == 256) && lo <= 0 && hi >= N_PHASES;
#ifndef PHMASK
#define PHMASK 0xFFF
#endif
#define EN(j) (((PHMASK) >> (j)) & 1)
#ifndef REPMASK
#define REPMASK 0
#endif
#define REPS(j) for (int rep_ = 0; rep_ < ((((REPMASK) >> (j)) & 1) ? 2 : 1); (++rep_, __syncthreads()))
#define IN(k) (lo <= (k) && (k) < hi)
#ifndef BARREP
#define BARREP 1
#endif
#define SEAM(k) do { if (IN(k) && IN((k) + 1)) { for (int br_ = 0; br_ < BARREP; ++br_) { XcdBarrier b2 = bar; asm volatile("" : "+s"(b2.bar), "+s"(b2.x)); \
        if (hostbar && (k) >= 1 && (k) <= 2 + PH_PER_LAYER + 5) xcd_barrier_host(b2, F, (unsigned)(k) + 1u); else xcd_barrier(b2); } } } while (0)

    if (EN(0) && IN(0)) REPS(0) { frame_fence(F); prologue0(F); }
    SEAM(0);
    if (EN(1) && IN(1)) REPS(1) { frame_fence(F); prologue1(F); }
    SEAM(1);
    for (int l = 0; l < DEPTH; ++l) {
        const int pb = 2 + l * PH_PER_LAYER;
        const bool split = false, conv_role = false;
        const int cidx = (int)blockIdx.x - NCOMP, ctot = (F8_NTILES - cidx + NCONV - 1) / NCONV, cq1 = 38, cq2 = 21;
        if (EN(2) && IN(pb + 0)) REPS(2) {
            frame_fence(F);
            if (conv_role) f8_convert_range(F, cidx, NCONV, cq1);
            else {
            if (split) frame_group(F, NCOMP);
            pg8::Gemm g{(const pg8::bf16_t*)(F.ws + WS_HN), (const pg8::bf16_t*)(F.ws + WS_WIN) + (size_t)l * NPROJ * DM, M, NPROJ, DM};
            pg8::StaticOrder S; S.init(M, NPROJ, F.G, (int)blockIdx.x);
            pg8::EpiBf16<0> E{(pg8::bf16_t*)(F.ws + WS_PROJ), NPROJ, nullptr, 0, 0, 1.f};
            pg8::gemm_phase<pg8::EpiBf16<0>, pg8::StaticOrder, true, true>(F.lds, g, S, E);
            if (l == 0 && F.G == 256 && (int)blockIdx.x >= 128) f8w_convert_idle(F);
            if (l == 1 && hostbar && (int)blockIdx.x >= 128) f8w_bar_flush(F, bar.st, F8W_BARQ0 + F8W_BARQ);
            }
        }
        SEAM(pb + 0);
        if (EN(3) && IN(pb + 1)) REPS(3) { frame_fence(F);
            if (conv_role) f8_convert_range(F, cidx + NCONV * cq1, NCONV, cq2);
            else { if (split) frame_group(F, NCOMP); phase_prep(F, l); } }
        SEAM(pb + 1);
        if (EN(4) && IN(pb + 2)) {
            frame_fence(F);
            if (conv_role) f8_convert_range(F, cidx + NCONV * (cq1 + cq2), NCONV, ctot - cq1 - cq2);
            else {
            if (split) frame_group(F, NCOMP);
            for (int it = blockIdx.x; it < 256; it += F.G) gla_scan_item(F, it);
            REPS(12) for (int it = F.vcu; it < 256; it += F.G) hy_conv_item(F, l, it);
            __syncthreads();
            float gq_ = fabsf(INP(F, I_QNORM)[l * 64 + F.lane]), gk_ = fabsf(INP(F, I_KNORM)[l * 64 + F.lane]);
            gq_ = fmaxf(gq_, dpp_f<DPP_X1>(gq_)); gq_ = fmaxf(gq_, dpp_f<DPP_X2>(gq_)); gq_ = fmaxf(gq_, dpp_f<DPP_HMIR>(gq_)); gq_ = fmaxf(gq_, dpp_f<DPP_MIR>(gq_)); gq_ = swap16_max(gq_); gq_ = swap32_max(gq_);
            gk_ = fmaxf(gk_, dpp_f<DPP_X1>(gk_)); gk_ = fmaxf(gk_, dpp_f<DPP_X2>(gk_)); gk_ = fmaxf(gk_, dpp_f<DPP_HMIR>(gk_)); gk_ = fmaxf(gk_, dpp_f<DPP_MIR>(gk_)); gk_ = swap16_max(gk_); gk_ = swap32_max(gk_);
            const float mfix = __uint_as_float(__builtin_amdgcn_readfirstlane(__float_as_uint(1.02f * ATT_C2 * 64.0f * gq_ * gk_)));
            const bool nomax = mfix <= 60.0f;
            REPS(13) for (int i = 0; ; ++i) { const int U = split ? F.vcu + F.G * i : 2 * F.vcu + i; if (U >= 512 || (!split && i >= 2)) break;
                    const int grp = U >> 6, j = U & 63, b = grp >> 1, h = (grp & 1) * 4 + (j >> 4), qb = j & 15;
                    if (nomax) attn_body::attn_unit<8, true>(b, h, qb, (const attn_body::bf16*)(F.ws + WS_QP), (const attn_body::bf16*)(F.ws + WS_KV), (const attn_body::bf16*)(F.ws + WS_KV) + 128,
                                            (attn_body::bf16*)(F.ws + WS_CAT) + 256, (char*)lds, mfix);
                    else attn_body::attn_unit<8>(b, h, qb, (const attn_body::bf16*)(F.ws + WS_QP), (const attn_body::bf16*)(F.ws + WS_KV), (const attn_body::bf16*)(F.ws + WS_KV) + 128,
                                            (attn_body::bf16*)(F.ws + WS_CAT) + 256, (char*)lds); }
            }
        }
        SEAM(pb + 2);
        if (EN(5) && IN(pb + 3)) REPS(5) { frame_fence(F); phase_mix_out(F, l); }
        SEAM(pb + 3);
        if (EN(6) && IN(pb + 4)) REPS(6) {
            frame_fence(F);
            pg8::Gemm g{(const pg8::bf16_t*)(F.ws + WS_CAT), (const pg8::bf16_t*)(F.ws + WS_WOUT) + (size_t)l * DM * DM, M, DM, DM};
            pg8::StaticOrder S; S.init(M, DM, F.G, (int)blockIdx.x);
            pg8::EpiBf16Row E{(pg8::bf16_t*)(F.ws + WS_Y), DM, nullptr, 1.0f};
            pg8::gemm_phase<pg8::EpiBf16Row, pg8::StaticOrder, true, true>(F.lds, g, S, E);
        }
        SEAM(pb + 4);
        if (EN(7) && IN(pb + 5)) { if (l == 0) { REPS(7) { frame_fence(F); phase_post_mix(F, l); } } else { frame_fence(F); phase_post_mix(F, l); } }
        SEAM(pb + 5);
        if (EN(8) && IN(pb + 6)) REPS(8) { frame_fence(F); phase_topk(F); }
        if (hostbar) { frame_fence(F); f8w_bar_flush(F, bar.st, l == 0 ? F8W_BARQ0 : F8W_BARQ0 + F8W_BARQ); }
        SEAM(pb + 6);
        if (EN(9) && IN(pb + 7)) REPS(9) {
            frame_fence(F);
            pg8::Gemm g{(const pg8::bf16_t*)(F.ws + WS_XG), (const pg8::bf16_t*)(F.ws + WS_WGU + (size_t)l * NEXP * 5632 * DM), NEXP * EROWS, NEXP * 5632, DM / 2};
            pg8::MoeOrder S; S.init(22, F.G, F.vcu);
            pg8::EpiSwiGLU8 E{(unsigned char*)(F.ws + WS_H), FF / 128, 1.0f / W8_SCALE};
            pg8::gemm_phase<pg8::EpiSwiGLU8, pg8::MoeOrder, true, true, true, true>(F.lds, g, S, E);
        }
        SEAM(pb + 7);
        if (EN(10) && IN(pb + 8)) REPS(10) {
            frame_fence(F);
            pg8::Gemm g{(const pg8::bf16_t*)(F.ws + WS_H), (const pg8::bf16_t*)(F.ws + WS_WD + (size_t)l * NEXP * DM * FF), NEXP * EROWS, NEXP * DM, FF / 2};
            pg8::MoeOrder S; S.init(4, F.G, F.vcu);
            pg8::EpiBf16Row E{(pg8::bf16_t*)(F.ws + WS_YE), DM, (const float*)(F.ws + WS_GATE), 1.0f / W8_SCALE};
            pg8::gemm_phase<pg8::EpiBf16Row, pg8::MoeOrder, true, true, true, true, true>(F.lds, g, S, E);
        }
        SEAM(pb + 8);
        if (EN(11) && IN(pb + 9)) { frame_fence(F); phase_combine(F, l); }
        SEAM(pb + 9);
    }
#undef IN
#undef SEAM
}

#ifndef MK_N_LAUNCHES
#define MK_N_LAUNCHES 1
#endif
extern "C" void kernel_launch(void* const* d_in, const int* in_sizes, int n_in, void* d_out, int out_size, void* d_ws, size_t ws_size, hipStream_t stream) {
    static int grid = 0;
    if (grid == 0) {
        if (n_in != 28 || out_size != M * DM || ws_size < WS_END) { fprintf(stderr, "kernel_launch: unexpected shapes (n_in %d, out %d, ws %zu < %zu); nothing launched\n", n_in, out_size, ws_size, (size_t)WS_END); grid = -1; return; }
        int dev = 0, cus = 0, per_cu = 0;
        if (hipGetDevice(&dev) != hipSuccess || hipDeviceGetAttribute(&cus, hipDeviceAttributeMultiprocessorCount, dev) != hipSuccess) { grid = -1; return; }
        if (hipFuncSetAttribute((const void*)fwd_kernel, hipFuncAttributeMaxDynamicSharedMemorySize, LDS_BYTES) != hipSuccess) { fprintf(stderr, "kernel_launch: hipFuncSetAttribute failed\n"); grid = -1; return; }
        if (hipOccupancyMaxActiveBlocksPerMultiprocessor(&per_cu, (const void*)fwd_kernel, NTHR, LDS_BYTES) != hipSuccess || per_cu < 1) fprintf(stderr, "kernel_launch: occupancy query says %d\n", per_cu);
        (void)hipGetLastError();
        grid = cus;
    }
    if (grid < 0) return;
    (void)hipMemsetAsync((char*)d_ws + WS_CTL, 0, CTL_ZERO_BYTES, stream);
    Args a{};
    for (int i = 0; i < 28; ++i) a.in[i] = (const float*)d_in[i];
    a.out = (float*)d_out; a.ws = (unsigned char*)d_ws;
#if MK_N_LAUNCHES == 1
    a.ph_lo = 0; a.ph_hi = N_PHASES;
    hipLaunchKernelGGL(fwd_kernel, dim3(grid), dim3(NTHR), LDS_BYTES, stream, a);
#else
    for (int p = 0; p < N_PHASES; ++p) { a.ph_lo = p; a.ph_hi = p + 1; hipLaunchKernelGGL(fwd_kernel, dim3(grid), dim3(NTHR), LDS_BYTES, stream, a); }
#endif
}
```

```cpp
#include <hip/hip_runtime.h>
#include <hip/hip_bf16.h>
#include <cstdio>
#include <cstdint>
#include <cmath>
namespace pg8 {
#define PG8_LAS __attribute__((address_space(3)))
typedef unsigned short bf16_t;
typedef short bf16x8 __attribute__((ext_vector_type(8)));
typedef float f32x4 __attribute__((ext_vector_type(4)));
typedef unsigned u32x4 __attribute__((ext_vector_type(4)));
constexpr int BM = 256, BK = 64, HALF = 128, HTB = HALF * BK * 2  , STAGE_BYTES = 8 * HTB, NXCD = 8, WGM = 8;

__host__ __device__ __forceinline__ int lds_byte(int r, int c) { const int st = (r >> 4) * 2 + (c >> 5), rr = r & 15, cc = c & 31, ob = rr * 64 + cc * 2; return st * 1024 + (ob ^ (((ob >> 9) & 1) << 5)); }
__host__ __device__ __forceinline__ void stage_rc(int b, int& R, int& C) { const int st = b / 1024, sb = b % 1024, swz = sb ^ (((sb >> 9) & 1) << 5); R = (st >> 1) * 16 + swz / 64; C = (st & 1) * 32 + (swz % 64) / 2; }
__host__ __device__ __forceinline__ int perm32(int rho) { const int n = rho >> 4, i = rho & 15; return 8 * (i >> 2) + 4 * n + (i & 3); }

struct Unit { int pm, pn, pc; };
struct Gemm { const bf16_t* A; const bf16_t* Bt; int M, N, K; };

struct StaticOrder {
    int nM, nN, nwg, G, c;
    __host__ __device__ void init(int M, int N, int G_, int c_) { nM = M / BM; nN = N / BM; nwg = nM * nN; G = G_; c = c_; }
    __host__ __device__ bool next(int i, Unit& u) const {
        const long L = (long)i * G + c; if (L >= nwg) return false;
        int wgid = (int)L; { const int q = nwg / NXCD, r = nwg % NXCD, xcd = wgid % NXCD, off = wgid / NXCD; wgid = (xcd < r ? xcd * (q + 1) : r * (q + 1) + (xcd - r) * q) + off; }
        const int nig = WGM * nN, gid = wgid / nig, fm = gid * WGM, gsz = (nM - fm) < WGM ? (nM - fm) : WGM;
        u.pm = fm + ((wgid % nig) % gsz); u.pn = (wgid % nig) / gsz; u.pc = u.pn; return true;
    }
    __device__ __forceinline__ void a_ready(const Unit&) const {}
    __device__ __forceinline__ void done(const Unit&) const {}
};

__device__ __forceinline__ unsigned cvt_pk_bf16(float lo, float hi) { unsigned r; asm volatile("v_cvt_pk_bf16_f32 %0, %1, %2" : "=v"(r) : "v"(lo), "v"(hi)); return r; }
typedef float f32x2 __attribute__((ext_vector_type(2)));
__device__ __forceinline__ f32x2 gelu_pk(f32x2 v) {
    const f32x2 av = __builtin_elementwise_abs(v), d = av * 0.2316418882f + 1.0f;
    f32x2 t; t.x = __builtin_amdgcn_rcpf(d.x); t.y = __builtin_amdgcn_rcpf(d.y);
    f32x2 q = t * 0.5307027145f + (-0.7265760135f); q = q * t + 0.7107068705f; q = q * t + (-0.142248368f); q = q * t + 0.127414796f; q = q * t;
    const f32x2 s = (v * v) * (-0.72134752044f);
    f32x2 e; e.x = __builtin_amdgcn_exp2f(s.x); e.y = __builtin_amdgcn_exp2f(s.y);
    const f32x2 m = v * (q * e), r = v - m;
    f32x2 o; o.x = v.x < 0.f ? m.x : r.x; o.y = v.y < 0.f ? m.y : r.y; return o;
}

template <int ACT  > struct EpiBf16 {
    static constexpr bool PERM = true, AFTER_DRAIN = false; static_assert(ACT == 0 || ACT == 1, "EpiBf16: ACT is 0 (none) or 1 (gelu_pk)");
    bf16_t* O; int ldc; const float* bias; int split_cols; size_t split_stride; float scale0;
    __device__ __forceinline__ void operator()(const f32x4 (&acc)[2][2][4][2], const Unit& u, int wr, int wc, int fr, int fq) const {
        const int row0 = u.pm * BM + wr * 64 + fr; int colt = u.pc * BM; bf16_t* base = O;
        float sc = 1.f; if (split_cols) { const int t = colt / split_cols; base += (size_t)t * split_stride; colt -= t * split_cols; if (t == 0) sc = scale0; }
        const int col0 = colt + wc * 32 + 8 * fq, bcol0 = u.pc * BM + wc * 32 + 8 * fq;
        f32x4 bv[2][2];
#pragma unroll
        for (int bj = 0; bj < 2; ++bj)
#pragma unroll
            for (int n = 0; n < 2; ++n) bv[bj][n] = bias ? *(const f32x4*)(bias + bcol0 + bj * HALF + 4 * n) : (f32x4){0.f, 0.f, 0.f, 0.f};
#pragma unroll
        for (int ai = 0; ai < 2; ++ai)
#pragma unroll
            for (int m = 0; m < 4; ++m) { bf16_t* rowp = base + (size_t)(row0 + ai * HALF + m * 16) * ldc + col0;
#pragma unroll
                for (int bj = 0; bj < 2; ++bj) { f32x4 v0 = acc[ai][bj][m][0] + bv[bj][0], v1 = acc[ai][bj][m][1] + bv[bj][1];
                    if (ACT == 1) { f32x2 a = gelu_pk((f32x2){v0[0], v0[1]}), b = gelu_pk((f32x2){v0[2], v0[3]}), c = gelu_pk((f32x2){v1[0], v1[1]}), d = gelu_pk((f32x2){v1[2], v1[3]});
                        v0 = (f32x4){a.x, a.y, b.x, b.y}; v1 = (f32x4){c.x, c.y, d.x, d.y}; }
                    v0 = v0 * sc; v1 = v1 * sc; u32x4 w; w.x = cvt_pk_bf16(v0[0], v0[1]); w.y = cvt_pk_bf16(v0[2], v0[3]); w.z = cvt_pk_bf16(v1[0], v1[1]); w.w = cvt_pk_bf16(v1[2], v1[3]);
                    *(u32x4*)(rowp + bj * HALF) = w; } }
    }
};

struct EpiF32 {
    static constexpr bool PERM = false, AFTER_DRAIN = false;
    float* O; int ldc; const float* rowscale; float mul;
    __device__ __forceinline__ void operator()(const f32x4 (&acc)[2][2][4][2], const Unit& u, int wr, int wc, int fr, int fq) const {
        const int row0 = u.pm * BM + wr * 64 + fr, col0 = u.pc * BM + wc * 32 + 4 * fq;
#pragma unroll
        for (int ai = 0; ai < 2; ++ai)
#pragma unroll
            for (int m = 0; m < 4; ++m) { const int row = row0 + ai * HALF + m * 16; const float s = (rowscale ? rowscale[row] : 1.f) * mul; float* rowp = O + (size_t)row * ldc + col0;
#pragma unroll
                for (int bj = 0; bj < 2; ++bj)
#pragma unroll
                    for (int n = 0; n < 2; ++n) *(f32x4*)(rowp + bj * HALF + n * 16) = acc[ai][bj][m][n] * s; }
    }
};
struct EpiBf16Row {
    static constexpr bool PERM = true, AFTER_DRAIN = false;
    bf16_t* O; int ldc; const float* rowscale; float mul;
    __device__ __forceinline__ void operator()(const f32x4 (&acc)[2][2][4][2], const Unit& u, int wr, int wc, int fr, int fq) const {
        const int row0 = u.pm * BM + wr * 64 + fr, col0 = u.pc * BM + wc * 32 + 8 * fq;
#pragma unroll
        for (int ai = 0; ai < 2; ++ai)
#pragma unroll
            for (int m = 0; m < 4; ++m) { const int row = row0 + ai * HALF + m * 16; const float s = (rowscale ? rowscale[row] : 1.f) * mul; bf16_t* rowp = O + (size_t)row * ldc + col0;
#pragma unroll
                for (int bj = 0; bj < 2; ++bj) { const f32x4 v0 = acc[ai][bj][m][0] * s, v1 = acc[ai][bj][m][1] * s;
                    u32x4 w; w.x = cvt_pk_bf16(v0[0], v0[1]); w.y = cvt_pk_bf16(v0[2], v0[3]); w.z = cvt_pk_bf16(v1[0], v1[1]); w.w = cvt_pk_bf16(v1[2], v1[3]);
                    *(u32x4*)(rowp + bj * HALF) = w; } }
    }
};
__device__ __forceinline__ float silu_mul(float g, float u) { return g * u * __builtin_amdgcn_rcpf(1.0f + __builtin_amdgcn_exp2f(-1.44269504089f * g)); }
struct EpiSwiGLU {
    static constexpr bool PERM = true, AFTER_DRAIN = false;
    bf16_t* O; int ldc;
    __device__ __forceinline__ void operator()(const f32x4 (&acc)[2][2][4][2], const Unit& u, int wr, int wc, int fr, int fq) const {
        const int row0 = u.pm * BM + wr * 64 + fr, col0 = u.pc * HALF + wc * 32 + 8 * fq;
#pragma unroll
        for (int ai = 0; ai < 2; ++ai)
#pragma unroll
            for (int m = 0; m < 4; ++m) { bf16_t* rowp = O + (size_t)(row0 + ai * HALF + m * 16) * ldc + col0;
                const f32x4 g0 = acc[ai][0][m][0], g1 = acc[ai][0][m][1], u0 = acc[ai][1][m][0], u1 = acc[ai][1][m][1];
                u32x4 w; w.x = cvt_pk_bf16(silu_mul(g0[0], u0[0]), silu_mul(g0[1], u0[1])); w.y = cvt_pk_bf16(silu_mul(g0[2], u0[2]), silu_mul(g0[3], u0[3]));
                w.z = cvt_pk_bf16(silu_mul(g1[0], u1[0]), silu_mul(g1[1], u1[1])); w.w = cvt_pk_bf16(silu_mul(g1[2], u1[2]), silu_mul(g1[3], u1[3]));
                *(u32x4*)rowp = w; }
    }
};
__device__ __forceinline__ unsigned pk4_fp8(float a, float b, float c, float d) {
    a = __builtin_amdgcn_fmed3f(a, -448.f, 448.f); b = __builtin_amdgcn_fmed3f(b, -448.f, 448.f); c = __builtin_amdgcn_fmed3f(c, -448.f, 448.f); d = __builtin_amdgcn_fmed3f(d, -448.f, 448.f);
    unsigned r = 0u; r = __builtin_amdgcn_cvt_pk_fp8_f32(a, b, r, false); r = __builtin_amdgcn_cvt_pk_fp8_f32(c, d, r, true); return r; }
struct EpiSwiGLU8 {
    static constexpr bool PERM = true, AFTER_DRAIN = false;
    unsigned char* O; int ntk; float isc;
    __device__ __forceinline__ f32x2 silu_mul2(f32x2 G, f32x2 U, float ka, float ks) const {
        const f32x2 a = G * ka; f32x2 ex; ex.x = __builtin_amdgcn_exp2f(a.x); ex.y = __builtin_amdgcn_exp2f(a.y);
        const f32x2 d = ex * ks + ks; f32x2 r; r.x = __builtin_amdgcn_rcpf(d.x); r.y = __builtin_amdgcn_rcpf(d.y);
        return (G * U) * r; }
    __device__ __forceinline__ void operator()(const f32x4 (&acc)[2][2][4][2], const Unit& u, int wr, int wc, int fr, int fq) const {
        typedef unsigned u32x2 __attribute__((ext_vector_type(2)));
        const int c = wc * 32 + 8 * fq;
        unsigned char* blk = O + ((size_t)u.pm * ntk + u.pc) * 32768 + (c >> 6) * 16384 + (c & 63) + (size_t)(wr * 64 + fr) * 64;
        const float ka = -1.44269504089f * isc, ks = 1.0f / (isc * isc);
#pragma unroll
        for (int ai = 0; ai < 2; ++ai)
#pragma unroll
            for (int m = 0; m < 4; ++m) { unsigned char* rowp = blk + (ai * HALF + m * 16) * 64;
                const f32x4 g0 = acc[ai][0][m][0], g1 = acc[ai][0][m][1], u0 = acc[ai][1][m][0], u1 = acc[ai][1][m][1];
                const f32x2 h0 = silu_mul2((f32x2){g0[0], g0[1]}, (f32x2){u0[0], u0[1]}, ka, ks), h1 = silu_mul2((f32x2){g0[2], g0[3]}, (f32x2){u0[2], u0[3]}, ka, ks);
                const f32x2 h2 = silu_mul2((f32x2){g1[0], g1[1]}, (f32x2){u1[0], u1[1]}, ka, ks), h3 = silu_mul2((f32x2){g1[2], g1[3]}, (f32x2){u1[2], u1[3]}, ka, ks);
                u32x2 w; w.x = pk4_fp8(h0.x, h0.y, h1.x, h1.y); w.y = pk4_fp8(h2.x, h2.y, h3.x, h3.y);
                *(u32x2*)rowp = w; __builtin_amdgcn_sched_barrier(0); }
    }
};
struct EpiF8Row {
    static constexpr bool PERM = true, AFTER_DRAIN = false;
    unsigned char* O; int ldc; const float* rowscale; float mul;
    __device__ __forceinline__ void operator()(const f32x4 (&acc)[2][2][4][2], const Unit& u, int wr, int wc, int fr, int fq) const {
        typedef unsigned u32x2 __attribute__((ext_vector_type(2)));
        const int row0 = u.pm * BM + wr * 64 + fr, col0 = u.pc * BM + wc * 32 + 8 * fq;
#pragma unroll
        for (int ai = 0; ai < 2; ++ai)
#pragma unroll
            for (int m = 0; m < 4; ++m) { const int row = row0 + ai * HALF + m * 16; const float s = (rowscale ? rowscale[row] : 1.f) * mul; unsigned char* rowp = O + (size_t)row * ldc + col0;
#pragma unroll
                for (int bj = 0; bj < 2; ++bj) { const f32x4 v0 = acc[ai][bj][m][0] * s, v1 = acc[ai][bj][m][1] * s;
                    u32x2 w; w.x = pk4_fp8(v0[0], v0[1], v0[2], v0[3]); w.y = pk4_fp8(v1[0], v1[1], v1[2], v1[3]);
                    *(u32x2*)(rowp + bj * HALF) = w; } }
    }
};
struct MoeOrder {
    int npn, per_e, total, G, c;
    __host__ __device__ void init(int npn_, int G_, int c_) { npn = npn_; per_e = 8 * npn_; total = 16 * per_e; G = G_; c = c_; }
    __host__ __device__ bool next(int i, Unit& u) const {
        const long L = (long)i * G + c; if (L >= total) return false;
        const int e = (int)L / per_e, r = (int)L % per_e; u.pm = 8 * e + (r & 7); u.pc = r >> 3; u.pn = npn * e + u.pc; return true;
    }
    __device__ __forceinline__ void a_ready(const Unit&) const {}
    __device__ __forceinline__ void done(const Unit&) const {}
};

typedef int pg8_v4i __attribute__((ext_vector_type(4)));
typedef int pg8_v8i __attribute__((ext_vector_type(8)));
__device__ __forceinline__ pg8_v8i cat8(bf16x8 lo, bf16x8 hi) { return __builtin_shufflevector(__builtin_bit_cast(pg8_v4i, lo), __builtin_bit_cast(pg8_v4i, hi), 0, 1, 2, 3, 4, 5, 6, 7); }
__device__ __forceinline__ void mfma_f8_inplace(f32x4& acc, pg8_v8i a, pg8_v8i b) { asm volatile("v_mfma_f32_16x16x128_f8f6f4 %0, %1, %2, %0" : "+v"(acc) : "v"(a), "v"(b)); }
template <class Epi, class Sched, bool ALIGN_EPI = false, bool SP2 = false, bool F8 = false, bool BTILED = false, bool ATILED = false>
__device__ __forceinline__ void gemm_phase(PG8_LAS unsigned char* lds, const Gemm g, const Sched& S, const Epi& E) {
    int tid_ = threadIdx.x; asm volatile("" : "+v"(tid_));
    const int tid = tid_, wid = __builtin_amdgcn_readfirstlane(tid >> 6), lane = tid & 63, wr = wid >> 2, wc = wid & 3, fr = lane & 15, fq = lane >> 4;
    const int K = g.K, nt = K / BK;
    unsigned voffA[2], voffB[2];
#pragma unroll
    for (int i = 0; i < 2; ++i) { int R, C; stage_rc(tid * 16 + i * 8192, R, C); const int Rb = Epi::PERM ? ((R & ~31) + perm32(R & 31)) : R;
        voffA[i] = ATILED ? (unsigned)((C >> 5) * 16384 + R * 64 + (C & 31) * 2) : (unsigned)(R * K + C) * 2u; voffB[i] = BTILED ? (unsigned)((C >> 5) * 16384 + Rb * 64 + (C & 31) * 2) : (unsigned)(Rb * K + C) * 2u; }
    const size_t kstep = (size_t)(BK * 2);
    const size_t hstep = (size_t)HALF * K * 2;
    const size_t tstep = 2 * hstep;
    const size_t kstepB = BTILED ? (size_t)32768 : kstep, hstepB = BTILED ? (size_t)8192 : hstep;
    const size_t kstepA = ATILED ? (size_t)32768 : kstep, hstepA = ATILED ? (size_t)8192 : hstep;
    const unsigned ldsw = (unsigned)wid * 1024u;
    const int aoff = lds_byte(wr * 64 + fr, fq * 8), boff = lds_byte(wc * 32 + fr, fq * 8);
#define PG8_SA(b, h) (((b) * 2 + (h)) * HTB)
#define PG8_SB(b, h) ((4 + (b) * 2 + (h)) * HTB)
#define PG8_STAGE(bufoff, gbase, voff) do { _Pragma("unroll") for (int _i = 0; _i < 2; ++_i) \
        __builtin_amdgcn_global_load_lds((const unsigned*)((const char*)(gbase) + (voff)[_i]), (PG8_LAS unsigned*)(lds + (bufoff) + ldsw + _i * 8192), 16, 0, 0); } while (0)
#define PG8_LDA(dst, b, h) do { _Pragma("unroll") for (int m = 0; m < 4; ++m) _Pragma("unroll") for (int k = 0; k < 2; ++k) dst[m][k] = *(const PG8_LAS bf16x8*)(lds + PG8_SA(b, h) + aoff + m * 2048 + k * 1024); } while (0)
#define PG8_LDB(dst, b, h) do { _Pragma("unroll") for (int n = 0; n < 2; ++n) _Pragma("unroll") for (int k = 0; k < 2; ++k) dst[n][k] = *(const PG8_LAS bf16x8*)(lds + PG8_SB(b, h) + boff + n * 2048 + k * 1024); } while (0)
#define PG8_MMA(ai, bj, At, Bt) do { __builtin_amdgcn_s_setprio(1); _Pragma("unroll") for (int m = 0; m < 4; ++m) _Pragma("unroll") for (int n = 0; n < 2; ++n) { \
        if constexpr (F8) mfma_f8_inplace(acc[ai][bj][m][n], cat8(Bt[n][0], Bt[n][1]), cat8(At[m][0], At[m][1])); \
        else { _Pragma("unroll") for (int k = 0; k < 2; ++k) acc[ai][bj][m][n] = __builtin_amdgcn_mfma_f32_16x16x32_bf16(Bt[n][k], At[m][k], acc[ai][bj][m][n], 0, 0, 0); } } \
        __builtin_amdgcn_s_setprio(0); } while (0)
#define PG8_WAIT_V(n) asm volatile("s_waitcnt vmcnt(" #n ")" ::: "memory")
#define PG8_WAIT_L(n) asm volatile("s_waitcnt lgkmcnt(" #n ")" ::: "memory")
#define PG8_BAR __builtin_amdgcn_s_barrier()
#define PG8_SCHED __builtin_amdgcn_sched_barrier(0)
    Unit cur, nxt; int ui = 0;
    if (!S.next(0, cur)) return;
    f32x4 acc[2][2][4][2];
#pragma unroll
    for (int a = 0; a < 2; ++a)
#pragma unroll
        for (int b = 0; b < 2; ++b)
#pragma unroll
            for (int m = 0; m < 4; ++m)
#pragma unroll
                for (int n = 0; n < 2; ++n) acc[a][b][m][n] = (f32x4){0.f, 0.f, 0.f, 0.f};
    bf16x8 At[4][2], B0[2][2], B1[2][2];
    const char* cA = (const char*)g.A + (size_t)cur.pm * tstep; const char* cB = (const char*)g.Bt + (size_t)cur.pn * tstep;
    S.a_ready(cur);
    if constexpr (SP2) {
        PG8_STAGE(PG8_SB(0, 0), cB, voffB); PG8_STAGE(PG8_SB(0, 1), cB + hstepB, voffB); PG8_STAGE(PG8_SA(0, 0), cA, voffA); PG8_STAGE(PG8_SA(0, 1), cA + hstepA, voffA);
        if (wr == 1) PG8_BAR;
        PG8_WAIT_V(2); PG8_BAR;
        PG8_STAGE(PG8_SB(1, 0), cB + kstepB, voffB); PG8_STAGE(PG8_SA(1, 0), cA + kstepA, voffA); PG8_STAGE(PG8_SB(1, 1), cB + hstepB + kstepB, voffB);
        PG8_WAIT_V(6); PG8_BAR;
    } else {
        PG8_STAGE(PG8_SB(0, 0), cB, voffB); PG8_STAGE(PG8_SA(0, 0), cA, voffA); PG8_STAGE(PG8_SB(0, 1), cB + hstepB, voffB); PG8_STAGE(PG8_SA(0, 1), cA + hstepA, voffA);
        if (wr == 1) PG8_BAR;
        PG8_WAIT_V(4); PG8_BAR;
        PG8_STAGE(PG8_SB(1, 0), cB + kstepB, voffB); PG8_STAGE(PG8_SA(1, 0), cA + kstepA, voffA); PG8_STAGE(PG8_SB(1, 1), cB + hstepB + kstepB, voffB);
        PG8_WAIT_V(6); PG8_BAR;
    }
    for (;;) {
        const bool has_next = S.next(ui + 1, nxt);
        const char* nA = has_next ? (const char*)g.A + (size_t)nxt.pm * tstep : cA; const char* nB = has_next ? (const char*)g.Bt + (size_t)nxt.pn * tstep : cB;
#pragma unroll 1
        for (int t = 0; t < nt; t += 2) {
            const bool last = (t == nt - 2);
            const char* a1 = cA + (size_t)(t + 1) * kstepA;
            const char* a2 = last ? nA : cA + (size_t)(t + 2) * kstepA; const char* b2 = last ? nB : cB + (size_t)(t + 2) * kstepB;
            const char* a3 = a2 + kstepA; const char* b3 = b2 + kstepB;
            if (last && has_next) S.a_ready(nxt);
            if constexpr (SP2) {
            PG8_LDB(B0, 0, 0); PG8_LDB(B1, 0, 1); PG8_SCHED; PG8_LDA(At, 0, 0); PG8_STAGE(PG8_SA(1, 1), a1 + hstepA, voffA);
            PG8_WAIT_V(8); PG8_WAIT_L(0); PG8_BAR; PG8_MMA(0, 0, At, B0); PG8_MMA(0, 1, At, B1); PG8_BAR; PG8_SCHED;
            PG8_LDA(At, 0, 1); PG8_STAGE(PG8_SB(0, 0), b2, voffB); PG8_STAGE(PG8_SB(0, 1), b2 + hstepB, voffB); PG8_STAGE(PG8_SA(0, 0), a2, voffA);
            PG8_WAIT_V(8); PG8_WAIT_L(0); PG8_BAR; PG8_MMA(1, 0, At, B0); PG8_MMA(1, 1, At, B1); PG8_BAR; PG8_SCHED;
            PG8_LDB(B0, 1, 0); PG8_LDB(B1, 1, 1); PG8_SCHED; PG8_LDA(At, 1, 0); PG8_STAGE(PG8_SA(0, 1), a2 + hstepA, voffA);
            PG8_WAIT_V(8); PG8_WAIT_L(0); PG8_BAR; PG8_MMA(0, 0, At, B0); PG8_MMA(0, 1, At, B1); PG8_BAR; PG8_SCHED;
            PG8_LDA(At, 1, 1); PG8_STAGE(PG8_SB(1, 0), b3, voffB); PG8_STAGE(PG8_SB(1, 1), b3 + hstepB, voffB); PG8_STAGE(PG8_SA(1, 0), a3, voffA);
            PG8_WAIT_V(8); PG8_WAIT_L(0); PG8_BAR; PG8_MMA(1, 0, At, B0); PG8_MMA(1, 1, At, B1); PG8_BAR; PG8_SCHED;
            } else {
            PG8_LDB(B0, 0, 0); PG8_SCHED; PG8_LDA(At, 0, 0); PG8_STAGE(PG8_SA(1, 1), a1 + hstepA, voffA);
            PG8_WAIT_L(8); PG8_BAR; PG8_WAIT_L(0); PG8_MMA(0, 0, At, B0); PG8_BAR; PG8_SCHED;
            PG8_LDB(B1, 0, 1); PG8_STAGE(PG8_SB(0, 0), b2, voffB);
            PG8_BAR; PG8_WAIT_L(0); PG8_MMA(0, 1, At, B1); PG8_BAR;
            PG8_LDA(At, 0, 1); PG8_STAGE(PG8_SA(0, 0), a2, voffA);
            PG8_BAR; PG8_WAIT_L(0); PG8_MMA(1, 0, At, B0); PG8_BAR; PG8_SCHED;
            PG8_STAGE(PG8_SB(0, 1), b2 + hstepB, voffB);
            PG8_WAIT_V(6); PG8_BAR; PG8_MMA(1, 1, At, B1); PG8_BAR;
            PG8_LDB(B0, 1, 0); PG8_SCHED; PG8_LDA(At, 1, 0); PG8_STAGE(PG8_SA(0, 1), a2 + hstepA, voffA);
            PG8_WAIT_L(8); PG8_BAR; PG8_WAIT_L(0); PG8_MMA(0, 0, At, B0); PG8_BAR; PG8_SCHED;
            PG8_LDB(B1, 1, 1); PG8_STAGE(PG8_SB(1, 0), b3, voffB);
            PG8_BAR; PG8_WAIT_L(0); PG8_MMA(0, 1, At, B1); PG8_BAR;
            PG8_LDA(At, 1, 1); PG8_STAGE(PG8_SA(1, 0), a3, voffA);
            PG8_BAR; PG8_WAIT_L(0); PG8_MMA(1, 0, At, B0); PG8_BAR; PG8_SCHED;
            PG8_STAGE(PG8_SB(1, 1), b3 + hstepB, voffB);
            PG8_WAIT_V(6); PG8_BAR; PG8_MMA(1, 1, At, B1); PG8_BAR;
            }
        }
        if constexpr (ALIGN_EPI) { if (wr == 0) PG8_BAR; }
        if constexpr (F8) asm volatile("s_nop 15\n\ts_nop 15" ::: "memory");
        if constexpr (!Epi::AFTER_DRAIN) { E(acc, cur, wr, wc, fr, fq); S.done(cur); }
        if (!has_next) break;
#pragma unroll
        for (int a = 0; a < 2; ++a)
#pragma unroll
            for (int b = 0; b < 2; ++b)
#pragma unroll
                for (int m = 0; m < 4; ++m)
#pragma unroll
                    for (int n = 0; n < 2; ++n) acc[a][b][m][n] = (f32x4){0.f, 0.f, 0.f, 0.f};
        cur = nxt; cA = nA; cB = nB; ++ui;
        if constexpr (ALIGN_EPI) { if (wr == 1) PG8_BAR; }
    }
    PG8_WAIT_V(0);
    if constexpr (!ALIGN_EPI) { if (wr == 0) PG8_BAR; }
    PG8_BAR;
    if constexpr (Epi::AFTER_DRAIN) { E.fused(acc, cur, wr, wc, fr, fq, lds, wid, lane); S.done(cur); }
#undef PG8_SA
#undef PG8_SB
#undef PG8_STAGE
#undef PG8_LDA
#undef PG8_LDB
#undef PG8_MMA
#undef PG8_WAIT_V
#undef PG8_WAIT_L
#undef PG8_BAR
#undef PG8_SCHED
}
}
namespace attn_body {
using bf16=__hip_bfloat16;
using bf16x8=__attribute__((ext_vector_type(8)))short;
using s16x4=__attribute__((ext_vector_type(4)))short;
using f32x16=__attribute__((ext_vector_type(16)))float;
using u32x4=__attribute__((ext_vector_type(4)))unsigned;
constexpr int BATCH=4,NHEAD=8,SEQ=4096,D=64,QP=512,KVP=256,OP=1024;
constexpr int NW=8,QBLK=32,QB=QBLK*NW,KVBLK=64,NQB=SEQ/QB;
constexpr int ATTN_UNIT_ROWS=QB;
__device__ __forceinline__ int crow(int r,int hi){return (r&3)+8*(r>>2)+4*hi;}
#define SBAR() __builtin_amdgcn_sched_barrier(0)
__device__ __forceinline__ void cmask(f32x16&p0,f32x16&p1,int jb,int qrel,int hi){
  const float NEG=-INFINITY; int kb=64*jb+4*hi;
  #pragma unroll
  for(int r=0;r<16;++r){int kv=kb+(r&3)+8*(r>>2); if(kv>qrel)p0[r]=NEG; if(kv+32>qrel)p1[r]=NEG;}
}

constexpr int NSLOT=3, SLOTB=8192;
constexpr int LDS_K=0, LDS_V=NSLOT*SLOTB, LDS_WS=2*NSLOT*SLOTB, LDS_OST=LDS_WS+NW*64*4, LDS_BYTES=LDS_OST+NW*4096;
constexpr float C2=0.125f*1.4426950408889634f;
__device__ __forceinline__ void glds16(const void*gsrc,unsigned lds_dst){unsigned keep;
  asm volatile("s_mov_b32 %0, m0\n\ts_mov_b32 m0, %2\n\ts_nop 0\n\tglobal_load_lds_dwordx4 %1, off\n\ts_mov_b32 m0, %0":"=&s"(keep):"v"(gsrc),"s"(lds_dst):"memory");}
__device__ __forceinline__ float max3f(float a,float b,float c){float r;asm("v_max3_f32 %0, %1, %2, %3":"=v"(r):"v"(a),"v"(b),"v"(c));return r;}
__device__ __forceinline__ float max2f(float a,float b){float r;asm("v_max_f32_e32 %0, %1, %2":"=v"(r):"v"(a),"v"(b));return r;}
__device__ __forceinline__ float fadd_s(float a,float b){float r;asm("v_add_f32_e32 %0, %1, %2":"=v"(r):"v"(a),"v"(b));return r;}
__device__ __forceinline__ float fsub_s(float a,float b){float r;asm("v_sub_f32_e32 %0, %1, %2":"=v"(r):"v"(a),"v"(b));return r;}
typedef float f32x2_t __attribute__((ext_vector_type(2))); typedef __bf16 bf16x2_t __attribute__((ext_vector_type(2)));
__device__ __forceinline__ unsigned cvtpk_s(float lo,float hi){f32x2_t v={lo,hi};bf16x2_t b=__builtin_convertvector(v,bf16x2_t);return __builtin_bit_cast(unsigned,b);}
#define WAIT_BAR(N) asm volatile("s_waitcnt vmcnt(" #N ") lgkmcnt(0)\n\ts_barrier":::"memory")

__device__ __forceinline__ void qkt(f32x16&p0,f32x16&p1,const char*Kslot,const bf16x8*qr,const f32x16&negm,int r32,int hi){
  const char*kb=Kslot+hi*1024+r32*16;
  #pragma unroll
  for(int d0=0;d0<4;++d0){
    const bf16x8 b0=*reinterpret_cast<const bf16x8*>(kb+d0*2048);
    const bf16x8 b1=*reinterpret_cast<const bf16x8*>(kb+d0*2048+512);
    if(d0==0){p0=__builtin_amdgcn_mfma_f32_32x32x16_bf16(b0,qr[0],negm,0,0,0);p1=__builtin_amdgcn_mfma_f32_32x32x16_bf16(b1,qr[0],negm,0,0,0);}
    else{p0=__builtin_amdgcn_mfma_f32_32x32x16_bf16(b0,qr[d0],p0,0,0,0);p1=__builtin_amdgcn_mfma_f32_32x32x16_bf16(b1,qr[d0],p1,0,0,0);}}
}
typedef __attribute__((address_space(3))) const char* lds_cptr;
typedef short v4i16_t __attribute__((ext_vector_type(4)));
__device__ __forceinline__ void kload8(bf16x8*kf,lds_cptr kp){
  kf[0]=*(const __attribute__((address_space(3))) bf16x8*)(kp);      kf[1]=*(const __attribute__((address_space(3))) bf16x8*)(kp+512);
  kf[2]=*(const __attribute__((address_space(3))) bf16x8*)(kp+2048); kf[3]=*(const __attribute__((address_space(3))) bf16x8*)(kp+2560);
  kf[4]=*(const __attribute__((address_space(3))) bf16x8*)(kp+4096); kf[5]=*(const __attribute__((address_space(3))) bf16x8*)(kp+4608);
  kf[6]=*(const __attribute__((address_space(3))) bf16x8*)(kp+6144); kf[7]=*(const __attribute__((address_space(3))) bf16x8*)(kp+6656);
}
__device__ __forceinline__ void kload2(bf16x8*kf,lds_cptr kp,int j){ kf[2*j]=*(const __attribute__((address_space(3))) bf16x8*)(kp+j*2048); kf[2*j+1]=*(const __attribute__((address_space(3))) bf16x8*)(kp+j*2048+512); }
__device__ __forceinline__ s16x4 vtr(lds_cptr p){ return __builtin_bit_cast(s16x4,__builtin_amdgcn_ds_read_tr16_b64_v4i16((__attribute__((address_space(3))) v4i16_t*)p)); }
__device__ __forceinline__ float rowmax(const f32x16&p0,const f32x16&p1){
  float a=max3f(p0[0],p0[1],p1[0]),b=max3f(p0[2],p0[3],p1[1]);a=max3f(a,p1[2],p1[3]);
  #pragma unroll
  for(int r=4;r<16;r+=4){a=max3f(a,p0[r],p0[r+1]);b=max3f(b,p0[r+2],p0[r+3]);a=max3f(a,p1[r],p1[r+1]);b=max3f(b,p1[r+2],p1[r+3]);}
  const float m=max2f(a,b);
  auto rr=__builtin_amdgcn_permlane32_swap(__float_as_uint(m),__float_as_uint(m),false,false);
  return max2f(__uint_as_float(rr[0]),__uint_as_float(rr[1]));
}
__device__ __forceinline__ void pv(f32x16*o,int vb,bf16x8 pa0,bf16x8 pa1,bf16x8 pa2,bf16x8 pa3){
  #pragma unroll
  for(int d0=0;d0<2;++d0){s16x4 lo[4],hi[4];
    #pragma unroll
    for(int ks=0;ks<4;++ks){
      asm volatile("ds_read_b64_tr_b16 %0,%1 offset:%c2":"=&v"(lo[ks]):"v"(vb),"i"(d0*4096+ks*1024):"memory");
      asm volatile("ds_read_b64_tr_b16 %0,%1 offset:%c2":"=&v"(hi[ks]):"v"(vb),"i"(d0*4096+ks*1024+512):"memory");}
    asm volatile("s_waitcnt lgkmcnt(0)":::"memory");SBAR();
    #define PK(k) (bf16x8){lo[k][0],lo[k][1],lo[k][2],lo[k][3],hi[k][0],hi[k][1],hi[k][2],hi[k][3]}
    o[d0]=__builtin_amdgcn_mfma_f32_32x32x16_bf16(pa0,PK(0),o[d0],0,0,0);
    o[d0]=__builtin_amdgcn_mfma_f32_32x32x16_bf16(pa1,PK(1),o[d0],0,0,0);
    o[d0]=__builtin_amdgcn_mfma_f32_32x32x16_bf16(pa2,PK(2),o[d0],0,0,0);
    o[d0]=__builtin_amdgcn_mfma_f32_32x32x16_bf16(pa3,PK(3),o[d0],0,0,0);
    #undef PK
  }
}

#ifndef ATTN_STORE16
#define ATTN_STORE16(p,v) (*(u32x4*)(p)=(v))
#endif
  template<int THRL,bool NOMAX=false> __device__ __forceinline__ void attn_unit(int b,int h,int qb,const bf16*Q,const bf16*__restrict__ K,const bf16*__restrict__ V,bf16*O,char*shm,float mfix=0.f){
  int tid_=threadIdx.x; asm volatile("":"+v"(tid_)); const int tid=tid_,lane=tid&63,r32=lane&31,hi=lane>>5; const int wid=__builtin_amdgcn_readfirstlane(tid>>6);
  const long rowbase=(long)b*SEQ; const int q0=qb*QB;
  const bf16*Qw=Q+(rowbase+q0+wid*QBLK)*QP+h*D;
  const bf16*Kh=K+rowbase*KVP+(h>>2)*D,*Vh=V+rowbase*KVP+(h>>2)*D;
  const unsigned lds0=(unsigned)(uintptr_t)shm;
  float*wsf=(float*)(shm+LDS_WS)+wid*64;
  const bf16*ksrc=Kh+(long)lane*KVP+wid*8;
  const bf16*vsrc=Vh+(long)(16*(wid&3)+(lane>>2))*KVP+(wid>>2)*32+(lane&3)*8;
  const unsigned kdst=lds0+LDS_K+wid*1024, vdst=lds0+LDS_V+wid*1024;
  #define DMA_K(t,slot) glds16(ksrc+(long)(t)*KVBLK*KVP,(unsigned)__builtin_amdgcn_readfirstlane(kdst+(slot)))
  #define DMA_V(t,slot) glds16(vsrc+(long)(t)*KVBLK*KVP,(unsigned)__builtin_amdgcn_readfirstlane(vdst+(slot)))
  const int vb0=(int)(lds0+LDS_V)+((lane>>4)&1)*32+(lane&3)*8+(4*hi+((lane&15)>>2))*64;
  const char*Kbase=shm+LDS_K; bf16x8 kf[8];
  const lds_cptr shm3=(lds_cptr)shm; const lds_cptr kp0=shm3+LDS_K+hi*1024+r32*16; const lds_cptr vp0=shm3+LDS_V+((lane>>4)&1)*32+(lane&3)*8+(4*hi+((lane&15)>>2))*64;
  const int NT=SEQ/KVBLK;
  DMA_K(0,0);DMA_V(0,0);DMA_K(1,SLOTB);
  bf16x8 qr[4];
  #pragma unroll
  for(int d0=0;d0<4;++d0)qr[d0]=*reinterpret_cast<const bf16x8*>(&Qw[(long)r32*QP+d0*16+hi*8]);
  float mhat=0.f,l_reg=0.f;f32x16 o[2];o[0]=f32x16{};o[1]=f32x16{};f32x16 negm=f32x16{};asm volatile("":"+v"(negm));
  const int qrel=wid*QBLK+r32;
  #define CMASK(P0,P1,t) do{}while(0)
  bool resc=false;
  #define START(P0,P1) do{ float rm; if constexpr(NOMAX) rm=mfix; else rm=rowmax(P0,P1); resc=false; \
    { const float dl=rm; mhat=fadd_s(mhat,dl); \
      _Pragma("unroll") for(int r=0;r<16;++r){P0[r]=fsub_s(P0[r],dl);P1[r]=fsub_s(P1[r],dl);} \
      _Pragma("unroll") for(int r=0;r<16;++r)negm[r]=-mhat; asm volatile("":"+v"(negm)); } \
    _Pragma("unroll") for(int r=0;r<16;++r)P0[r]=__builtin_amdgcn_exp2f(P0[r]); }while(0)
  #define RESC() do{ if(resc){ asm volatile("s_waitcnt lgkmcnt(0)":::"memory"); \
      _Pragma("unroll") for(int d_=0;d_<2;++d_) _Pragma("unroll") for(int r=0;r<16;++r)o[d_][r]*=wsf[crow(r,hi)]; } }while(0)
  f32x16 pA0,pA1,pB0,pB1;
  int sl_prev=0,sl_cur=0,sl_next=SLOTB;
  #define ROT() do{sl_prev=sl_cur;sl_cur=sl_next;sl_next=(sl_next==(NSLOT-1)*SLOTB)?0:sl_next+SLOTB;}while(0)
  DMA_K(2,2*SLOTB);
  WAIT_BAR(3);
  qkt(pA0,pA1,Kbase,qr,negm,r32,hi);asm volatile("s_nop 15\n\ts_nop 7":"+v"(pA0),"+v"(pA1));CMASK(pA0,pA1,0);
  START(pA0,pA1);
  _Pragma("unroll") for(int r=0;r<16;++r)pA1[r]=__builtin_amdgcn_exp2f(pA1[r]);
  WAIT_BAR(0);
  DMA_K(3,0);DMA_V(1,SLOTB);
  ROT();
  kload8(kf,kp0+sl_cur);
  WAIT_BAR(2);
  s16x4 vlo[8],vhi[8]; u32x4 pw0,pw1,pw2,pw3;
  #define PKW(P,B) cvtpk_s(P[B],P[B+1])
  #define PAF(k) __builtin_bit_cast(bf16x8,pw##k)
  #define VFR(i) (bf16x8){vlo[i][0],vlo[i][1],vlo[i][2],vlo[i][3],vhi[i][0],vhi[i][1],vhi[i][2],vhi[i][3]}
  #define PIN(x) asm volatile("":"+v"(x))
  #define MX3(a,b,c) __builtin_fmaxf(__builtin_fmaxf((a),(b)),(c))
  #define GAPA(MF,A0,A1,A2,A3,W0,W1,PW) do{ MF; sacc+=A0; sacc+=A1; sacc+=A2; sacc+=A3; PIN(sacc); W0; W1; PIN(PW); SBAR(); }while(0)
  #define EX(v) __builtin_amdgcn_exp2f(v)
  #define GAPB(MF,X,B) do{ MF; X[B]=EX(X[B]); X[B+1]=EX(X[B+1]); X[B+2]=EX(X[B+2]); X[B+3]=EX(X[B+3]); PIN(X); SBAR(); }while(0)
  #define VRD(i) do{ vlo[i]=vtr(vp_+(((i)>>2)*4096+((i)&3)*1024)); vhi[i]=vtr(vp_+(((i)>>2)*4096+((i)&3)*1024+512)); }while(0)
  #define KRD(G,j) do{ if(G){ kload2(kf,kp0+sl_next,j); SBAR(); } }while(0)
  #define STEP(C0,C1,P0,P1,t,GK,GV,GL) do{ SBAR(); \
    const lds_cptr vp_=vp0+sl_prev; \
    VRD(0); SBAR(); float sacc=(P0[0]+P0[1]); \
    GAPA(C0=__builtin_amdgcn_mfma_f32_32x32x16_bf16(kf[0],qr[0],negm,0,0,0), P0[2],P0[3],P0[4],P0[5],     pw0[0]=PKW(P0,0), pw0[1]=PKW(P0,2), pw0); \
    VRD(4); SBAR(); GAPA(C1=__builtin_amdgcn_mfma_f32_32x32x16_bf16(kf[1],qr[0],negm,0,0,0), P0[6],P0[7],P0[8],P0[9],     pw0[2]=PKW(P0,4), pw0[3]=PKW(P0,6), pw0); \
    VRD(1); SBAR(); GAPA(C0=__builtin_amdgcn_mfma_f32_32x32x16_bf16(kf[2],qr[1],C0,0,0,0),   P0[10],P0[11],P0[12],P0[13], pw1[0]=PKW(P0,8), pw1[1]=PKW(P0,10), pw1); \
    VRD(5); SBAR(); GAPA(C1=__builtin_amdgcn_mfma_f32_32x32x16_bf16(kf[3],qr[1],C1,0,0,0),   P0[14],P0[15],P1[0],P1[1],   pw1[2]=PKW(P0,12),pw1[3]=PKW(P0,14), pw1); \
    VRD(2); SBAR(); GAPA(C0=__builtin_amdgcn_mfma_f32_32x32x16_bf16(kf[4],qr[2],C0,0,0,0),   P1[2],P1[3],P1[4],P1[5],     pw2[0]=PKW(P1,0), pw2[1]=PKW(P1,2), pw2); \
    VRD(6); SBAR(); GAPA(C1=__builtin_amdgcn_mfma_f32_32x32x16_bf16(kf[5],qr[2],C1,0,0,0),   P1[6],P1[7],P1[8],P1[9],     pw2[2]=PKW(P1,4), pw2[3]=PKW(P1,6), pw2); \
    VRD(3); SBAR(); GAPA(C0=__builtin_amdgcn_mfma_f32_32x32x16_bf16(kf[6],qr[3],C0,0,0,0),   P1[10],P1[11],P1[12],P1[13], pw3[0]=PKW(P1,8), pw3[1]=PKW(P1,10), pw3); \
    VRD(7); SBAR(); GAPA(C1=__builtin_amdgcn_mfma_f32_32x32x16_bf16(kf[7],qr[3],C1,0,0,0),   P1[14],P1[15],0.f,0.f,       pw3[2]=PKW(P1,12),pw3[3]=PKW(P1,14), pw3); \
    l_reg+=sacc; \
    if(GK){DMA_K((t)+3,sl_cur);} if(GV){DMA_V((t)+1,sl_next);} \
    CMASK(C0,C1,t); \
    if constexpr(!NOMAX){ float a=MX3(C0[0],C0[1],C1[0]),b=MX3(C0[2],C0[3],C1[1]); a=MX3(a,C1[2],C1[3]); \
      _Pragma("unroll") for(int r=4;r<16;r+=4){a=MX3(a,C0[r],C0[r+1]);b=MX3(b,C0[r+2],C0[r+3]);a=MX3(a,C1[r],C1[r+1]);b=MX3(b,C1[r+2],C1[r+3]);} \
      float rm=__builtin_fmaxf(a,b); { auto rr=__builtin_amdgcn_permlane32_swap(__float_as_uint(rm),__float_as_uint(rm),false,false); rm=__builtin_fmaxf(__uint_as_float(rr[0]),__uint_as_float(rr[1])); } \
      resc=false; \
      if(__builtin_expect(__any(rm>(float)THRL),0)){ const float dl=__builtin_fmaxf(rm,0.f); mhat+=dl; \
        _Pragma("unroll") for(int r=0;r<16;++r){C0[r]-=dl;C1[r]-=dl;} \
        _Pragma("unroll") for(int r=0;r<16;++r)negm[r]=-mhat; asm volatile("":"+v"(negm)); \
        const float f=__builtin_amdgcn_exp2f(-dl); l_reg*=f; if(hi==0)wsf[r32]=f; resc=true; } } \
    SBAR(); \
    GAPB(o[0]=__builtin_amdgcn_mfma_f32_32x32x16_bf16(PAF(0),VFR(0),o[0],0,0,0), C0,0); \
    GAPB(o[1]=__builtin_amdgcn_mfma_f32_32x32x16_bf16(PAF(0),VFR(4),o[1],0,0,0), C0,4); \
    KRD(GL,0); GAPB(o[0]=__builtin_amdgcn_mfma_f32_32x32x16_bf16(PAF(1),VFR(1),o[0],0,0,0), C0,8); \
    KRD(GL,1); GAPB(o[1]=__builtin_amdgcn_mfma_f32_32x32x16_bf16(PAF(1),VFR(5),o[1],0,0,0), C0,12); \
    KRD(GL,2); GAPB(o[0]=__builtin_amdgcn_mfma_f32_32x32x16_bf16(PAF(2),VFR(2),o[0],0,0,0), C1,0); \
    KRD(GL,3); GAPB(o[1]=__builtin_amdgcn_mfma_f32_32x32x16_bf16(PAF(2),VFR(6),o[1],0,0,0), C1,4); \
    GAPB(o[0]=__builtin_amdgcn_mfma_f32_32x32x16_bf16(PAF(3),VFR(3),o[0],0,0,0), C1,8); \
    GAPB(o[1]=__builtin_amdgcn_mfma_f32_32x32x16_bf16(PAF(3),VFR(7),o[1],0,0,0), C1,12); \
    }while(0)
  int t=1;
  #undef CMASK
  #define CMASK(P0,P1,t) do{}while(0)
  for(;t+5<NT;t+=2){
    STEP(pB0,pB1,pA0,pA1,t,true,true,true);     WAIT_BAR(2); RESC(); ROT();
    STEP(pA0,pA1,pB0,pB1,t+1,true,true,true);   WAIT_BAR(2); RESC(); ROT();
  }
  #undef CMASK
  #define CMASK(P0,P1,t) do{}while(0)
  #define ENDW(tt) do{ if((tt)+3<NT){WAIT_BAR(2);} else if((tt)+2<NT){WAIT_BAR(1);} else {WAIT_BAR(0);} }while(0)
  for(;t+1<NT;t+=2){
    STEP(pB0,pB1,pA0,pA1,t,(t+3<NT),(t+1<NT),(t+1<NT));       ENDW(t);   RESC(); ROT();
    STEP(pA0,pA1,pB0,pB1,t+1,(t+4<NT),(t+2<NT),(t+2<NT));     ENDW(t+1); RESC(); ROT();
  }
  STEP(pB0,pB1,pA0,pA1,NT-1,false,false,false); RESC();
  { float sacc=pB0[0]+pB0[1]; _Pragma("unroll") for(int r=2;r<16;++r)sacc+=pB0[r]; _Pragma("unroll") for(int r=0;r<16;++r)sacc+=pB1[r]; l_reg+=sacc;
    pw0=(u32x4){PKW(pB0,0),PKW(pB0,2),PKW(pB0,4),PKW(pB0,6)};pw1=(u32x4){PKW(pB0,8),PKW(pB0,10),PKW(pB0,12),PKW(pB0,14)};pw2=(u32x4){PKW(pB1,0),PKW(pB1,2),PKW(pB1,4),PKW(pB1,6)};pw3=(u32x4){PKW(pB1,8),PKW(pB1,10),PKW(pB1,12),PKW(pB1,14)};
    SBAR(); pv(o,vb0+sl_cur,PAF(0),PAF(1),PAF(2),PAF(3)); }
  #undef PKW
  #undef PAF
  #undef VFR
  #undef PIN
  #undef MX3
  #undef GAPA
  #undef GAPB
  #undef EX
  #undef VRD
  #undef KRD
  #undef STEP
  #undef ENDW
  {auto rr=__builtin_amdgcn_permlane32_swap(__float_as_uint(l_reg),__float_as_uint(l_reg),false,false);l_reg=__uint_as_float(rr[0])+__uint_as_float(rr[1]);}
  if(hi==0)wsf[32+r32]=l_reg;asm volatile("s_waitcnt lgkmcnt(0)":::"memory");
  float rli[16];
  #pragma unroll
  for(int r=0;r<16;++r)rli[r]=__builtin_amdgcn_rcpf(wsf[32+crow(r,hi)]);
  bf16*Ow=O+(rowbase+q0+wid*QBLK)*OP+h*D;
  { bf16*stg=(bf16*)(shm+LDS_OST)+wid*2048;
    #pragma unroll
    for(int r=0;r<16;++r){const int orow=crow(r,hi);
      #pragma unroll
      for(int d0=0;d0<2;++d0)stg[orow*64+d0*32+r32]=__float2bfloat16(o[d0][r]*rli[r]);}
    asm volatile("s_waitcnt lgkmcnt(0)":::"memory");
    #pragma unroll
    for(int i=0;i<4;++i){const int row=i*8+(lane>>3),ch=lane&7; const u32x4 v=*(const u32x4*)(stg+row*64+ch*8); ATTN_STORE16(Ow+(long)row*OP+ch*8,v);} }
  asm volatile("s_waitcnt lgkmcnt(0)\n\ts_barrier":::"memory");
  #undef DMA_K
  #undef DMA_V
  #undef CMASK
  #undef START
  #undef RESC
  #undef ROT
}
#undef SBAR
#undef WAIT_BAR
}
constexpr int NWAVES = 8, NTHR = 512;
constexpr int BATCH = 4, SEQ = 4096, DM = 1024, M = BATCH * SEQ, DEPTH = 2;
constexpr int NPROJ = 2560, NIN = 2336;
constexpr int PC_GQ = 0, PC_GK = 128, PC_GV = 256, PC_GG = 512, PC_LAF = 768, PC_LAB = 896, PC_AQ = 1024, PC_AK = 1536, PC_AV = 1664, PC_HX0 = 1792, PC_HX1 = 2048, PC_HV = 2304;
constexpr int NEXP = 16, CAP = 512, FF = 2816, EROWS = BATCH * CAP;
constexpr int NCHUNK = SEQ / 32;
constexpr float EPS = 1e-6f;
constexpr float YE8_SCALE = 16.0f;
constexpr float W8_SCALE = 64.0f;
constexpr float ATT_C2 = 0.125f * 1.4426950408889634f;

constexpr size_t MiB = 1u << 20;
constexpr size_t WS_CTL = 0, CTL_ZERO_BYTES = 32768;
constexpr size_t WS_MOD = 1 * MiB, WS_AFF = 2 * MiB, WS_SLOT = 3 * MiB, WS_GATE = 4 * MiB, WS_ALAST = 5 * MiB, WS_HF = 6 * MiB;
constexpr size_t WS_WIN = 22 * MiB, WS_WOUT = 32 * MiB, WS_HN = 36 * MiB, WS_PROJ = 68 * MiB, WS_QP = 148 * MiB, WS_KV = 164 * MiB, WS_CAT = 172 * MiB;
constexpr size_t WS_GKV = 204 * MiB, WS_ZT = 236 * MiB, WS_YC = 244 * MiB, WS_Y = 260 * MiB, WS_XG = 324 * MiB, WS_H = 388 * MiB, WS_YE = 564 * MiB;
constexpr size_t WS_WGU = 692 * MiB, WS_WD = 1044 * MiB, WS_END = 1220 * MiB;
constexpr size_t WS_XR = 628 * MiB;
constexpr int CW_BAR = 4096;

constexpr int RING_BYTES = 131072, LDSCTL_OFF = RING_BYTES, MISC_OFF = LDSCTL_OFF + 320, LDS_BYTES = 147456;

#define GAS __attribute__((address_space(1)))
#define LAS __attribute__((address_space(3)))
typedef unsigned short bf16;
typedef unsigned v4u __attribute__((ext_vector_type(4)));
typedef unsigned v2u __attribute__((ext_vector_type(2)));
typedef float f32x4 __attribute__((ext_vector_type(4)));
#define LDS_WAIT() asm volatile("s_waitcnt lgkmcnt(0)" ::: "memory")
#define VM_WAIT() asm volatile("s_waitcnt vmcnt(0)" ::: "memory")
typedef float m_f32x2 __attribute__((ext_vector_type(2))); typedef __bf16 m_bf16x2 __attribute__((ext_vector_type(2)));
__device__ __forceinline__ unsigned pk2(float lo, float hi) { const m_f32x2 v = {lo, hi}; return __builtin_bit_cast(unsigned, __builtin_convertvector(v, m_bf16x2)); }
__device__ __forceinline__ unsigned f2bf(float f) { return pk2(f, f); }
__device__ __forceinline__ float bf2f(bf16 u) { return __uint_as_float((unsigned)u << 16); }
__device__ __forceinline__ float lane_get(float v, int src) { return __uint_as_float((unsigned)__builtin_amdgcn_ds_bpermute(src << 2, (int)__float_as_uint(v))); }
__device__ __forceinline__ unsigned lane_getu(unsigned v, int src) { return (unsigned)__builtin_amdgcn_ds_bpermute(src << 2, (int)v); }
template <int CTRL> __device__ __forceinline__ float dpp_f(float v) { return __uint_as_float((unsigned)__builtin_amdgcn_update_dpp(0, (int)__float_as_uint(v), CTRL, 0xF, 0xF, true)); }
constexpr int DPP_X1 = 0xB1, DPP_X2 = 0x4E, DPP_HMIR = 0x141, DPP_MIR = 0x140, DPP_ROR8 = 0x128;
__device__ __forceinline__ float swap16_sum(float a, float b) { const auto r = __builtin_amdgcn_permlane16_swap(__float_as_uint(a), __float_as_uint(b), false, false); return __uint_as_float(r[0]) + __uint_as_float(r[1]); }
__device__ __forceinline__ float swap32_sum(float a, float b) { const auto r = __builtin_amdgcn_permlane32_swap(__float_as_uint(a), __float_as_uint(b), false, false); return __uint_as_float(r[0]) + __uint_as_float(r[1]); }
__device__ __forceinline__ float swap16_max(float a) { const auto r = __builtin_amdgcn_permlane16_swap(__float_as_uint(a), __float_as_uint(a), false, false); return fmaxf(__uint_as_float(r[0]), __uint_as_float(r[1])); }
__device__ __forceinline__ float swap32_max(float a) { const auto r = __builtin_amdgcn_permlane32_swap(__float_as_uint(a), __float_as_uint(a), false, false); return fmaxf(__uint_as_float(r[0]), __uint_as_float(r[1])); }
__device__ __forceinline__ float row16_sum(float v) { v += dpp_f<DPP_X1>(v); v += dpp_f<DPP_X2>(v); v += dpp_f<DPP_HMIR>(v); v += dpp_f<DPP_MIR>(v); return v; }
__device__ __forceinline__ float half_sum(float v) { v = row16_sum(v); return swap16_sum(v, v); }
__device__ __forceinline__ float wave_sum(float v, int) { v = half_sum(v); return swap32_sum(v, v); }
__device__ __forceinline__ float siluf(float x) { return x / (1.0f + __expf(-x)); }
__device__ __forceinline__ float logsigf(float x) { return fminf(x, 0.f) - __logf(1.0f + __expf(-fabsf(x))); }
__device__ __forceinline__ float rsq(float x) { return __builtin_amdgcn_rsqf(x); }
#define XB_TMO      128
#define XB_XCNT(j)  (256  + 64 * (j))
#define XB_XSUB(j)  (1280 + 64 * (j))
#define XB_XGEN(j)  (2304 + 64 * (j))
#define XB_TOP      3328
#define XB_TOPGEN   3392
#define XCD_BAR_WORDS 3456
#define XB_SPIN_CAP (1u << 18)

__device__ __forceinline__ unsigned xb_ld(unsigned* p)              { return __hip_atomic_load(p, __ATOMIC_RELAXED, __HIP_MEMORY_SCOPE_AGENT); }
__device__ __forceinline__ unsigned xb_add(unsigned* p, unsigned v) { return __hip_atomic_fetch_add(p, v, __ATOMIC_RELAXED, __HIP_MEMORY_SCOPE_AGENT); }
__device__ __forceinline__ unsigned xb_xcc_id() { return (unsigned)__builtin_amdgcn_s_getreg((3 << 11) | 20) & 0xFu; }
#define XB_SPIN(cond, bar) do { unsigned _sp = 0; while (cond) { __builtin_amdgcn_s_sleep(1); \
    if ((++_sp & 255u) == 0u) { if (xb_ld(&(bar)[XB_TMO])) break; if (_sp > XB_SPIN_CAP) { atomicAdd(&(bar)[XB_TMO], 1u); break; } } } } while (0)

struct XcdBarrier {
    unsigned* bar; unsigned x;
    volatile LAS unsigned* st;
};

__device__ __forceinline__ XcdBarrier xcd_barrier_post(unsigned* bar, volatile LAS unsigned* st) {
    XcdBarrier b; b.bar = bar; b.x = xb_xcc_id(); b.st = st;
    if (threadIdx.x == 0) (void)xb_add(&bar[XB_XCNT(b.x)], 1u);
    return b;
}
__device__ __forceinline__ void xcd_barrier_complete(unsigned* bar, unsigned x, unsigned& nloc, unsigned& nx) {
    const unsigned G = gridDim.x * gridDim.y * gridDim.z;
    unsigned sum, cnt, mine, sp = 0u;
    for (;;) {
        sum = 0u; cnt = 0u; mine = 0u;
#pragma unroll
        for (unsigned j = 0; j < 16; ++j) { const unsigned c = xb_ld(&bar[XB_XCNT(j)]); sum += c; cnt += (c > 0u) ? 1u : 0u; mine = (j == x) ? c : mine; }
        if (sum == G) break;
        __builtin_amdgcn_s_sleep(1);
        if ((++sp & 255u) == 0u) { if (xb_ld(&bar[XB_TMO])) break; if (sp > XB_SPIN_CAP) { atomicAdd(&bar[XB_TMO], 1u); break; } }
    }
    nloc = mine > 0u ? mine : 1u; nx = cnt > 0u ? cnt : 1u;
}

__device__ __forceinline__ void xcd_barrier(const XcdBarrier& b) {
    asm volatile("s_waitcnt vmcnt(0)" ::: "memory");
    __syncthreads();
    if (threadIdx.x == 0) {
        unsigned* bar = b.bar;
        __builtin_amdgcn_s_waitcnt(0);
        unsigned nloc = b.st[0], nx = b.st[1];
        if (nloc == 0u) { xcd_barrier_complete(bar, b.x, nloc, nx); b.st[0] = nloc; b.st[1] = nx; }
        const unsigned old = xb_add(&bar[XB_XSUB(b.x)], 1u);
        const unsigned gen = old / nloc;
        if (old + 1u == (gen + 1u) * nloc) {
            __builtin_amdgcn_fence(__ATOMIC_RELEASE, "agent");
            asm volatile("s_waitcnt vmcnt(0)" ::: "memory");
            const unsigned og = xb_add(&bar[XB_TOP], 1u);
            const unsigned tg = og / nx;
            if (og + 1u == (tg + 1u) * nx) xb_add(&bar[XB_TOPGEN], 1u);
            else XB_SPIN(xb_ld(&bar[XB_TOPGEN]) == tg, bar);
            __builtin_amdgcn_fence(__ATOMIC_ACQUIRE, "agent");
            xb_add(&bar[XB_XGEN(b.x)], 1u);
            asm volatile("s_waitcnt vmcnt(0)" ::: "memory");
        } else {
            XB_SPIN(xb_ld(&bar[XB_XGEN(b.x)]) == gen, bar);
            __builtin_amdgcn_fence(__ATOMIC_ACQUIRE, "agent");
            asm volatile("s_waitcnt vmcnt(0)" ::: "memory");
        }
    }
    __syncthreads();
}

struct Frame {
    LAS unsigned char* lds;
    GAS unsigned* ctl;
    int tid, lane, wave, vcu, G;
    GAS float* out; GAS unsigned char* ws;
};
__device__ __forceinline__ const GAS float* INP(const Frame& F, int i) {
    const LAS unsigned* p = (const LAS unsigned*)(F.lds + LDSCTL_OFF) + 2 * i;
    const unsigned lo = __builtin_amdgcn_readfirstlane(p[0]), hi = __builtin_amdgcn_readfirstlane(p[1]);
    return (const GAS float*)(((unsigned long long)hi << 32) | lo);
}
enum { I_X = 0, I_C, I_ADAW, I_ADAB, I_MPRE, I_MPOST, I_WIN, I_GWDEC, I_GBDEC, I_GNORM, I_QNORM, I_KNORM, I_HCW, I_HCB, I_HW1, I_HB1, I_HW2, I_HB2, I_HW3, I_HFREQ, I_HSKIP,
       I_WOUT, I_FPRE, I_FPOST, I_ROUTER, I_EG, I_EU, I_ED };

__device__ __forceinline__ void transpose_item(const GAS float* src, size_t src_ld, GAS bf16* dst, size_t dst_ld, int lane) {
    const GAS float* s = src + lane; float v[32];
#pragma unroll
    for (int i = 0; i < 32; ++i) v[i] = __builtin_nontemporal_load(s + (size_t)i * src_ld);
    GAS v4u* d = (GAS v4u*)(dst + (size_t)lane * dst_ld);
#pragma unroll
    for (int q = 0; q < 4; ++q) { v4u o; o.x = pk2(v[8 * q], v[8 * q + 1]); o.y = pk2(v[8 * q + 2], v[8 * q + 3]); o.z = pk2(v[8 * q + 4], v[8 * q + 5]); o.w = pk2(v[8 * q + 6], v[8 * q + 7]); d[q] = o; }
}
__device__ __forceinline__ unsigned pk4_f8(float a, float b, float c, float d) {
    a = fminf(fmaxf(a, -448.f), 448.f); b = fminf(fmaxf(b, -448.f), 448.f); c = fminf(fmaxf(c, -448.f), 448.f); d = fminf(fmaxf(d, -448.f), 448.f);
    unsigned r = 0u; r = __builtin_amdgcn_cvt_pk_fp8_f32(a, b, r, false); r = __builtin_amdgcn_cvt_pk_fp8_f32(c, d, r, true); return r; }
struct F8Tile { const GAS float* src; size_t ld; GAS unsigned char* dst; };
__device__ __forceinline__ F8Tile f8_tile(Frame& F, int tile) {
    const int le = tile / 528; int r = tile % 528; const int which = r / 176; r %= 176; const int nn = F.tid >> 1, hh = F.tid & 1; F8Tile t;
    if (which < 2) { const int kb = r & 15, nb = r >> 4, n = 256 * nb + nn, pn = n >> 7, row = (n & 127) + which * 128;
        t.src = INP(F, which == 0 ? I_EG : I_EU) + (size_t)le * DM * FF + (size_t)(64 * kb + 8 * F.wave) * FF + 256 * nb + 4 * F.lane; t.ld = FF;
        t.dst = (GAS unsigned char*)(F.ws + WS_WGU) + (size_t)le * 5632 * DM + (size_t)(((pn * 8 + (kb >> 1)) * 2 + (kb & 1)) * 16384 + row * 64 + 32 * hh); }
    else { const int kb = r % 44, nb = r / 44;
        t.src = INP(F, I_ED) + (size_t)le * FF * DM + (size_t)(64 * kb + 8 * F.wave) * DM + 256 * nb + 4 * F.lane; t.ld = DM;
        t.dst = (GAS unsigned char*)(F.ws + WS_WD) + (size_t)le * DM * FF + (size_t)(((nb * 22 + (kb >> 1)) * 2 + (kb & 1)) * 16384 + nn * 64 + 32 * hh); }
    return t;
}
__device__ __forceinline__ void f8_tile_load(const F8Tile& t, f32x4 (&v)[8]) {
#pragma unroll
    for (int i = 0; i < 8; ++i) { const GAS float* a = t.src + (size_t)i * t.ld; asm volatile("global_load_dwordx4 %0, %1, off nt" : "=v"(v[i]) : "v"(a) : "memory"); }
}
__device__ __forceinline__ void f8_tile_wait(f32x4 (&v)[8]) {
    asm volatile("s_waitcnt vmcnt(16)" : "+v"(v[0]), "+v"(v[1]), "+v"(v[2]), "+v"(v[3]), "+v"(v[4]), "+v"(v[5]), "+v"(v[6]), "+v"(v[7]) :: "memory");
}
__device__ __forceinline__ void f8_tile_finish(Frame& F, const F8Tile& t, f32x4 (&v)[8], LAS unsigned char* img) {
    f8_tile_wait(v);
#pragma unroll
    for (int j = 0; j < 4; ++j) { v2u o; o.x = pk4_f8(v[0][j] * W8_SCALE, v[1][j] * W8_SCALE, v[2][j] * W8_SCALE, v[3][j] * W8_SCALE); o.y = pk4_f8(v[4][j] * W8_SCALE, v[5][j] * W8_SCALE, v[6][j] * W8_SCALE, v[7][j] * W8_SCALE);
        *(LAS v2u*)(img + (4 * F.lane + j) * 80 + 8 * F.wave) = o; }
    asm volatile("s_waitcnt lgkmcnt(0)" ::: "memory"); __builtin_amdgcn_s_barrier(); asm volatile("" ::: "memory");
    const LAS unsigned char* rp = img + (F.tid >> 1) * 80 + 32 * (F.tid & 1);
    const v4u a = *(const LAS v4u*)rp, b = *(const LAS v4u*)(rp + 16);
    *(GAS v4u*)t.dst = a; *(GAS v4u*)(t.dst + 16) = b;
}
__device__ __forceinline__ void f8_convert_range(Frame& F, int first, int stride, int count) {
    if (count <= 0) return;
    LAS unsigned char* img0 = F.lds; LAS unsigned char* img1 = F.lds + 256 * 80; LAS unsigned char* img2 = F.lds + 2 * 256 * 80;
#define F8_TIDX(i) (first + stride * (((i) < count) ? (i) : count - 1))
    F8Tile ta = f8_tile(F, F8_TIDX(0)), tb = f8_tile(F, F8_TIDX(1)), tc; f32x4 va[8], vb[8], vc[8];
    f8_tile_load(ta, va); f8_tile_load(tb, vb);
#pragma unroll 1
    for (int i = 0; i < count; i += 3) {
        tc = f8_tile(F, F8_TIDX(i + 2)); f8_tile_load(tc, vc);
        f8_tile_finish(F, ta, va, img0);
        ta = f8_tile(F, F8_TIDX(i + 3)); f8_tile_load(ta, va);
        f8_tile_finish(F, tb, vb, img1);
        tb = f8_tile(F, F8_TIDX(i + 4)); f8_tile_load(tb, vb);
        f8_tile_finish(F, tc, vc, img2);
    }
#undef F8_TIDX
    __syncthreads();
}
constexpr int F8_NTILES = 32 * 528;
struct F8WItem { const GAS float* src; int ld; GAS unsigned char* dst; };
__device__ __forceinline__ F8WItem f8w_item(Frame& F, int q) {
    const int tile = q >> 2, quarter = q & 3, le = tile / 528; int r = tile % 528; const int which = r / 176; r %= 176;
    const int n4 = F.lane & 15, kq = F.lane >> 4; F8WItem it;
    if (which < 2) { const int kb = r & 15, nb = (r >> 4) * 4 + quarter, n = 64 * nb + 4 * n4, pn = n >> 7, row = (n & 127) + which * 128;
        it.src = INP(F, which == 0 ? I_EG : I_EU) + (size_t)le * DM * FF + (size_t)(64 * kb + 16 * kq) * FF + n; it.ld = FF;
        it.dst = (GAS unsigned char*)(F.ws + WS_WGU) + (size_t)le * 5632 * DM + (size_t)(((pn * 8 + (kb >> 1)) * 2 + (kb & 1)) * 16384 + row * 64 + 16 * kq); }
    else { const int kb = r % 44, nb = (r / 44) * 4 + quarter, n = 64 * nb + 4 * n4, pn = n >> 8, row = n & 255;
        it.src = INP(F, I_ED) + (size_t)le * FF * DM + (size_t)(64 * kb + 16 * kq) * DM + n; it.ld = DM;
        it.dst = (GAS unsigned char*)(F.ws + WS_WD) + (size_t)le * DM * FF + (size_t)(((pn * 22 + (kb >> 1)) * 2 + (kb & 1)) * 16384 + row * 64 + 16 * kq); }
    return it;
}
#ifndef MK_N_LAUNCHES
#define MK_N_LAUNCHES 1
#endif
constexpr int F8W_HOSTED = 4, F8W_IDLE = 5, F8W_BARQ = (MK_N_LAUNCHES == 1) ? 11 : 0, F8W_BARQ0 = (MK_N_LAUNCHES == 1) ? 15 : 0, F8W_BARW = 256 * 7, F8W_HOST0 = 2 * F8_NTILES;
__device__ __forceinline__ void f8w_load(const F8WItem& it, f32x4 (&v)[16]) {
#pragma unroll
    for (int i = 0; i < 16; ++i) { const GAS float* a = it.src + (size_t)i * it.ld; asm volatile("global_load_dwordx4 %0, %1, off nt" : "=v"(v[i]) : "v"(a) : "memory"); }
}
__device__ __forceinline__ void f8w_finish(const F8WItem& it, f32x4 (&v)[16]) {
    asm volatile("s_waitcnt vmcnt(0)" : "+v"(v[0]), "+v"(v[1]), "+v"(v[2]), "+v"(v[3]), "+v"(v[4]), "+v"(v[5]), "+v"(v[6]), "+v"(v[7]),
                 "+v"(v[8]), "+v"(v[9]), "+v"(v[10]), "+v"(v[11]), "+v"(v[12]), "+v"(v[13]), "+v"(v[14]), "+v"(v[15]) :: "memory");
#pragma unroll
    for (int j = 0; j < 4; ++j) { v4u o;
        o.x = pk4_f8(v[0][j] * W8_SCALE, v[1][j] * W8_SCALE, v[2][j] * W8_SCALE, v[3][j] * W8_SCALE); o.y = pk4_f8(v[4][j] * W8_SCALE, v[5][j] * W8_SCALE, v[6][j] * W8_SCALE, v[7][j] * W8_SCALE);
        o.z = pk4_f8(v[8][j] * W8_SCALE, v[9][j] * W8_SCALE, v[10][j] * W8_SCALE, v[11][j] * W8_SCALE); o.w = pk4_f8(v[12][j] * W8_SCALE, v[13][j] * W8_SCALE, v[14][j] * W8_SCALE, v[15][j] * W8_SCALE);
        *(GAS v4u*)(it.dst + j * 64) = o; }
}
__device__ __forceinline__ void f8w_convert_all(Frame& F) {
    const int gw = F.vcu * NWAVES + F.wave, NGW = F.G * NWAVES;
    const int h0 = (F.G == 256) ? F8W_HOST0 : 4 * F8_NTILES, h1 = h0 + F8W_HOSTED * NGW + F8W_IDLE * 1024 + F8W_BARQ * F8W_BARW;
    const int g0 = (F.G == 256) ? F8W_HOST0 - F8W_BARQ0 * F8W_BARW : 4 * F8_NTILES;
    for (int q = gw; q < 4 * F8_NTILES; q += NGW) { if (q >= g0 && q < h1) continue; const F8WItem it = f8w_item(F, q); f32x4 v[16];
#pragma unroll
        for (int i = 0; i < 16; ++i) v[i] = __builtin_nontemporal_load((const GAS f32x4*)(it.src + (size_t)i * it.ld));
#pragma unroll
        for (int j = 0; j < 4; ++j) { v4u o;
            o.x = pk4_f8(v[0][j] * W8_SCALE, v[1][j] * W8_SCALE, v[2][j] * W8_SCALE, v[3][j] * W8_SCALE); o.y = pk4_f8(v[4][j] * W8_SCALE, v[5][j] * W8_SCALE, v[6][j] * W8_SCALE, v[7][j] * W8_SCALE);
            o.z = pk4_f8(v[8][j] * W8_SCALE, v[9][j] * W8_SCALE, v[10][j] * W8_SCALE, v[11][j] * W8_SCALE); o.w = pk4_f8(v[12][j] * W8_SCALE, v[13][j] * W8_SCALE, v[14][j] * W8_SCALE, v[15][j] * W8_SCALE);
            *(GAS v4u*)(it.dst + j * 64) = o; } }
}

__device__ __forceinline__ void f8w_convert_one(Frame& F, int q) {
    const F8WItem it = f8w_item(F, q); f32x4 v[16];
#pragma unroll
    for (int k = 0; k < 16; ++k) v[k] = __builtin_nontemporal_load((const GAS f32x4*)(it.src + (size_t)k * it.ld));
#pragma unroll
    for (int j = 0; j < 4; ++j) { v4u o;
        o.x = pk4_f8(v[0][j] * W8_SCALE, v[1][j] * W8_SCALE, v[2][j] * W8_SCALE, v[3][j] * W8_SCALE); o.y = pk4_f8(v[4][j] * W8_SCALE, v[5][j] * W8_SCALE, v[6][j] * W8_SCALE, v[7][j] * W8_SCALE);
        o.z = pk4_f8(v[8][j] * W8_SCALE, v[9][j] * W8_SCALE, v[10][j] * W8_SCALE, v[11][j] * W8_SCALE); o.w = pk4_f8(v[12][j] * W8_SCALE, v[13][j] * W8_SCALE, v[14][j] * W8_SCALE, v[15][j] * W8_SCALE);
        *(GAS v4u*)(it.dst + j * 64) = o; }
}
__device__ __forceinline__ void f8w_convert_idle(Frame& F) {
    const int iw = ((int)blockIdx.x - 128) * NWAVES + F.wave;
    for (int i = 0; i < F8W_IDLE; ++i) { const F8WItem it = f8w_item(F, F8W_HOST0 + F8W_HOSTED * 2048 + iw + 1024 * i); f32x4 v[16];
#pragma unroll
        for (int k = 0; k < 16; ++k) v[k] = __builtin_nontemporal_load((const GAS f32x4*)(it.src + (size_t)k * it.ld));
#pragma unroll
        for (int j = 0; j < 4; ++j) { v4u o;
            o.x = pk4_f8(v[0][j] * W8_SCALE, v[1][j] * W8_SCALE, v[2][j] * W8_SCALE, v[3][j] * W8_SCALE); o.y = pk4_f8(v[4][j] * W8_SCALE, v[5][j] * W8_SCALE, v[6][j] * W8_SCALE, v[7][j] * W8_SCALE);
            o.z = pk4_f8(v[8][j] * W8_SCALE, v[9][j] * W8_SCALE, v[10][j] * W8_SCALE, v[11][j] * W8_SCALE); o.w = pk4_f8(v[12][j] * W8_SCALE, v[13][j] * W8_SCALE, v[14][j] * W8_SCALE, v[15][j] * W8_SCALE);
            *(GAS v4u*)(it.dst + j * 64) = o; } }
}
__device__ __forceinline__ void mod_item(Frame& F, int it) {
    const int l = it / 96, cg = it % 96, tid = F.tid;
    LAS float* cond = (LAS float*)F.lds; LAS float* part = (LAS float*)(F.lds + 16384);
    const GAS float* c = INP(F, I_C);
    for (int i = tid; i < BATCH * DM; i += NTHR) cond[i] = siluf(c[i]);
    __syncthreads();
    const int cl = tid & 15, kq = tid >> 4;
    const GAS float* W = INP(F, I_ADAW) + (size_t)l * DM * 6144 + cg * 64 + cl * 4;
    f32x4 acc[4];
#pragma unroll
    for (int b = 0; b < 4; ++b) acc[b] = (f32x4){0.f, 0.f, 0.f, 0.f};
#pragma unroll 4
    for (int kk = 0; kk < 32; ++kk) { const int k = kq * 32 + kk; const f32x4 w = *(const GAS f32x4*)(W + (size_t)k * 6144);
#pragma unroll
        for (int b = 0; b < 4; ++b) acc[b] += w * cond[b * DM + k]; }
#pragma unroll
    for (int b = 0; b < 4; ++b) *(LAS f32x4*)(part + (kq * 4 + b) * 64 + cl * 4) = acc[b];
    __syncthreads();
    if (tid < 256) { const int b = tid >> 6, col = tid & 63; float s = 0.f;
        for (int q = 0; q < 32; ++q) s += part[(q * 4 + b) * 64 + col];
        GAS float* mod = (GAS float*)(F.ws + WS_MOD);
        mod[(size_t)(l * 4 + b) * 6144 + cg * 64 + col] = s + INP(F, I_ADAB)[l * 6144 + cg * 64 + col]; }
    __syncthreads();
}
constexpr float HY_MIN_DECAY = -3.0701134573253943f, HY_MAX_DECAY = -15.350567286626972f;
__device__ __forceinline__ void filter_item(Frame& F, int it) {
    const int l = it >> 7, pg = it & 127, p0 = pg * 32, tid = F.tid, lane = F.lane, w = F.wave;
    LAS float* L = (LAS float*)F.lds;
    LAS float* W1 = L;
    LAS float* B1 = W1 + 33 * 64;
    LAS float* W2 = B1 + 64;
    LAS float* B2 = W2 + 2 * 64 * 64;
    LAS float* FR = B2 + 128;
    LAS float* EMB = FR + 64;
    LAS float* HB = EMB + 8 * 64;
    LAS float* H3 = HB + 8 * 64;
    for (int i = tid; i < 33 * 64; i += NTHR) W1[i] = INP(F, I_HW1)[l * 33 * 64 + i];
    for (int i = tid; i < 2 * 64 * 64; i += NTHR) W2[i] = INP(F, I_HW2)[l * 2 * 64 * 64 + i];
    if (tid < 64) { B1[tid] = INP(F, I_HB1)[l * 64 + tid]; FR[tid] = INP(F, I_HFREQ)[l * 64 + tid]; }
    if (tid < 128) B2[tid] = INP(F, I_HB2)[l * 128 + tid];
    __syncthreads();
    const float fr = FR[lane];
    for (int pj = 0; pj < 4; ++pj) {
        const int pl = w * 4 + pj, p = p0 + pl;
        if (lane < 16) { const float f = 1e-4f + (float)lane * ((15.0f - 1e-4f) / 15.0f); const float ang = (6.283185307179586f * (float)p / (float)SEQ) * f;
            EMB[w * 64 + 1 + lane] = cosf(ang); EMB[w * 64 + 17 + lane] = -sinf(ang); }
        if (lane == 0) EMB[w * 64] = (float)p / (float)(SEQ - 1);
        LDS_WAIT(); asm volatile("" ::: "memory");
        float a = B1[lane];
        for (int k = 0; k < 33; ++k) a += EMB[w * 64 + k] * W1[k * 64 + lane];
        float h = sinf(fr * a);
#pragma unroll
        for (int i = 0; i < 2; ++i) {
            LDS_WAIT(); asm volatile("" ::: "memory");
            HB[w * 64 + lane] = h;
            LDS_WAIT(); asm volatile("" ::: "memory");
            float a2 = B2[i * 64 + lane];
            for (int k = 0; k < 64; ++k) a2 += HB[w * 64 + k] * W2[(i * 64 + k) * 64 + lane];
            h = sinf(fr * a2);
        }
        H3[pl * 64 + lane] = h;
        LDS_WAIT(); asm volatile("" ::: "memory");
    }
    __syncthreads();
    {
        const int oc = tid, c = oc & 255; const GAS float* w3 = INP(F, I_HW3) + (size_t)l * 64 * 512 + oc;
        float wc[64];
#pragma unroll
        for (int k = 0; k < 64; ++k) wc[k] = w3[k * 512];
        const float delta = fabsf(HY_MIN_DECAY + (float)c * ((HY_MAX_DECAY - HY_MIN_DECAY) / 255.0f));
        GAS float* hf = (GAS float*)(F.ws + WS_HF) + ((size_t)l * 256 + c) * 8192;
        for (int pl = 0; pl < 32; ++pl) { const int p = p0 + pl; float a = 0.f;
#pragma unroll
            for (int k4 = 0; k4 < 16; ++k4) { const f32x4 hv = *(LAS f32x4*)(H3 + pl * 64 + 4 * k4); a += hv[0] * wc[4 * k4] + hv[1] * wc[4 * k4 + 1] + hv[2] * wc[4 * k4 + 2] + hv[3] * wc[4 * k4 + 3]; }
            const float t = (float)p / (float)(SEQ - 1); a *= __expf(-t * delta);
            if (oc < 256) hf[4096 + p]= a; else if (p > 0) hf[4096 - p] = a; }
        if (pg == 0 && oc < 256) hf[0] = 0.f;
    }
    __syncthreads();
}
__device__ __forceinline__ void row_load(const GAS float* row, int lane, f32x4 (&v)[4]) {
#pragma unroll
    for (int j = 0; j < 4; ++j) v[j] = ((const GAS f32x4*)row)[lane + 64 * j];
}
__device__ __forceinline__ void row_load_bf16(const GAS bf16* row, int lane, f32x4 (&v)[4]) {
#pragma unroll
    for (int j = 0; j < 4; ++j) { const v2u w = ((const GAS v2u*)row)[lane + 64 * j]; v[j] = (f32x4){__uint_as_float(w.x << 16), __uint_as_float(w.x & 0xffff0000u), __uint_as_float(w.y << 16), __uint_as_float(w.y & 0xffff0000u)}; }
}
__device__ __forceinline__ void row_load_f8(const GAS unsigned char* row, int lane, float scale, f32x4 (&v)[4]) {
    typedef float f32x2_ __attribute__((ext_vector_type(2)));
#pragma unroll
    for (int j = 0; j < 4; ++j) { const unsigned w = ((const GAS unsigned*)row)[lane + 64 * j]; const f32x2_ lo = __builtin_amdgcn_cvt_pk_f32_fp8(w, false), hi = __builtin_amdgcn_cvt_pk_f32_fp8(w, true);
        v[j] = (f32x4){lo.x * scale, lo.y * scale, hi.x * scale, hi.y * scale}; }
}
__device__ __forceinline__ float row_ss(const f32x4 (&v)[4], int lane) { float s = 0.f;
#pragma unroll
    for (int j = 0; j < 4; ++j) s += (v[j][0] * v[j][0] + v[j][1] * v[j][1]) + (v[j][2] * v[j][2] + v[j][3] * v[j][3]);
    return wave_sum(s, lane); }
__device__ __forceinline__ void row_modnorm(f32x4 (&v)[4], int lane, const GAS float* g, const GAS float* sc, const GAS float* sh, GAS bf16* orow) {
    const float rstd = rsq(row_ss(v, lane) * (1.0f / DM) + EPS);
#pragma unroll
    for (int j = 0; j < 4; ++j) { const int c4 = lane + 64 * j; const f32x4 gg = ((const GAS f32x4*)g)[c4], s1 = ((const GAS f32x4*)sc)[c4], s0 = ((const GAS f32x4*)sh)[c4];
        v[j] = v[j] * rstd * gg * (1.0f + s1) + s0;
        v2u o; o.x = pk2(v[j][0], v[j][1]); o.y = pk2(v[j][2], v[j][3]); ((GAS v2u*)orow)[c4] = o; }
}

__device__ __forceinline__ void row_modnorm_f8(f32x4 (&v)[4], int lane, const GAS float* g, const GAS float* sc, const GAS float* sh, GAS unsigned char* orow) {
    const float rstd = rsq(row_ss(v, lane) * (1.0f / DM) + EPS);
#pragma unroll
    for (int j = 0; j < 4; ++j) { const int c4 = lane + 64 * j; const f32x4 gg = ((const GAS f32x4*)g)[c4], s1 = ((const GAS f32x4*)sc)[c4], s0 = ((const GAS f32x4*)sh)[c4];
        v[j] = v[j] * rstd * gg * (1.0f + s1) + s0;
        ((GAS unsigned*)orow)[c4] = pk4_f8(v[j][0], v[j][1], v[j][2], v[j][3]); }
}
__device__ __forceinline__ void row_store_bf16(GAS bf16* row, int lane, const f32x4 (&v)[4]) {
#pragma unroll
    for (int j = 0; j < 4; ++j) { v2u o; o.x = pk2(v[j][0], v[j][1]); o.y = pk2(v[j][2], v[j][3]); ((GAS v2u*)row)[lane + 64 * j] = o; }
}
__device__ __forceinline__ void bf8_to_f32(const v4u& w, f32x4& lo, f32x4& hi) {
    lo = (f32x4){__uint_as_float(w.x << 16), __uint_as_float(w.x & 0xffff0000u), __uint_as_float(w.y << 16), __uint_as_float(w.y & 0xffff0000u)};
    hi = (f32x4){__uint_as_float(w.z << 16), __uint_as_float(w.z & 0xffff0000u), __uint_as_float(w.w << 16), __uint_as_float(w.w & 0xffff0000u)}; }
__device__ __forceinline__ void roww_load_bf16(const GAS bf16* row, int lane, f32x4 (&v)[4]) {
    const v4u a = ((const GAS v4u*)row)[2 * lane], b = ((const GAS v4u*)row)[2 * lane + 1]; bf8_to_f32(a, v[0], v[1]); bf8_to_f32(b, v[2], v[3]); }
__device__ __forceinline__ void roww_load(const GAS float* row, int lane, f32x4 (&v)[4]) {
#pragma unroll
    for (int j = 0; j < 4; ++j) v[j] = ((const GAS f32x4*)row)[4 * lane + j]; }
__device__ __forceinline__ void roww_store_bf16(GAS bf16* row, int lane, const f32x4 (&v)[4]) {
    v4u a, b; a.x = pk2(v[0][0], v[0][1]); a.y = pk2(v[0][2], v[0][3]); a.z = pk2(v[1][0], v[1][1]); a.w = pk2(v[1][2], v[1][3]);
    b.x = pk2(v[2][0], v[2][1]); b.y = pk2(v[2][2], v[2][3]); b.z = pk2(v[3][0], v[3][1]); b.w = pk2(v[3][2], v[3][3]);
    ((GAS v4u*)row)[2 * lane] = a; ((GAS v4u*)row)[2 * lane + 1] = b; }
__device__ __forceinline__ void prologue0(Frame& F) {
    for (int it = blockIdx.x; it < 192; it += F.G) mod_item(F, it);
}
__device__ __forceinline__ void prologue2(Frame& F);
__device__ __forceinline__ void prologue1(Frame& F) {
    for (int it = blockIdx.x; it < 256; it += F.G) filter_item(F, it);
    prologue2(F);
    {   GAS bf16* WIN = (GAS bf16*)(F.ws + WS_WIN);
        for (int it = blockIdx.x * NTHR + F.tid; it < DEPTH * 256 * DM; it += F.G * NTHR) {
            const int k = it & 1023, n = (it >> 10) & 255, l = it >> 18, dir = n >> 7, j = n & 127;
            const GAS float* wi = INP(F, I_WIN) + ((size_t)l * DM + k) * NIN + 768 + 16 * dir; const GAS float* wd = INP(F, I_GWDEC) + ((size_t)(l * 2 + dir) * 16) * 128 + j;
            float s = 0.f;
#pragma unroll
            for (int r = 0; r < 16; ++r) s += wi[r] * wd[r * 128];
            WIN[((size_t)l * NPROJ + 768 + n) * DM + k] = (bf16)f2bf(s); } }
    const int gw = F.vcu * NWAVES + F.wave, NGW = F.G * NWAVES;
    constexpr int N_WIN = 2 * 1152, N_WOUT = 2 * 512;
    for (int it0 = gw; it0 < N_WIN + N_WOUT; it0 += NGW) {
        int it = it0;
        if (it < N_WIN) { const int l = it / 1152; int r = it % 1152; int kb, srccol, dstrow;
            if (r < 384) { kb = r / 12; const int nb = r % 12; srccol = 64 * nb; dstrow = 64 * nb; } else { r -= 384; kb = r / 24; const int nb = r % 24; srccol = 800 + 64 * nb; dstrow = 1024 + 64 * nb; }
            transpose_item(INP(F, I_WIN) + ((size_t)l * DM + 32 * kb) * NIN + srccol, NIN, (GAS bf16*)(F.ws + WS_WIN) + ((size_t)l * NPROJ + dstrow) * DM + 32 * kb, DM, F.lane); continue; }
        it -= N_WIN;
        {   const int l = it / 512, r = it % 512, kb = r / 16, nb = r % 16;
            transpose_item(INP(F, I_WOUT) + ((size_t)l * DM + 32 * kb) * DM + 64 * nb, DM, (GAS bf16*)(F.ws + WS_WOUT) + ((size_t)l * DM + 64 * nb) * DM + 32 * kb, DM, F.lane); }
    }
    __syncthreads();
    f8w_convert_all(F);
}
__device__ __forceinline__ void prologue2(Frame& F) {
    const int gw = F.vcu * NWAVES + F.wave, NGW = F.G * NWAVES, lane = F.lane; const GAS float* mod = (const GAS float*)(F.ws + WS_MOD);
    LAS float* PV = (LAS float*)F.lds;
    for (int i = F.tid; i < 4 * 256; i += NTHR) { const int b = i >> 8, c4 = i & 255; const GAS float* mb = mod + (size_t)b * 6144;
        const f32x4 gg = ((const GAS f32x4*)INP(F, I_MPRE))[c4], s1 = ((const GAS f32x4*)(mb + 1024))[c4], s0 = ((const GAS f32x4*)mb)[c4];
        LAS f32x4* pv = (LAS f32x4*)(PV + b * 2048) + c4; pv[0] = gg * (1.0f + s1); pv[256] = s0; }
    __syncthreads();
    for (int m = gw; m < M; m += NGW) { const int b = m >> 12; f32x4 v[4]; row_load(INP(F, I_X) + (size_t)m * DM, lane, v);
        const LAS f32x4* Bv = (const LAS f32x4*)(PV + b * 2048); const float rstd = rsq(row_ss(v, lane) * (1.0f / DM) + EPS); GAS v2u* orow = (GAS v2u*)((GAS bf16*)(F.ws + WS_HN) + (size_t)m * DM);
#pragma unroll
        for (int j = 0; j < 4; ++j) { const int c4 = lane + 64 * j; const f32x4 o4 = v[j] * rstd * Bv[c4] + Bv[256 + c4]; v2u o; o.x = pk2(o4[0], o4[1]); o.y = pk2(o4[2], o4[3]); orow[c4] = o; } }
    __syncthreads();
}

__device__ __forceinline__ void gla_cumsums(const GAS bf16* proj_chunk  , int h, const GAS float* bdec  , int lane, float (&pf)[16], float (&sb)[16], float& totf, float& totb) {
    const int dk = lane & 31, half = lane >> 5;
    const float bf_ = bdec[h * 32 + dk], bb_ = bdec[128 + h * 32 + dk];
    const GAS bf16* pr = proj_chunk + (size_t)(16 * half) * NPROJ + h * 32 + dk;
    float accf = 0.f;
#pragma unroll
    for (int ii = 0; ii < 16; ++ii) { accf += logsigf(bf2f(pr[(size_t)ii * NPROJ + PC_LAF]) + bf_) * (1.0f / 16.0f); pf[ii] = accf; }
    float accb = 0.f;
#pragma unroll
    for (int ii = 15; ii >= 0; --ii) { accb += logsigf(bf2f(pr[(size_t)ii * NPROJ + PC_LAB]) + bb_) * (1.0f / 16.0f); sb[ii] = accb; }
    const float of = lane_get(accf, lane ^ 32), ob = lane_get(accb, lane ^ 32);
    totf = accf + of; totb = accb + ob;
    if (half == 1) {
#pragma unroll
        for (int ii = 0; ii < 16; ++ii) pf[ii] += of; }
    else {
#pragma unroll
        for (int ii = 0; ii < 16; ++ii) sb[ii] += ob; }
}
typedef short g_bf16x8 __attribute__((ext_vector_type(8)));
typedef float g_f32x16 __attribute__((ext_vector_type(16)));
__device__ __forceinline__ g_bf16x8 g_frag(unsigned a, unsigned b, unsigned c, unsigned d) { v4u w; w.x = a; w.y = b; w.z = c; w.w = d; return __builtin_bit_cast(g_bf16x8, w); }
__device__ __forceinline__ g_bf16x8 g_col8(const GAS bf16* p, size_t st) {
    unsigned e[8];
#pragma unroll
    for (int j = 0; j < 8; ++j) e[j] = p[(size_t)j * st];
    return g_frag(e[0] | (e[1] << 16), e[2] | (e[3] << 16), e[4] | (e[5] << 16), e[6] | (e[7] << 16));
}
__device__ __forceinline__ void gla_chunk_kv(Frame& F, int l, int item) {
    int lane = F.lane; asm volatile("" : "+v"(lane));
    const int n = item & 127, h = (item >> 7) & 3, b = item >> 9, dk = lane & 31, half = lane >> 5;
    const GAS bf16* proj = (const GAS bf16*)(F.ws + WS_PROJ) + (size_t)(b * SEQ + 32 * n) * NPROJ;
    g_bf16x8 vb[2][2];
#pragma unroll
    for (int s = 0; s < 2; ++s)
#pragma unroll
        for (int blk = 0; blk < 2; ++blk) vb[s][blk] = g_col8(proj + (size_t)(16 * half + 8 * s) * NPROJ + PC_GV + h * 64 + blk * 32 + dk, NPROJ);
    float pf[16], sb[16], totf, totb;
    gla_cumsums(proj, h, INP(F, I_GBDEC) + l * 256, lane, pf, sb, totf, totb);
    unsigned wf[8], wb[8];
#pragma unroll
    for (int ip = 0; ip < 8; ++ip) {
        const float k0 = bf2f(proj[(size_t)(16 * half + 2 * ip) * NPROJ + PC_GK + h * 32 + dk]), k1 = bf2f(proj[(size_t)(16 * half + 2 * ip + 1) * NPROJ + PC_GK + h * 32 + dk]);
        wf[ip] = pk2(k0 * __expf(totf - pf[2 * ip]), k1 * __expf(totf - pf[2 * ip + 1])); wb[ip] = pk2(k0 * __expf(totb - sb[2 * ip]), k1 * __expf(totb - sb[2 * ip + 1])); }
    GAS float* alast = (GAS float*)(F.ws + WS_ALAST);
    if (half == 0) { alast[(size_t)(((b * 4 + h) * 2 + 0) * NCHUNK + n) * 32 + dk] = __expf(totf); alast[(size_t)(((b * 4 + h) * 2 + 1) * NCHUNK + n) * 32 + dk] = __expf(totb); }
    g_f32x16 accf[2], accb[2];
#pragma unroll
    for (int blk = 0; blk < 2; ++blk)
#pragma unroll
        for (int r = 0; r < 16; ++r) { accf[blk][r] = 0.f; accb[blk][r] = 0.f; }
#pragma unroll
    for (int s = 0; s < 2; ++s) { const g_bf16x8 af = g_frag(wf[4 * s], wf[4 * s + 1], wf[4 * s + 2], wf[4 * s + 3]), ab = g_frag(wb[4 * s], wb[4 * s + 1], wb[4 * s + 2], wb[4 * s + 3]);
#pragma unroll
        for (int blk = 0; blk < 2; ++blk) { accf[blk] = __builtin_amdgcn_mfma_f32_32x32x16_bf16(af, vb[s][blk], accf[blk], 0, 0, 0); accb[blk] = __builtin_amdgcn_mfma_f32_32x32x16_bf16(ab, vb[s][blk], accb[blk], 0, 0, 0); } }
    GAS bf16* gkv = (GAS bf16*)(F.ws + WS_GKV);
    GAS bf16* of_ = gkv + (size_t)(((b * 4 + h) * 2 + 0) * NCHUNK + n) * 2048 + dk * 8 + 4 * half; GAS bf16* ob_ = gkv + (size_t)(((b * 4 + h) * 2 + 1) * NCHUNK + n) * 2048 + dk * 8 + 4 * half;
#pragma unroll
    for (int blk = 0; blk < 2; ++blk)
#pragma unroll
        for (int g = 0; g < 4; ++g) { const int f = ((((g >> 1) * 2 + blk) * 2 + (g & 1)) * 32) * 8;
            v2u wf_, wb_; wf_.x = pk2(accf[blk][4 * g], accf[blk][4 * g + 1]); wf_.y = pk2(accf[blk][4 * g + 2], accf[blk][4 * g + 3]); wb_.x = pk2(accb[blk][4 * g], accb[blk][4 * g + 1]); wb_.y = pk2(accb[blk][4 * g + 2], accb[blk][4 * g + 3]);
            *(GAS v2u*)(of_ + f) = wf_; *(GAS v2u*)(ob_ + f) = wb_; }
}
__device__ __forceinline__ void qk_prep_rows4(Frame& F, int l, int m0, int mstep, const LAS float* tab) {
    const int lane = F.lane;
    const LAS float* gt = tab + 2048;
    const GAS bf16* proj = (const GAS bf16*)(F.ws + WS_PROJ);
    v2u xa[5], xb[5];
#pragma unroll
    for (int i = 0; i < 5; ++i) { const int T = lane + 64 * i, q = (T * 205) >> 14, r = T - 80 * q, head = r >> 3, hf = (r >> 2) & 1, jj = r & 3, d1 = hf * 32 + 4 * jj;
        const GAS bf16* pr = proj + (size_t)(m0 + q * mstep) * NPROJ + ((head < 8) ? (PC_AQ + head * 64) : (PC_AK + (head - 8) * 64)) + d1;
        xa[i] = *(const GAS v2u*)pr; xb[i] = *(const GAS v2u*)(pr + 16); }
    const int mv = m0 + (lane >> 4) * mstep;
    const v4u vv = *(const GAS v4u*)(proj + (size_t)mv * NPROJ + PC_AV + 8 * (lane & 15));
#pragma unroll
    for (int i = 0; i < 5; ++i) { const int T = lane + 64 * i, q = (T * 205) >> 14, r = T - 80 * q, head = r >> 3, hf = (r >> 2) & 1, jj = r & 3, d1 = hf * 32 + 4 * jj;
        const int m = m0 + q * mstep, t = m & (SEQ - 1), pos = hf ? (t & 63) : (t >> 6);
        const float x1[4] = {__uint_as_float(xa[i].x << 16), __uint_as_float(xa[i].x & 0xffff0000u), __uint_as_float(xa[i].y << 16), __uint_as_float(xa[i].y & 0xffff0000u)};
        const float x2[4] = {__uint_as_float(xb[i].x << 16), __uint_as_float(xb[i].x & 0xffff0000u), __uint_as_float(xb[i].y << 16), __uint_as_float(xb[i].y & 0xffff0000u)};
        float ss = (x1[0] * x1[0] + x1[1] * x1[1]) + (x1[2] * x1[2] + x1[3] * x1[3]) + (x2[0] * x2[0] + x2[1] * x2[1]) + (x2[2] * x2[2] + x2[3] * x2[3]);
        ss += dpp_f<DPP_X1>(ss); ss += dpp_f<DPP_X2>(ss); ss += dpp_f<DPP_HMIR>(ss);
        const float rstd = rsq(ss * (1.0f / 64.0f) + EPS);
        const LAS float* g = gt + ((head < 8) ? 0 : 64) + d1; const f32x4 ga = *(const LAS f32x4*)g, gb = *(const LAS f32x4*)(g + 16);
        const LAS f32x4* tp = (const LAS f32x4*)(tab + (pos * 16 + 4 * jj) * 2); const f32x4 c0 = tp[0], c1 = tp[1];
        const float sc = (head < 8) ? rstd * ATT_C2 : rstd;
        float o1[4], o2[4];
#pragma unroll
        for (int e = 0; e < 4; ++e) { const float y1 = x1[e] * sc * ga[e], y2 = x2[e] * sc * gb[e]; const float cs = (e < 2) ? c0[2 * e] : c1[2 * e - 4], sn = (e < 2) ? c0[2 * e + 1] : c1[2 * e - 3];
            o1[e] = y1 * cs - y2 * sn; o2[e] = y2 * cs + y1 * sn; }
        GAS bf16* op = (head < 8) ? ((GAS bf16*)(F.ws + WS_QP) + (size_t)m * 512 + head * 64 + d1) : ((GAS bf16*)(F.ws + WS_KV) + (size_t)m * 256 + (head - 8) * 64 + d1);
        v2u w1, w2; w1.x = pk2(o1[0], o1[1]); w1.y = pk2(o1[2], o1[3]); w2.x = pk2(o2[0], o2[1]); w2.y = pk2(o2[2], o2[3]);
        *(GAS v2u*)op = w1; *(GAS v2u*)(op + 16) = w2; }
    *(GAS v4u*)((GAS bf16*)(F.ws + WS_KV) + (size_t)mv * 256 + 128 + 8 * (lane & 15)) = vv;
}
__device__ __forceinline__ float bfe(const v4u& w, int e) { const unsigned u = (e & 1) ? (w[e >> 1] & 0xffff0000u) : (w[e >> 1] << 16); return __uint_as_float(u); }
__device__ __forceinline__ void hy_rows(const GAS bf16* p, int tq0, v4u (&rows)[6]) {
#pragma unroll
    for (int r = 0; r < 6; ++r) { const int t = tq0 - 1 + r; rows[r] = (t >= 0 && t < SEQ) ? *(const GAS v4u*)(p + (ptrdiff_t)(r - 1) * NPROJ) : (v4u){0u, 0u, 0u, 0u}; }
}
template <int EH> __device__ __forceinline__ void hy_conv4x4(const v4u (&rows)[6], const GAS float* w, const GAS float* bias, float (&u)[4][4]) {
    const f32x4 w0 = *(const GAS f32x4*)(w + 4 * EH), w1 = *(const GAS f32x4*)(w + 768 + 4 * EH), w2 = *(const GAS f32x4*)(w + 1536 + 4 * EH), bs = *(const GAS f32x4*)(bias + 4 * EH);
#pragma unroll
    for (int e = 0; e < 4; ++e)
#pragma unroll
        for (int i = 0; i < 4; ++i) u[i][e] = bfe(rows[i], 4 * EH + e) * w0[e] + bfe(rows[i + 1], 4 * EH + e) * w1[e] + bfe(rows[i + 2], 4 * EH + e) * w2[e] + bs[e];
}
template <int EH> __device__ __forceinline__ void hy_z_half(const v4u (&r1)[6], const v4u (&r2)[6], const GAS float* cw, const GAS float* cb, unsigned (&zp)[4][4]) {
    float x1[4][4], vv[4][4]; hy_conv4x4<EH>(r1, cw + 256, cb + 256, x1); hy_conv4x4<EH>(r2, cw + 512, cb + 512, vv);
#pragma unroll
    for (int i = 0; i < 4; ++i) { zp[i][2 * EH] = pk2(x1[i][0] * vv[i][0], x1[i][1] * vv[i][1]); zp[i][2 * EH + 1] = pk2(x1[i][2] * vv[i][2], x1[i][3] * vv[i][3]); }
    __builtin_amdgcn_sched_barrier(0);
}
__device__ __forceinline__ void hy_prep_item(Frame& F, int l, int item, LAS unsigned char* lb) {
    int tid = F.tid; asm volatile("" : "+v"(tid));
    const int b = item >> 6, t0 = (item & 63) * 64, cg = tid & 31, tq = tid >> 5, tq0 = t0 + 4 * tq;
    const GAS bf16* p = (const GAS bf16*)(F.ws + WS_PROJ) + ((size_t)b * SEQ + tq0) * NPROJ + PC_HX1 + 8 * cg;
    const GAS float* cw = INP(F, I_HCW) + l * 3 * 768 + 8 * cg; const GAS float* cb = INP(F, I_HCB) + l * 768 + 8 * cg;
    v4u r1[6], r2[6]; hy_rows(p, tq0, r1); hy_rows(p + 256, tq0, r2);
    unsigned zp[4][4]; hy_z_half<0>(r1, r2, cw, cb, zp); hy_z_half<1>(r1, r2, cw, cb, zp);
    LAS bf16* zs = (LAS bf16*)lb;
#pragma unroll
    for (int e = 0; e < 8; ++e) { const int sh = (e & 1) * 16; v2u o;
        o.x = ((zp[0][e >> 1] >> sh) & 0xffffu) | (((zp[1][e >> 1] >> sh) & 0xffffu) << 16); o.y = ((zp[2][e >> 1] >> sh) & 0xffffu) | (((zp[3][e >> 1] >> sh) & 0xffffu) << 16);
        *(LAS v2u*)(zs + (8 * cg + e) * 72 + 4 * tq) = o; }
    __syncthreads();
    {   const int cc = tid >> 1, hh = tid & 1; GAS bf16* zt = (GAS bf16*)(F.ws + WS_ZT) + ((size_t)cc * BATCH + b) * SEQ + t0 + hh * 32;
#pragma unroll
        for (int q = 0; q < 4; ++q) *(GAS v4u*)(zt + 8 * q) = *(LAS v4u*)(zs + cc * 72 + hh * 32 + 8 * q); }
    __syncthreads();
}
__device__ __forceinline__ void phase_prep(Frame& F, int l) {
    LAS float* tab = (LAS float*)F.lds;
    for (int i = F.tid; i < 1024; i += NTHR) { const int pos = i >> 4, j = i & 15; const float inv = exp2f(-(float)j * (13.287712379549449f / 16.0f)); float sn, cs; sincosf((float)pos * inv, &sn, &cs); tab[2 * i] = cs; tab[2 * i + 1] = sn; }
    if (F.tid < 128) tab[2048 + F.tid] = (F.tid < 64) ? INP(F, I_QNORM)[l * 64 + F.tid] : INP(F, I_KNORM)[l * 64 + F.tid - 64];
    __syncthreads();
    for (int it = blockIdx.x; it < 256; it += F.G) hy_prep_item(F, l, it, F.lds + 8192 + 512);
    const int gw = F.vcu * NWAVES + F.wave, NGW = F.G * NWAVES;
    for (int it = gw; it < 2048; it += NGW) gla_chunk_kv(F, l, it);
    for (int m = gw; m + 3 * NGW < M; m += 4 * NGW) qk_prep_rows4(F, l, m, NGW, tab);
    if ((M / NGW) % 4 != 0 || M % NGW != 0) { for (int m = gw + (M / NGW / 4) * 4 * NGW; m < M; m += NGW) qk_prep_rows4(F, l, m, 0, tab); }
}

__device__ __forceinline__ void gla_scan_item(Frame& F, int item) {
    const int sub = item & 7, bhd = item >> 3, dir = bhd & 1, lane = F.lane, w = F.wave, dk0 = 16 * (sub >> 2) + 8 * (sub & 1) + 4 * (lane & 1);
    GAS bf16* kv = (GAS bf16*)(F.ws + WS_GKV) + (size_t)bhd * NCHUNK * 2048 + sub * 256 + 4 * lane;
    const GAS float* al = (const GAS float*)(F.ws + WS_ALAST) + (size_t)bhd * NCHUNK * 32 + dk0;
    LAS f32x4* AB = (LAS f32x4*)F.lds;
    v2u x[16]; f32x4 a[16];
#pragma unroll
    for (int q = 0; q < 16; ++q) { const int p = 16 * w + q, n = dir ? (NCHUNK - 1 - p) : p; x[q] = *(const GAS v2u*)(kv + (size_t)n * 2048); a[q] = *(const GAS f32x4*)(al + n * 32); }
    f32x4 A = (f32x4){1.f, 1.f, 1.f, 1.f}, B = (f32x4){0.f, 0.f, 0.f, 0.f};
#pragma unroll
    for (int q = 0; q < 16; ++q) { const f32x4 xv = (f32x4){__uint_as_float(x[q].x << 16), __uint_as_float(x[q].x & 0xffff0000u), __uint_as_float(x[q].y << 16), __uint_as_float(x[q].y & 0xffff0000u)};
        B = a[q] * B + xv; A = A * a[q]; }
    AB[(w * 2 + 0) * 64 + lane] = A; AB[(w * 2 + 1) * 64 + lane] = B;
    __syncthreads();
    f32x4 S = (f32x4){0.f, 0.f, 0.f, 0.f};
    for (int v = 0; v < w; ++v) S = AB[(v * 2 + 0) * 64 + lane] * S + AB[(v * 2 + 1) * 64 + lane];
#pragma unroll
    for (int q = 0; q < 16; ++q) { const int p = 16 * w + q, n = dir ? (NCHUNK - 1 - p) : p;
        v2u o; o.x = pk2(S[0], S[1]); o.y = pk2(S[2], S[3]); *(GAS v2u*)(kv + (size_t)n * 2048) = o;
        const f32x4 xv = (f32x4){__uint_as_float(x[q].x << 16), __uint_as_float(x[q].x & 0xffff0000u), __uint_as_float(x[q].y << 16), __uint_as_float(x[q].y & 0xffff0000u)};
        S = a[q] * S + xv; }
    __syncthreads();
}
typedef short hy_bf16x8 __attribute__((ext_vector_type(8)));
typedef short hy_bf16x8_a8 __attribute__((ext_vector_type(8), aligned(8)));
typedef float hy_f32x16 __attribute__((ext_vector_type(16)));
constexpr int HYC_CST = 8224, HYC_Z_OFF = 4 * HYC_CST * 2, HYC_ZROW = 144;
__device__ __forceinline__ void hy_conv_item(Frame& F, int l, int c) {
    const int tid = F.tid, lane = F.lane, w = F.wave;
    LAS bf16* G = (LAS bf16*)F.lds; LAS unsigned char* Z = F.lds + HYC_Z_OFF;
    const GAS float* hf = (const GAS float*)(F.ws + WS_HF) + ((size_t)l * 256 + c) * 8192;
    {
        LAS float* HS = (LAS float*)Z;
        for (int i = tid; i < 2048; i += NTHR) *(LAS f32x4*)(HS + 4 * i) = *(const GAS f32x4*)(hf + 4 * i);
        __syncthreads();
#pragma unroll
        for (int q = 0; q < 4; ++q)
            for (int u2 = tid; u2 < HYC_CST / 2; u2 += NTHR) { const int i0 = 8192 + q - 2 * u2, i1 = i0 - 1;
                const float v0 = (i0 >= 1 && i0 <= 8191) ? HS[i0] : 0.f, v1 = (i1 >= 1 && i1 <= 8191) ? HS[i1] : 0.f;
                ((LAS unsigned*)G)[q * (HYC_CST / 2) + u2] = pk2(v0, v1); }
        __syncthreads(); }
    const GAS bf16* zt = (const GAS bf16*)(F.ws + WS_ZT) + (size_t)c * BATCH * SEQ;
    for (int i = tid; i < BATCH * SEQ / 8; i += NTHR) { const int b = i >> 9, s8 = i & 511, S = s8 >> 3, j8 = s8 & 7;
        *(LAS v4u*)(Z + (S * 4 + b) * HYC_ZROW + j8 * 16) = *(const GAS v4u*)(zt + (size_t)b * SEQ + s8 * 8); }
    if (tid < 36) ((LAS unsigned*)(Z + 256 * HYC_ZROW))[tid] = 0u;
    __syncthreads();
    const int r = lane & 31, h = lane >> 5, q = r & 3, nT = 8 * w + (r >> 2), nb = r & 3;
    hy_f32x16 acc0, acc1;
#pragma unroll
    for (int i = 0; i < 16; ++i) { acc0[i] = 0.f; acc1[i] = 0.f; }
    const int a_base = q * HYC_CST + 4096 + 8 * h - (r - q);
    hy_bf16x8 c2, c3;
    {   const LAS bf16* ap = G + (a_base - 64 * (8 * w - 63)); c2 = *(const LAS hy_bf16x8_a8*)(ap + 32); c3 = *(const LAS hy_bf16x8_a8*)(ap + 48); }
    const bool host = (l == 0) && (F.G == 256) && (c == F.vcu);
    const int hq0 = F8W_HOST0 + F.vcu * NWAVES + w; F8WItem hit; f32x4 hv[16]; int di = 0;
#define HYC_LOAD(DD, A00, A01, A10, A11, B0, B1, B2, B3) do { const int S_ = nT - (DD); const int zr_ = (S_ >= 0 && S_ < 64) ? (S_ * 4 + nb) : 256; \
        const LAS unsigned char* zp_ = Z + zr_ * HYC_ZROW + h * 16; const LAS bf16* ap_ = G + (a_base - 64 * (DD)); \
        B0 = *(const LAS hy_bf16x8*)(zp_); B1 = *(const LAS hy_bf16x8*)(zp_ + 32); B2 = *(const LAS hy_bf16x8*)(zp_ + 64); B3 = *(const LAS hy_bf16x8*)(zp_ + 96); \
        A00 = *(const LAS hy_bf16x8_a8*)(ap_); A01 = *(const LAS hy_bf16x8_a8*)(ap_ + 16); A10 = *(const LAS hy_bf16x8_a8*)(ap_ - 32); A11 = *(const LAS hy_bf16x8_a8*)(ap_ - 16); } while (0)
    hy_bf16x8 a00, a01, a10, a11, b0, b1, b2, b3;
    HYC_LOAD(8 * w - 63, a00, a01, a10, a11, b0, b1, b2, b3);
    for (int D = 8 * w - 63; D <= 8 * w + 7; ++D, ++di) {
        if (host && (di & 15) == 0) {
            if (di > 0) f8w_finish(hit, hv);
            if (di < 16 * F8W_HOSTED) { hit = f8w_item(F, hq0 + (di >> 4) * (F.G * NWAVES)); f8w_load(hit, hv); } }
        hy_bf16x8 n00, n01, n10, n11, m0, m1, m2, m3;
        HYC_LOAD((D < 8 * w + 7) ? D + 1 : D, n00, n01, n10, n11, m0, m1, m2, m3);
        acc0 = __builtin_amdgcn_mfma_f32_32x32x16_bf16(a00, b0, acc0, 0, 0, 0); acc1 = __builtin_amdgcn_mfma_f32_32x32x16_bf16(a10, b0, acc1, 0, 0, 0);
        acc0 = __builtin_amdgcn_mfma_f32_32x32x16_bf16(a01, b1, acc0, 0, 0, 0); acc1 = __builtin_amdgcn_mfma_f32_32x32x16_bf16(a11, b1, acc1, 0, 0, 0);
        acc0 = __builtin_amdgcn_mfma_f32_32x32x16_bf16(c2, b2, acc0, 0, 0, 0);  acc1 = __builtin_amdgcn_mfma_f32_32x32x16_bf16(a00, b2, acc1, 0, 0, 0);
        acc0 = __builtin_amdgcn_mfma_f32_32x32x16_bf16(c3, b3, acc0, 0, 0, 0);  acc1 = __builtin_amdgcn_mfma_f32_32x32x16_bf16(a01, b3, acc1, 0, 0, 0);
        c2 = a10; c3 = a11; a00 = n00; a01 = n01; a10 = n10; a11 = n11; b0 = m0; b1 = m1; b2 = m2; b3 = m3;
    }
#undef HYC_LOAD
    GAS bf16* yc = (GAS bf16*)(F.ws + WS_YC) + ((size_t)c * BATCH + nb) * SEQ + 64 * nT + 4 * h;
#pragma unroll
    for (int g = 0; g < 4; ++g) {
        v2u o0; o0.x = pk2(acc0[4 * g], acc0[4 * g + 1]); o0.y = pk2(acc0[4 * g + 2], acc0[4 * g + 3]); *(GAS v2u*)(yc + 8 * g) = o0;
        v2u o1; o1.x = pk2(acc1[4 * g], acc1[4 * g + 1]); o1.y = pk2(acc1[4 * g + 2], acc1[4 * g + 3]); *(GAS v2u*)(yc + 32 + 8 * g) = o1; }
    __syncthreads();
}

__device__ __forceinline__ void gla_out_item(Frame& F, int l, int item, LAS bf16* wl  ) {
    int lane = F.lane; asm volatile("" : "+v"(lane));
    const int n = item & 127, h = (item >> 7) & 3, b = item >> 9, dk = lane & 31, half = lane >> 5;
    const size_t m0 = (size_t)b * SEQ + 32 * n;
    const GAS bf16* proj = (const GAS bf16*)(F.ws + WS_PROJ) + m0 * NPROJ;
    const GAS bf16* gkv = (const GAS bf16*)(F.ws + WS_GKV);
    LAS bf16* R1 = wl; LAS bf16* R2 = wl + 5120;
    LAS bf16* QDF = wl; LAS bf16* KIF = wl + 1280; LAS bf16* QDB = wl + 2560; LAS bf16* KIB = wl + 3840;
    const int rA = lane >> 2, pA = lane & 3, rB = lane >> 3, pB = lane & 7;
    v4u pin[8], pvv[4], pgg[4];
#pragma unroll
    for (int a = 0; a < 4; ++a) { const int col = (a == 0 ? PC_LAF : a == 1 ? PC_LAB : a == 2 ? PC_GQ : PC_GK) + h * 32 + 8 * pA;
        pin[2 * a] = *(const GAS v4u*)(proj + (size_t)rA * NPROJ + col); pin[2 * a + 1] = *(const GAS v4u*)(proj + (size_t)(rA + 16) * NPROJ + col); }
#pragma unroll
    for (int rep = 0; rep < 4; ++rep) { pvv[rep] = *(const GAS v4u*)(proj + (size_t)(rB + 8 * rep) * NPROJ + PC_GV + h * 64 + 8 * pB); pgg[rep] = *(const GAS v4u*)(proj + (size_t)(rB + 8 * rep) * NPROJ + PC_GG + h * 64 + 8 * pB); }
    g_bf16x8 sfr[2][2][2];
#pragma unroll
    for (int dir = 0; dir < 2; ++dir) { const GAS bf16* Sp = gkv + (size_t)(((b * 4 + h) * 2 + dir) * NCHUNK + n) * 2048 + (half * 32 + dk) * 8;
#pragma unroll
        for (int s = 0; s < 2; ++s)
#pragma unroll
            for (int blk = 0; blk < 2; ++blk) sfr[dir][s][blk] = *(const GAS g_bf16x8*)(Sp + (s * 2 + blk) * 512); }
    const float bf_ = (INP(F, I_GBDEC) + l * 256)[h * 32 + dk], bb_ = (INP(F, I_GBDEC) + l * 256)[128 + h * 32 + dk];
    LDS_WAIT(); asm volatile("" ::: "memory");
#pragma unroll
    for (int a = 0; a < 4; ++a) { *(LAS v4u*)(R1 + a * 1280 + rA * 40 + 8 * pA) = pin[2 * a]; *(LAS v4u*)(R1 + a * 1280 + (rA + 16) * 40 + 8 * pA) = pin[2 * a + 1]; }
#pragma unroll
    for (int rep = 0; rep < 4; ++rep) *(LAS v4u*)(R2 + (rB + 8 * rep) * 72 + 8 * pB) = pvv[rep];
    LDS_WAIT(); asm volatile("" ::: "memory");
    g_f32x16 o[2];
#pragma unroll
    for (int blk = 0; blk < 2; ++blk)
#pragma unroll
        for (int r = 0; r < 16; ++r) o[blk][r] = 0.f;
    g_bf16x8 qf[2], qb[2];
    {
        g_bf16x8 kf[2], kb[2];
        g_bf16x8 vfr[2][2];
#pragma unroll
        for (int s = 0; s < 2; ++s)
#pragma unroll
            for (int blk = 0; blk < 2; ++blk) { const LAS bf16* vp = R2 + (16 * s + 4 * half) * 72 + blk * 32 + dk; unsigned ev[8];
#pragma unroll
                for (int jj = 0; jj < 8; ++jj) ev[jj] = vp[(8 * (jj >> 2) + (jj & 3)) * 72];
                vfr[s][blk] = g_frag(ev[0] | (ev[1] << 16), ev[2] | (ev[3] << 16), ev[4] | (ev[5] << 16), ev[6] | (ev[7] << 16)); }
        {
            float pf[16], sb[16], qv[16], kv[16];
            {   const LAS bf16* cp = R1 + (16 * half) * 40 + dk;
                float accf = 0.f;
#pragma unroll
                for (int ii = 0; ii < 16; ++ii) { accf += logsigf(bf2f(cp[ii * 40]) + bf_) * (1.0f / 16.0f); pf[ii] = accf; }
                float accb = 0.f;
#pragma unroll
                for (int ii = 15; ii >= 0; --ii) { accb += logsigf(bf2f(cp[1280 + ii * 40]) + bb_) * (1.0f / 16.0f); sb[ii] = accb; }
#pragma unroll
                for (int ii = 0; ii < 16; ++ii) { qv[ii] = bf2f(cp[2560 + ii * 40]) * 0.17677669529663687f; kv[ii] = bf2f(cp[3840 + ii * 40]); }
                const float of = lane_get(accf, lane ^ 32), ob = lane_get(accb, lane ^ 32);
                if (half == 1) {
#pragma unroll
                    for (int ii = 0; ii < 16; ++ii) pf[ii] += of; }
                else {
#pragma unroll
                    for (int ii = 0; ii < 16; ++ii) sb[ii] += ob; }
            }
            LDS_WAIT(); asm volatile("" ::: "memory");
#pragma unroll
            for (int ii = 0; ii < 16; ++ii) { const int i = 16 * half + ii;
                QDF[i * 40 + dk] = (bf16)f2bf(qv[ii] * __expf(pf[ii])); KIF[i * 40 + dk] = (bf16)f2bf(kv[ii] * __expf(-pf[ii]));
                QDB[i * 40 + dk] = (bf16)f2bf(qv[ii] * __expf(sb[ii])); KIB[i * 40 + dk] = (bf16)f2bf(kv[ii] * __expf(-sb[ii])); }
            LDS_WAIT(); asm volatile("" ::: "memory");
        }
#pragma unroll
        for (int s = 0; s < 2; ++s) { const int fo = dk * 40 + 16 * s + 8 * half;
            qf[s] = *(const LAS g_bf16x8*)(QDF + fo); kf[s] = *(const LAS g_bf16x8*)(KIF + fo); qb[s] = *(const LAS g_bf16x8*)(QDB + fo); kb[s] = *(const LAS g_bf16x8*)(KIB + fo); }
        LDS_WAIT(); asm volatile("" ::: "memory");
#pragma unroll
        for (int rep = 0; rep < 4; ++rep) *(LAS v4u*)(R1 + (rB + 8 * rep) * 72 + 8 * pB) = pgg[rep];
        g_f32x16 xf, xb;
#pragma unroll
        for (int r = 0; r < 16; ++r) { xf[r] = 0.f; xb[r] = 0.f; }
#pragma unroll
        for (int s = 0; s < 2; ++s) { xf = __builtin_amdgcn_mfma_f32_32x32x16_bf16(kf[s], qf[s], xf, 0, 0, 0); xb = __builtin_amdgcn_mfma_f32_32x32x16_bf16(kb[s], qb[s], xb, 0, 0, 0); }
        unsigned xw[8];
#pragma unroll
        for (int rp = 0; rp < 8; ++rp) { float t[2];
#pragma unroll
            for (int u = 0; u < 2; ++u) { const int r = 2 * rp + u, j = (r & 3) + 8 * (r >> 2) + 4 * half; t[u] = ((dk >= j) ? xf[r] : 0.f) + ((dk <= j) ? xb[r] : 0.f); }
            xw[rp] = pk2(t[0], t[1]); }
#pragma unroll
        for (int s = 0; s < 2; ++s) { const g_bf16x8 xa = g_frag(xw[4 * s], xw[4 * s + 1], xw[4 * s + 2], xw[4 * s + 3]);
#pragma unroll
            for (int blk = 0; blk < 2; ++blk) o[blk] = __builtin_amdgcn_mfma_f32_32x32x16_bf16(xa, vfr[s][blk], o[blk], 0, 0, 0); }
    }
#pragma unroll
    for (int dir = 0; dir < 2; ++dir)
#pragma unroll
        for (int s = 0; s < 2; ++s)
#pragma unroll
            for (int blk = 0; blk < 2; ++blk) o[blk] = __builtin_amdgcn_mfma_f32_32x32x16_bf16(dir ? qb[s] : qf[s], sfr[dir][s][blk], o[blk], 0, 0, 0);
    const float ng0 = INP(F, I_GNORM)[l * 64 + dk], ng1 = INP(F, I_GNORM)[l * 64 + 32 + dk];
    LDS_WAIT(); asm volatile("" ::: "memory");
#pragma unroll
    for (int r4 = 0; r4 < 4; ++r4) {
        float g0[4], g1[4], ss[4];
#pragma unroll
        for (int k = 0; k < 4; ++k) { const int row = k + 8 * r4 + 4 * half; g0[k] = bf2f(R1[row * 72 + dk]); g1[k] = bf2f(R1[row * 72 + 32 + dk]); ss[k] = o[0][4 * r4 + k] * o[0][4 * r4 + k] + o[1][4 * r4 + k] * o[1][4 * r4 + k]; }
#pragma unroll
        for (int k = 0; k < 4; ++k) ss[k] = half_sum(ss[k]);
#pragma unroll
        for (int k = 0; k < 4; ++k) { const int row = k + 8 * r4 + 4 * half; const float rstd = rsq(ss[k] * (1.0f / 64.0f) + EPS);
            R2[row * 72 + dk] = (bf16)f2bf(o[0][4 * r4 + k] * rstd * ng0 * siluf(g0[k])); R2[row * 72 + 32 + dk] = (bf16)f2bf(o[1][4 * r4 + k] * rstd * ng1 * siluf(g1[k])); }
    }
    LDS_WAIT(); asm volatile("" ::: "memory");
    GAS bf16* cat = (GAS bf16*)(F.ws + WS_CAT) + m0 * DM + h * 64 + 8 * pB;
#pragma unroll
    for (int rep = 0; rep < 4; ++rep) *(GAS v4u*)(cat + (size_t)(rB + 8 * rep) * DM) = *(const LAS v4u*)(R2 + (rB + 8 * rep) * 72 + 8 * pB);
}
__device__ __forceinline__ void hy_out_item(Frame& F, int l, int item, LAS unsigned char* lb) {
    int tid = F.tid; asm volatile("" : "+v"(tid));
    const int b = item >> 6, t0 = (item & 63) * 64, cg = tid & 31, tq = tid >> 5, tq0 = t0 + 4 * tq;
    LAS float* ys = (LAS float*)lb;
    {   const GAS bf16* yc = (const GAS bf16*)(F.ws + WS_YC);
#pragma unroll
        for (int k = 0; k < 8; ++k) { const int i = tid + NTHR * k, cc = i >> 4, q = i & 15; const v2u w_ = *(const GAS v2u*)(yc + ((size_t)cc * BATCH + b) * SEQ + t0 + 4 * q);
            const f32x4 v = (f32x4){__uint_as_float(w_.x << 16), __uint_as_float(w_.x & 0xffff0000u), __uint_as_float(w_.y << 16), __uint_as_float(w_.y & 0xffff0000u)};
            ys[(4 * q) * 260 + cc] = v[0]; ys[(4 * q + 1) * 260 + cc] = v[1]; ys[(4 * q + 2) * 260 + cc] = v[2]; ys[(4 * q + 3) * 260 + cc] = v[3]; } }
    const GAS bf16* p = (const GAS bf16*)(F.ws + WS_PROJ) + ((size_t)b * SEQ + tq0) * NPROJ + PC_HX0 + 8 * cg;
    const GAS float* cw = INP(F, I_HCW) + l * 3 * 768 + 8 * cg; const GAS float* cb = INP(F, I_HCB) + l * 768 + 8 * cg;
    __builtin_amdgcn_sched_barrier(0);
    unsigned zp[4][4];
    {   v4u r1[6], r2[6]; hy_rows(p + 256, tq0, r1); hy_rows(p + 512, tq0, r2); hy_z_half<0>(r1, r2, cw, cb, zp); hy_z_half<1>(r1, r2, cw, cb, zp); }
    float x0[4][8];
    {   v4u r0[6]; hy_rows(p, tq0, r0); float h0[4][4], h1[4][4]; hy_conv4x4<0>(r0, cw, cb, h0); hy_conv4x4<1>(r0, cw, cb, h1);
#pragma unroll
        for (int i = 0; i < 4; ++i)
#pragma unroll
            for (int e = 0; e < 4; ++e) { x0[i][e] = h0[i][e]; x0[i][4 + e] = h1[i][e]; } }
    __builtin_amdgcn_sched_barrier(0);
    const GAS float* skp = INP(F, I_HSKIP) + l * 256 + 8 * cg; const f32x4 ska = *(const GAS f32x4*)skp, skb = *(const GAS f32x4*)(skp + 4);
    __syncthreads();
    GAS bf16* cat = (GAS bf16*)(F.ws + WS_CAT) + ((size_t)b * SEQ + tq0) * DM + 768 + 8 * cg;
#pragma unroll
    for (int i = 0; i < 4; ++i) { const f32x4 ya = *(LAS f32x4*)(ys + (4 * tq + i) * 260 + 8 * cg), yb = *(LAS f32x4*)(ys + (4 * tq + i) * 260 + 8 * cg + 4); float o[8];
#pragma unroll
        for (int e = 0; e < 8; ++e) { const float y = (e < 4) ? ya[e & 3] : yb[e & 3], sk = (e < 4) ? ska[e & 3] : skb[e & 3]; const float zz = __uint_as_float((e & 1) ? (zp[i][e >> 1] & 0xffff0000u) : (zp[i][e >> 1] << 16)); o[e] = x0[i][e] * (y + zz * sk); }
        v4u w; w.x = pk2(o[0], o[1]); w.y = pk2(o[2], o[3]); w.z = pk2(o[4], o[5]); w.w = pk2(o[6], o[7]); *(GAS v4u*)(cat + (size_t)i * DM) = w; }
    __syncthreads();
}
__device__ __forceinline__ void phase_mix_out(Frame& F, int l) {
    for (int it = blockIdx.x; it < 256; it += F.G) hy_out_item(F, l, it, F.lds);
    const int gw = F.vcu * NWAVES + F.wave, NGW = F.G * NWAVES;
    for (int it = gw; it < 2048; it += NGW) gla_out_item(F, l, it, (LAS bf16*)(F.lds + F.wave * 14848));
}

__device__ __forceinline__ void post_mix_front(Frame& F, int l, int m, const f32x4 (&y)[4], f32x4 (&x)[4], const LAS float* PV) {
    const int lane = F.lane, b = m >> 12; const LAS f32x4* A = (const LAS f32x4*)(PV + b * 3072); const LAS f32x4* Bv = A + 256; const LAS f32x4* Cv = A + 512;
    const float rstd = rsq(row_ss(y, lane) * (1.0f / DM) + EPS);
#pragma unroll
    for (int j = 0; j < 4; ++j) { const int c4 = lane + 64 * j; x[j] = x[j] + A[c4] * (y[j] * rstd); }
    roww_store_bf16((GAS bf16*)(F.ws + WS_XR) + (size_t)m * DM, lane, x);
    const float rstd2 = rsq(row_ss(x, lane) * (1.0f / DM) + EPS);
    v4u hw;
#pragma unroll
    for (int j = 0; j < 4; ++j) { const int c4 = lane + 64 * j; x[j] = x[j] * rstd2 * Bv[c4] + Cv[c4]; hw[j] = pk4_f8(x[j][0], x[j][1], x[j][2], x[j][3]); }
    ((GAS v4u*)((GAS unsigned char*)(F.ws + WS_HN) + (size_t)m * DM))[lane] = hw;
}
__device__ __forceinline__ void post_mix_route(Frame& F, int m, float (&lg)[16]) {
    const int lane = F.lane, b = m >> 12, t = m & (SEQ - 1);
    const bool b5 = (lane & 32) != 0, b4 = (lane & 16) != 0, b3 = (lane & 8) != 0, b2 = (lane & 4) != 0;
    float a8[8], a4[4], a2[2];
#pragma unroll
    for (int e = 0; e < 8; ++e) a8[e] = swap32_sum(lg[e], lg[8 + e]);
#pragma unroll
    for (int e = 0; e < 4; ++e) a4[e] = swap16_sum(a8[e], a8[4 + e]);
#pragma unroll
    for (int e = 0; e < 2; ++e) { const float keep = b3 ? a4[2 + e] : a4[e], send = b3 ? a4[e] : a4[2 + e]; a2[e] = keep + dpp_f<DPP_ROR8>(send); }
    float v = (b2 ? a2[1] : a2[0]) + dpp_f<DPP_HMIR>(b2 ? a2[0] : a2[1]);
    v += dpp_f<DPP_X2>(v); v += dpp_f<DPP_X1>(v);
    float mx = fmaxf(v, dpp_f<DPP_HMIR>(v)); mx = fmaxf(mx, dpp_f<DPP_ROR8>(mx)); mx = swap16_max(mx); mx = swap32_max(mx);
    const float ex = expf(v - mx); float den = ex + dpp_f<DPP_HMIR>(ex); den += dpp_f<DPP_ROR8>(den); den = swap16_sum(den, den); den = swap32_sum(den, den);
    const int e = (b5 ? 8 : 0) + (b4 ? 4 : 0) + (b3 ? 2 : 0) + (b2 ? 1 : 0);
    if ((lane & 3) == 0) ((GAS float*)(F.ws + WS_AFF))[((size_t)b * NEXP + e) * SEQ + t] = ex / den;
}
__device__ __forceinline__ void phase_post_mix(Frame& F, int l) {
    LAS float* rws = (LAS float*)F.lds;
    for (int i = F.tid; i < DM * NEXP / 4; i += NTHR) { const int k = i >> 2, part = i & 3, g = k >> 2, slot_ = (g >> 2) + 64 * (g & 3);
        *(LAS f32x4*)(rws + slot_ * 68 + (k & 3) * 16 + part * 4) = ((const GAS f32x4*)(INP(F, I_ROUTER) + (size_t)l * DM * NEXP))[i]; }
    const GAS float* mod = (const GAS float*)(F.ws + WS_MOD) + (size_t)l * 4 * 6144;
    LAS float* PV = (LAS float*)(F.lds + 69632);
    for (int i = F.tid; i < 4 * 256; i += NTHR) { const int b = i >> 8, c4 = i & 255; const GAS float* mb = mod + (size_t)b * 6144;
        const f32x4 gm = ((const GAS f32x4*)(mb + 2048))[c4], pg = ((const GAS f32x4*)(INP(F, I_MPOST) + l * DM))[c4], gg = ((const GAS f32x4*)(INP(F, I_FPRE) + l * DM))[c4], s1 = ((const GAS f32x4*)(mb + 4096))[c4], s0 = ((const GAS f32x4*)(mb + 3072))[c4];
        LAS f32x4* pv = (LAS f32x4*)(PV + b * 3072) + ((c4 >> 2) + 64 * (c4 & 3)); pv[0] = gm * pg; pv[256] = gg * (1.0f + s1); pv[512] = s0; }
    __syncthreads();
    const int gw = F.vcu * NWAVES + F.wave, NGW = F.G * NWAVES, lane = F.lane;
    const GAS float* xin = INP(F, I_X); const GAS bf16* xr = (const GAS bf16*)(F.ws + WS_XR); const GAS bf16* Y = (const GAS bf16*)(F.ws + WS_Y);
    for (int m0 = gw; m0 < M; m0 += 4 * NGW) {
        int mm[4]; f32x4 xx[4][4];
#pragma unroll
        for (int q = 0; q < 4; ++q) mm[q] = (m0 + q * NGW < M) ? m0 + q * NGW : m0;
#pragma unroll
        for (int q = 0; q < 4; q += 2) { f32x4 ya[4], yb[4];
            roww_load_bf16(Y + (size_t)mm[q] * DM, lane, ya); roww_load_bf16(Y + (size_t)mm[q + 1] * DM, lane, yb);
            if (l == 0) { roww_load(xin + (size_t)mm[q] * DM, lane, xx[q]); roww_load(xin + (size_t)mm[q + 1] * DM, lane, xx[q + 1]); }
            else { roww_load_bf16(xr + (size_t)mm[q] * DM, lane, xx[q]); roww_load_bf16(xr + (size_t)mm[q + 1] * DM, lane, xx[q + 1]); }
            post_mix_front(F, l, mm[q], ya, xx[q], PV); post_mix_front(F, l, mm[q + 1], yb, xx[q + 1], PV); }
        typedef float r_f32x2 __attribute__((ext_vector_type(2)));
        r_f32x2 lg2[4][8];
#pragma unroll
        for (int q = 0; q < 4; ++q)
#pragma unroll
            for (int e = 0; e < 8; ++e) lg2[q][e] = (r_f32x2){0.f, 0.f};
#pragma unroll
        for (int j = 0; j < 4; ++j) { const LAS float* wg = rws + (lane + 64 * j) * 68;
#pragma unroll
            for (int i = 0; i < 4; ++i) { const f32x4 w0 = *(const LAS f32x4*)(wg + 16 * i), w1 = *(const LAS f32x4*)(wg + 16 * i + 4), w2 = *(const LAS f32x4*)(wg + 16 * i + 8), w3 = *(const LAS f32x4*)(wg + 16 * i + 12);
                const r_f32x2 wv[8] = {{w0[0], w0[1]}, {w0[2], w0[3]}, {w1[0], w1[1]}, {w1[2], w1[3]}, {w2[0], w2[1]}, {w2[2], w2[3]}, {w3[0], w3[1]}, {w3[2], w3[3]}};
#pragma unroll
                for (int q = 0; q < 4; ++q) { const float h = xx[q][j][i]; const r_f32x2 hh = {h, h};
#pragma unroll
                    for (int e = 0; e < 8; ++e) lg2[q][e] = __builtin_elementwise_fma(hh, wv[e], lg2[q][e]); }
#pragma unroll
                for (int q = 0; q < 4; ++q)
                    asm volatile("" : "+v"(lg2[q][0]), "+v"(lg2[q][1]), "+v"(lg2[q][2]), "+v"(lg2[q][3]), "+v"(lg2[q][4]), "+v"(lg2[q][5]), "+v"(lg2[q][6]), "+v"(lg2[q][7]));
                } }
        float lg[4][16];
#pragma unroll
        for (int q = 0; q < 4; ++q)
#pragma unroll
            for (int e = 0; e < 8; ++e) { lg[q][2 * e] = lg2[q][e].x; lg[q][2 * e + 1] = lg2[q][e].y; }
#pragma unroll
        for (int q = 0; q < 4; ++q) if (q == 0 || mm[q] != m0) post_mix_route(F, mm[q], lg[q]);
    }
    __syncthreads();
}

__device__ __forceinline__ unsigned block_excl_scan(unsigned v, LAS unsigned* wsum, int lane, int wave) {
    unsigned inc = v;
#pragma unroll
    for (int o = 1; o < 64; o <<= 1) { const unsigned t = lane_getu(inc, lane - o); if (lane >= o) inc += t; }
    if (lane == 63) wsum[wave] = inc;
    __syncthreads();
    unsigned base = 0;
#pragma unroll
    for (int w = 0; w < 8; ++w) base += (w < wave) ? wsum[w] : 0u;
    __syncthreads();
    return base + inc - v;
}
__device__ __forceinline__ void phase_topk(Frame& F) {
    const int tid = F.tid, lane = F.lane, wave = F.wave;
    LAS unsigned* hist = (LAS unsigned*)F.lds;
    LAS unsigned* ctl = hist + 256;
    LAS unsigned* lst = hist + 512;
    const GAS float* aff = (const GAS float*)(F.ws + WS_AFF); GAS int* slotp = (GAS int*)(F.ws + WS_SLOT); GAS float* gate = (GAS float*)(F.ws + WS_GATE);
    const GAS unsigned char* hn8 = (const GAS unsigned char*)(F.ws + WS_HN); GAS unsigned char* xg8 = (GAS unsigned char*)(F.ws + WS_XG);
    for (int it = F.vcu; it < BATCH * NEXP * 4; it += F.G) { const int be = it >> 2, qu = it & 3, b = be >> 4, e = be & 15;
        const GAS f32x4* ap = (const GAS f32x4*)(aff + (size_t)be * SEQ + 8 * tid); const f32x4 v0 = ap[0], v1 = ap[1];
        unsigned key[8];
#pragma unroll
        for (int j = 0; j < 4; ++j) { key[j] = __float_as_uint(v0[j]); key[4 + j] = __float_as_uint(v1[j]); }
        unsigned prefix = 0u, mask = 0u, kk = CAP;
        if (tid == 0) ctl[2] = 0u;
#pragma unroll 1
        for (int pass = 0; pass < 4; ++pass) { const int shift = 24 - 8 * pass;
            if (tid < 256) hist[tid] = 0u;
            __syncthreads();
#pragma unroll
            for (int j = 0; j < 8; ++j) if ((key[j] & mask) == prefix) __hip_atomic_fetch_add(&hist[(key[j] >> shift) & 255u], 1u, __ATOMIC_RELAXED, __HIP_MEMORY_SCOPE_WORKGROUP);
            __syncthreads();
            if (wave == 0) { const unsigned h0 = hist[4 * lane], h1 = hist[4 * lane + 1], h2 = hist[4 * lane + 2], h3 = hist[4 * lane + 3]; const unsigned loc = h0 + h1 + h2 + h3;
                unsigned suf = loc;
#pragma unroll
                for (int o = 1; o < 64; o <<= 1) { const unsigned t = lane_getu(suf, lane + o); if (lane + o < 64) suf += t; }
                const unsigned above = suf - loc;
                if (above < kk && kk <= suf) { unsigned c = above; int d;
                    if (c + h3 >= kk) d = 3; else { c += h3; if (c + h2 >= kk) d = 2; else { c += h2; if (c + h1 >= kk) d = 1; else { c += h1; d = 0; } } }
                    ctl[0] = prefix | ((unsigned)(4 * lane + d) << shift); ctl[1] = kk - c; } }
            __syncthreads();
            prefix = ctl[0]; kk = ctl[1]; mask |= 255u << shift;
        }
        unsigned eqc = 0u;
#pragma unroll
        for (int j = 0; j < 8; ++j) eqc += (key[j] == prefix) ? 1u : 0u;
        unsigned eqr = block_excl_scan(eqc, ctl + 8, lane, wave);
        unsigned selm = 0u, selc = 0u;
#pragma unroll
        for (int j = 0; j < 8; ++j) { bool s = key[j] > prefix; if (key[j] == prefix) { s = eqr < kk; ++eqr; } selm |= s ? (1u << j) : 0u; selc += s ? 1u : 0u; }
        unsigned sl = block_excl_scan(selc, ctl + 8, lane, wave);
        if ((tid >> 7) == qu) { int so[8];
#pragma unroll
            for (int j = 0; j < 8; ++j) { const bool s = (selm >> j) & 1u; so[j] = s ? (int)sl : -1;
                if (s) { gate[e * EROWS + b * CAP + sl] = __uint_as_float(key[j]); const unsigned p = __hip_atomic_fetch_add(&ctl[2], 1u, __ATOMIC_RELAXED, __HIP_MEMORY_SCOPE_WORKGROUP); lst[p] = (unsigned)(8 * tid + j) | (sl << 16); ++sl; } }
            GAS int* sp = slotp + (size_t)be * SEQ + 8 * tid;
            typedef int v4i __attribute__((ext_vector_type(4))); *(GAS v4i*)sp = (v4i){so[0], so[1], so[2], so[3]}; *(GAS v4i*)(sp + 4) = (v4i){so[4], so[5], so[6], so[7]}; }
        __syncthreads();
        const int nsel = (int)ctl[2];
        for (int i0 = wave * 8; i0 < nsel; i0 += 64) {
            v4u r0[8]; unsigned en[8];
#pragma unroll
            for (int q = 0; q < 8; ++q) { const int i = (i0 + q < nsel) ? i0 + q : i0; en[q] = lst[i]; r0[q] = ((const GAS v4u*)(hn8 + ((size_t)b * SEQ + (en[q] & 0xffffu)) * DM))[lane]; }
#pragma unroll
            for (int q = 0; q < 8; ++q) if (i0 + q < nsel) ((GAS v4u*)(xg8 + ((size_t)e * EROWS + b * CAP + (en[q] >> 16)) * DM))[lane] = r0[q];
        }
        __syncthreads();
    }
}

__device__ __forceinline__ void phase_combine(Frame& F, int l) {
    const int gw = F.vcu * NWAVES + F.wave, NGW = F.G * NWAVES, lane = F.lane;
    const GAS float* modl = (const GAS float*)(F.ws + WS_MOD) + (size_t)l * 4 * 6144;
    const GAS int* slot = (const GAS int*)(F.ws + WS_SLOT); const GAS bf16* ye = (const GAS bf16*)(F.ws + WS_YE);
    LAS float* PV = (LAS float*)F.lds;
    for (int i = F.tid; i < 4 * 256; i += NTHR) { const int b = i >> 8, c4 = i & 255; const GAS float* mb = modl + (size_t)b * 6144;
        const f32x4 gf = ((const GAS f32x4*)(mb + 5120))[c4], pg = ((const GAS f32x4*)(INP(F, I_FPOST) + l * DM))[c4];
        LAS f32x4* pv = (LAS f32x4*)(PV + b * 3072) + ((c4 >> 2) + 64 * (c4 & 3)); pv[0] = gf * pg;
        if (l + 1 < DEPTH) { const GAS float* mn = modl + 4 * 6144 + (size_t)b * 6144; const f32x4 gg = ((const GAS f32x4*)(INP(F, I_MPRE) + (l + 1) * DM))[c4], s1 = ((const GAS f32x4*)(mn + 1024))[c4], s0 = ((const GAS f32x4*)mn)[c4];
            pv[256] = gg * (1.0f + s1); pv[512] = s0; } }
    __syncthreads();
    for (int m0 = gw; m0 < M; m0 += 2 * NGW) {
        int mm[2]; mm[0] = m0; mm[1] = (m0 + NGW < M) ? m0 + NGW : m0;
        int sl[2]; unsigned long long mask[2]; f32x4 y[2][4], x[2][4];
#pragma unroll
        for (int q = 0; q < 2; ++q) { const int b = mm[q] >> 12, t = mm[q] & (SEQ - 1); sl[q] = -1; if (lane < 16) sl[q] = slot[((size_t)b * NEXP + lane) * SEQ + t];
            roww_load_bf16((const GAS bf16*)(F.ws + WS_XR) + (size_t)mm[q] * DM, lane, x[q]);
#pragma unroll
            for (int j = 0; j < 4; ++j) y[q][j] = (f32x4){0.f, 0.f, 0.f, 0.f}; }
#pragma unroll
        for (int q = 0; q < 2; ++q) mask[q] = __ballot(sl[q] >= 0);
        while (mask[0] | mask[1]) {
            f32x4 r[2][4]; bool on[2];
#pragma unroll
            for (int q = 0; q < 2; ++q) { on[q] = mask[q] != 0ull; if (on[q]) { const int e = __builtin_ctzll(mask[q]); mask[q] &= mask[q] - 1; const int s = (int)lane_getu((unsigned)sl[q], e);
                    roww_load_bf16(ye + ((size_t)e * EROWS + (mm[q] >> 12) * CAP + s) * DM, lane, r[q]); } }
#pragma unroll
            for (int q = 0; q < 2; ++q) if (on[q]) {
#pragma unroll
                for (int j = 0; j < 4; ++j) y[q][j] += r[q][j]; }
        }
#pragma unroll
        for (int q = 0; q < 2; ++q) { const int m = mm[q], b = m >> 12; const LAS f32x4* A = (const LAS f32x4*)(PV + b * 3072);
            const float rstd = rsq(row_ss(y[q], lane) * (1.0f / DM) + EPS);
#pragma unroll
            for (int j = 0; j < 4; ++j) { const int c4 = lane + 64 * j;
                x[q][j] = x[q][j] + A[c4] * (y[q][j] * rstd); if (l + 1 == DEPTH) ((GAS f32x4*)(F.out + (size_t)m * DM))[4 * lane + j] = x[q][j]; }
            if (l + 1 < DEPTH) { roww_store_bf16((GAS bf16*)(F.ws + WS_XR) + (size_t)m * DM, lane, x[q]);
                const float rstd2 = rsq(row_ss(x[q], lane) * (1.0f / DM) + EPS); f32x4 hv[4];
#pragma unroll
                for (int j = 0; j < 4; ++j) { const int c4 = lane + 64 * j; hv[j] = x[q][j] * rstd2 * A[256 + c4] + A[512 + c4]; }
                roww_store_bf16((GAS bf16*)(F.ws + WS_HN) + (size_t)m * DM, lane, hv); } }
    }
    __syncthreads();
}

__device__ __forceinline__ void frame_fence(Frame& F) {
    asm volatile("" : "+s"(F.ws), "+s"(F.out), "+s"(F.ctl));
    { int g = gridDim.x; asm volatile("" : "+s"(g)); const int bx = blockIdx.x; F.G = g; F.vcu = (g % 8 == 0) ? (bx % 8) * (g / 8) + bx / 8 : bx; }
    int t = threadIdx.x; asm volatile("" : "+v"(t)); F.tid = t; F.lane = t & 63; F.wave = __builtin_amdgcn_readfirstlane(t >> 6);
}
__device__ __forceinline__ void frame_group(Frame& F, int G_eff) { const int bx = blockIdx.x; F.G = G_eff; F.vcu = (G_eff % 8 == 0) ? (bx % 8) * (G_eff / 8) + bx / 8 : bx; }
constexpr int NCOMP = 176, NCONV = 256 - NCOMP;
constexpr int F8W_BAR0 = F8W_HOST0 + F8W_HOSTED * 2048 + F8W_IDLE * 1024;
__device__ __forceinline__ int f8w_bar_count(int wi) { return F8W_BARQ0 + ((wi >= 896) ? F8W_BARQ + 3 : F8W_BARQ - 3); }
__device__ __forceinline__ int f8w_bar_item(int wi, int i) {
    if (i < F8W_BARQ0) return F8W_HOST0 - F8W_BARQ0 * F8W_BARW + wi + F8W_BARW * i;
    return (wi < 896) ? (F8W_BAR0 + wi + 896 * (i - F8W_BARQ0)) : (F8W_BAR0 + 896 * (F8W_BARQ - 3) + (wi - 896) + 896 * (i - F8W_BARQ0)); }
__device__ __forceinline__ void xcd_barrier_host(const XcdBarrier& b, Frame& F, unsigned epoch) {
    asm volatile("s_waitcnt vmcnt(0)" ::: "memory");
    __syncthreads();
    volatile LAS unsigned* st = b.st;
    if (F.wave == 0) {
      if (threadIdx.x == 0) {
        unsigned* bar = b.bar;
        __builtin_amdgcn_s_waitcnt(0);
        unsigned nloc = b.st[0], nx = b.st[1];
        if (nloc == 0u) { xcd_barrier_complete(bar, b.x, nloc, nx); b.st[0] = nloc; b.st[1] = nx; }
        const unsigned old = xb_add(&bar[XB_XSUB(b.x)], 1u);
        const unsigned gen = old / nloc;
        if (old + 1u == (gen + 1u) * nloc) {
            __builtin_amdgcn_fence(__ATOMIC_RELEASE, "agent");
            asm volatile("s_waitcnt vmcnt(0)" ::: "memory");
            const unsigned og = xb_add(&bar[XB_TOP], 1u);
            const unsigned tg = og / nx;
            if (og + 1u == (tg + 1u) * nx) xb_add(&bar[XB_TOPGEN], 1u);
            else XB_SPIN(xb_ld(&bar[XB_TOPGEN]) == tg, bar);
            __builtin_amdgcn_fence(__ATOMIC_ACQUIRE, "agent");
            xb_add(&bar[XB_XGEN(b.x)], 1u);
            asm volatile("s_waitcnt vmcnt(0)" ::: "memory");
        } else {
            XB_SPIN(xb_ld(&bar[XB_XGEN(b.x)]) == gen, bar);
            __builtin_amdgcn_fence(__ATOMIC_ACQUIRE, "agent");
            asm volatile("s_waitcnt vmcnt(0)" ::: "memory");
        }
        st[2] = epoch;
      }
    } else {
        const int wv = F.wave, wi = (int)blockIdx.x * 7 + wv - 1;
        for (;;) {
            if (st[2] == epoch) break;
            const int i = (int)st[8 + wv];
            if (i >= f8w_bar_count(wi)) { __builtin_amdgcn_s_sleep(2); continue; }
            f8w_convert_one(F, f8w_bar_item(wi, i));
            if (F.lane == 0) st[8 + wv] = (unsigned)(i + 1);
            asm volatile("s_waitcnt lgkmcnt(0)" ::: "memory");
        }
    }
    __syncthreads();
}
__device__ __forceinline__ void f8w_bar_flush(Frame& F, volatile LAS unsigned* st, int upto) {
    if (F.wave == 0) return;
    const int wv = F.wave, wi = (int)blockIdx.x * 7 + wv - 1; int i = (int)st[8 + wv];
    if (upto > F8W_BARQ0) upto = f8w_bar_count(wi);
    if (i >= upto) return;
    for (; i < upto; ++i) f8w_convert_one(F, f8w_bar_item(wi, i));
    if (F.lane == 0) st[8 + wv] = (unsigned)upto;
}
struct Args { const float* in[28]; float* out; unsigned char* ws; int ph_lo, ph_hi; };
constexpr int PH_PER_LAYER = 10, N_PHASES = 2 + DEPTH * PH_PER_LAYER;
__global__ void __launch_bounds__(NTHR, 2) fwd_kernel(Args args) {
    extern __shared__ __attribute__((aligned(16))) unsigned char lds[];
    Frame F;
    F.lds = (LAS unsigned char*)lds;
    F.tid = threadIdx.x; F.lane = F.tid & 63; F.wave = __builtin_amdgcn_readfirstlane(F.tid >> 6);
    F.G = gridDim.x; { const int bx = blockIdx.x; F.vcu = (F.G % 8 == 0) ? (bx % 8) * (F.G / 8) + bx / 8 : bx; }
    F.ws = (GAS unsigned char*)args.ws; F.out = (GAS float*)args.out; F.ctl = (GAS unsigned*)(args.ws + WS_CTL);
    for (int u = F.tid; u < (LDS_BYTES - LDSCTL_OFF) / 4; u += NTHR) ((LAS unsigned*)(F.lds + LDSCTL_OFF))[u] = 0u;
    __syncthreads();
    if (F.tid == 0) {
#pragma unroll
        for (int i = 0; i < 28; ++i) ((LAS unsigned long long*)(F.lds + LDSCTL_OFF))[i] = (unsigned long long)args.in[i]; }
    __syncthreads();
    XcdBarrier bar = xcd_barrier_post((unsigned*)F.ctl + CW_BAR, (volatile LAS unsigned*)(F.lds + MISC_OFF) + 8);
    const int lo = args.ph_lo, hi = args.ph_hi;
    const bool hostbar = (gridDim.x == 256) && lo <= 0 && hi >= N_PHASES;
#ifndef PHMASK
#define PHMASK 0xFFF
#endif
#define EN(j) (((PHMASK) >> (j)) & 1)
#ifndef REPMASK
#define REPMASK 0
#endif
#define REPS(j) for (int rep_ = 0; rep_ < ((((REPMASK) >> (j)) & 1) ? 2 : 1); (++rep_, __syncthreads()))
#define IN(k) (lo <= (k) && (k) < hi)
#ifndef BARREP
#define BARREP 1
#endif
#define SEAM(k) do { if (IN(k) && IN((k) + 1)) { for (int br_ = 0; br_ < BARREP; ++br_) { XcdBarrier b2 = bar; asm volatile("" : "+s"(b2.bar), "+s"(b2.x)); \
        if (hostbar && (k) >= 1 && (k) <= 2 + PH_PER_LAYER + 5) xcd_barrier_host(b2, F, (unsigned)(k) + 1u); else xcd_barrier(b2); } } } while (0)

    if (EN(0) && IN(0)) REPS(0) { frame_fence(F); prologue0(F); }
    SEAM(0);
    if (EN(1) && IN(1)) REPS(1) { frame_fence(F); prologue1(F); }
    SEAM(1);
    for (int l = 0; l < DEPTH; ++l) {
        const int pb = 2 + l * PH_PER_LAYER;
        const bool split = false, conv_role = false;
        const int cidx = (int)blockIdx.x - NCOMP, ctot = (F8_NTILES - cidx + NCONV - 1) / NCONV, cq1 = 38, cq2 = 21;
        if (EN(2) && IN(pb + 0)) REPS(2) {
            frame_fence(F);
            if (conv_role) f8_convert_range(F, cidx, NCONV, cq1);
            else {
            if (split) frame_group(F, NCOMP);
            pg8::Gemm g{(const pg8::bf16_t*)(F.ws + WS_HN), (const pg8::bf16_t*)(F.ws + WS_WIN) + (size_t)l * NPROJ * DM, M, NPROJ, DM};
            pg8::StaticOrder S; S.init(M, NPROJ, F.G, (int)blockIdx.x);
            pg8::EpiBf16<0> E{(pg8::bf16_t*)(F.ws + WS_PROJ), NPROJ, nullptr, 0, 0, 1.f};
            pg8::gemm_phase<pg8::EpiBf16<0>, pg8::StaticOrder, true, true>(F.lds, g, S, E);
            if (l == 0 && F.G == 256 && (int)blockIdx.x >= 128) f8w_convert_idle(F);
            if (l == 1 && hostbar && (int)blockIdx.x >= 128) f8w_bar_flush(F, bar.st, F8W_BARQ0 + F8W_BARQ);
            }
        }
        SEAM(pb + 0);
        if (EN(3) && IN(pb + 1)) REPS(3) { frame_fence(F);
            if (conv_role) f8_convert_range(F, cidx + NCONV * cq1, NCONV, cq2);
            else { if (split) frame_group(F, NCOMP); phase_prep(F, l); } }
        SEAM(pb + 1);
        if (EN(4) && IN(pb + 2)) {
            frame_fence(F);
            if (conv_role) f8_convert_range(F, cidx + NCONV * (cq1 + cq2), NCONV, ctot - cq1 - cq2);
            else {
            if (split) frame_group(F, NCOMP);
            for (int it = blockIdx.x; it < 256; it += F.G) gla_scan_item(F, it);
            REPS(12) for (int it = F.vcu; it < 256; it += F.G) hy_conv_item(F, l, it);
            __syncthreads();
            float gq_ = fabsf(INP(F, I_QNORM)[l * 64 + F.lane]), gk_ = fabsf(INP(F, I_KNORM)[l * 64 + F.lane]);
            gq_ = fmaxf(gq_, dpp_f<DPP_X1>(gq_)); gq_ = fmaxf(gq_, dpp_f<DPP_X2>(gq_)); gq_ = fmaxf(gq_, dpp_f<DPP_HMIR>(gq_)); gq_ = fmaxf(gq_, dpp_f<DPP_MIR>(gq_)); gq_ = swap16_max(gq_); gq_ = swap32_max(gq_);
            gk_ = fmaxf(gk_, dpp_f<DPP_X1>(gk_)); gk_ = fmaxf(gk_, dpp_f<DPP_X2>(gk_)); gk_ = fmaxf(gk_, dpp_f<DPP_HMIR>(gk_)); gk_ = fmaxf(gk_, dpp_f<DPP_MIR>(gk_)); gk_ = swap16_max(gk_); gk_ = swap32_max(gk_);
            const float mfix = __uint_as_float(__builtin_amdgcn_readfirstlane(__float_as_uint(1.02f * ATT_C2 * 64.0f * gq_ * gk_)));
            const bool nomax = mfix <= 60.0f;
            REPS(13) for (int i = 0; ; ++i) { const int U = split ? F.vcu + F.G * i : 2 * F.vcu + i; if (U >= 512 || (!split && i >= 2)) break;
                    const int grp = U >> 6, j = U & 63, b = grp >> 1, h = (grp & 1) * 4 + (j >> 4), qb = j & 15;
                    if (nomax) attn_body::attn_unit<8, true>(b, h, qb, (const attn_body::bf16*)(F.ws + WS_QP), (const attn_body::bf16*)(F.ws + WS_KV), (const attn_body::bf16*)(F.ws + WS_KV) + 128,
                                            (attn_body::bf16*)(F.ws + WS_CAT) + 256, (char*)lds, mfix);
                    else attn_body::attn_unit<8>(b, h, qb, (const attn_body::bf16*)(F.ws + WS_QP), (const attn_body::bf16*)(F.ws + WS_KV), (const attn_body::bf16*)(F.ws + WS_KV) + 128,
                                            (attn_body::bf16*)(F.ws + WS_CAT) + 256, (char*)lds); }
            }
        }
        SEAM(pb + 2);
        if (EN(5) && IN(pb + 3)) REPS(5) { frame_fence(F); phase_mix_out(F, l); }
        SEAM(pb + 3);
        if (EN(6) && IN(pb + 4)) REPS(6) {
            frame_fence(F);
            pg8::Gemm g{(const pg8::bf16_t*)(F.ws + WS_CAT), (const pg8::bf16_t*)(F.ws + WS_WOUT) + (size_t)l * DM * DM, M, DM, DM};
            pg8::StaticOrder S; S.init(M, DM, F.G, (int)blockIdx.x);
            pg8::EpiBf16Row E{(pg8::bf16_t*)(F.ws + WS_Y), DM, nullptr, 1.0f};
            pg8::gemm_phase<pg8::EpiBf16Row, pg8::StaticOrder, true, true>(F.lds, g, S, E);
        }
        SEAM(pb + 4);
        if (EN(7) && IN(pb + 5)) { if (l == 0) { REPS(7) { frame_fence(F); phase_post_mix(F, l); } } else { frame_fence(F); phase_post_mix(F, l); } }
        SEAM(pb + 5);
        if (EN(8) && IN(pb + 6)) REPS(8) { frame_fence(F); phase_topk(F); }
        if (hostbar) { frame_fence(F); f8w_bar_flush(F, bar.st, l == 0 ? F8W_BARQ0 : F8W_BARQ0 + F8W_BARQ); }
        SEAM(pb + 6);
        if (EN(9) && IN(pb + 7)) REPS(9) {
            frame_fence(F);
            pg8::Gemm g{(const pg8::bf16_t*)(F.ws + WS_XG), (const pg8::bf16_t*)(F.ws + WS_WGU + (size_t)l * NEXP * 5632 * DM), NEXP * EROWS, NEXP * 5632, DM / 2};
            pg8::MoeOrder S; S.init(22, F.G, F.vcu);
            pg8::EpiSwiGLU8 E{(unsigned char*)(F.ws + WS_H), FF / 128, 1.0f / W8_SCALE};
            pg8::gemm_phase<pg8::EpiSwiGLU8, pg8::MoeOrder, true, true, true, true>(F.lds, g, S, E);
        }
        SEAM(pb + 7);
        if (EN(10) && IN(pb + 8)) REPS(10) {
            frame_fence(F);
            pg8::Gemm g{(const pg8::bf16_t*)(F.ws + WS_H), (const pg8::bf16_t*)(F.ws + WS_WD + (size_t)l * NEXP * DM * FF), NEXP * EROWS, NEXP * DM, FF / 2};
            pg8::MoeOrder S; S.init(4, F.G, F.vcu);
            pg8::EpiBf16Row E{(pg8::bf16_t*)(F.ws + WS_YE), DM, (const float*)(F.ws + WS_GATE), 1.0f / W8_SCALE};
            pg8::gemm_phase<pg8::EpiBf16Row, pg8::MoeOrder, true, true, true, true, true>(F.lds, g, S, E);
        }
        SEAM(pb + 8);
        if (EN(11) && IN(pb + 9)) { frame_fence(F); phase_combine(F, l); }
        SEAM(pb + 9);
    }
#undef IN
#undef SEAM
}

#ifndef MK_N_LAUNCHES
#define MK_N_LAUNCHES 1
#endif
extern "C" void kernel_launch(void* const* d_in, const int* in_sizes, int n_in, void* d_out, int out_size, void* d_ws, size_t ws_size, hipStream_t stream) {
    static int grid = 0;
    if (grid == 0) {
        if (n_in != 28 || out_size != M * DM || ws_size < WS_END) { fprintf(stderr, "kernel_launch: unexpected shapes (n_in %d, out %d, ws %zu < %zu); nothing launched\n", n_in, out_size, ws_size, (size_t)WS_END); grid = -1; return; }
        int dev = 0, cus = 0, per_cu = 0;
        if (hipGetDevice(&dev) != hipSuccess || hipDeviceGetAttribute(&cus, hipDeviceAttributeMultiprocessorCount, dev) != hipSuccess) { grid = -1; return; }
        if (hipFuncSetAttribute((const void*)fwd_kernel, hipFuncAttributeMaxDynamicSharedMemorySize, LDS_BYTES) != hipSuccess) { fprintf(stderr, "kernel_launch: hipFuncSetAttribute failed\n"); grid = -1; return; }
        if (hipOccupancyMaxActiveBlocksPerMultiprocessor(&per_cu, (const void*)fwd_kernel, NTHR, LDS_BYTES) != hipSuccess || per_cu < 1) fprintf(stderr, "kernel_launch: occupancy query says %d\n", per_cu);
        (void)hipGetLastError();
        grid = cus;
    }
    if (grid < 0) return;
    (void)hipMemsetAsync((char*)d_ws + WS_CTL, 0, CTL_ZERO_BYTES, stream);
    Args a{};
    for (int i = 0; i < 28; ++i) a.in[i] = (const float*)d_in[i];
    a.out = (float*)d_out; a.ws = (unsigned char*)d_ws;
#if MK_N_LAUNCHES == 1
    a.ph_lo = 0; a.ph_hi = N_PHASES;
    hipLaunchKernelGGL(fwd_kernel, dim3(grid), dim3(NTHR), LDS_BYTES, stream, a);
#else
    for (int p = 0; p < N_PHASES; ++p) { a.ph_lo = p; a.ph_hi = p + 1; hipLaunchKernelGGL(fwd_kernel, dim3(grid), dim3(NTHR), LDS_BYTES, stream, a); }
#endif
}
```
